# Optimizing an MI355X kernel written in HIP

```python
import math
import jax, jax.numpy as jnp
from jax import lax
import numpy as np

D_MODEL = 2048
BATCH = 2
SEQ = 16384
DEPTH = 1

A_HEADS = 16
A_HEAD_DIM = 128
A_PATTERNS = ((128, 1), (512, 4), (2048, 16))
A_BLOCK = 128
A_WIDTH = A_HEADS * A_HEAD_DIM
B_HEADS = 16
Q_LORA = 512
KV_LORA = 512
QK_NOPE = 128
QK_ROPE = 64
V_HEAD = 128
ROPE_THETA = 10000.0
Q_BLOCK = 128
N_KEYS = 128
N_EXPERTS = N_KEYS * N_KEYS
PEER_HEADS = 8
PEER_QDIM = 256
PEER_TOPK = 16
PEER_CHUNK = 128
LN_EPS = 1e-5
RMS_EPS = 1e-6
ALPHA = (2.0 * DEPTH) ** 0.25
BETA = (8.0 * DEPTH) ** -0.25
NEG = -1e30
IN_SIZES = (A_WIDTH, A_WIDTH, A_WIDTH, Q_LORA, KV_LORA, QK_ROPE, 2 * D_MODEL)
IN_WIDTH = sum(IN_SIZES)
IN_SPLITS = tuple(int(v) for v in np.cumsum(IN_SIZES)[:-1])

kernel_name = 'hybrid_dilated_mla_peer_deepnorm'


def layer_norm(x, g, b):
    xf = x.astype(jnp.float32)
    mu = jnp.mean(xf, axis=-1, keepdims=True)
    var = jnp.mean(jnp.square(xf - mu), axis=-1, keepdims=True)
    return ((xf - mu) * lax.rsqrt(var + LN_EPS) * g + b).astype(x.dtype)


def rms_norm(x, g):
    xf = x.astype(jnp.float32)
    ms = jnp.mean(jnp.square(xf), axis=-1, keepdims=True)
    return (xf * lax.rsqrt(ms + RMS_EPS) * g).astype(x.dtype)


def apply_rope(t, positions):
    half = t.shape[-1] // 2
    inv_freq = ROPE_THETA ** (-jnp.arange(half, dtype=jnp.float32) / half)
    ang = positions.astype(jnp.float32)[:, None] * inv_freq[None, :]
    cos = jnp.cos(ang)[:, None, :].astype(t.dtype)
    sin = jnp.sin(ang)[:, None, :].astype(t.dtype)
    t1, t2 = t[..., :half], t[..., half:]
    return jnp.concatenate([t1 * cos - t2 * sin, t1 * sin + t2 * cos], axis=-1)


def alibi_slopes(n_heads):
    return jnp.power(2.0, -8.0 * jnp.arange(1, n_heads + 1, dtype=jnp.float32) / n_heads)


def dilated_window_attention(q, k, v, window, dilation, slopes):
    B, S, H, Dh = q.shape
    steps = window // dilation
    L = S // dilation
    nb = -(-L // A_BLOCK)
    Lp = nb * A_BLOCK

    def to_sub(t):
        t = t.reshape(B, L, dilation, H, Dh).transpose(0, 2, 3, 1, 4)
        t = jnp.pad(t, ((0, 0), (0, 0), (0, 0), (0, Lp - L), (0, 0)))
        return t.reshape(B, dilation, H, nb, A_BLOCK, Dh)

    def with_prev(t):
        prev = jnp.pad(t, ((0, 0), (0, 0), (0, 0), (1, 0), (0, 0), (0, 0)))[:, :, :, :-1]
        return jnp.concatenate([prev, t], axis=4)

    qb = to_sub(q)
    kw = with_prev(to_sub(k))
    vw = with_prev(to_sub(v))
    s = jnp.einsum('bdhnqc,bdhnkc->bdhnqk', qb, kw).astype(jnp.float32) * (Dh ** -0.5)

    i = jnp.arange(A_BLOCK)[:, None]
    c = jnp.arange(2 * A_BLOCK)[None, :]
    rel = A_BLOCK + i - c
    band = (rel >= 0) & (rel <= steps)
    blk = jnp.arange(nb)[:, None, None]
    valid = band[None] & (blk * A_BLOCK + c[None] >= A_BLOCK)
    bias = -slopes[:, None, None] * (dilation * rel).astype(jnp.float32)
    logits = jnp.where(valid, s + bias[None, None, :, None], NEG)

    m = jnp.max(logits, axis=-1, keepdims=True)
    p = jnp.exp(logits - m)
    z = jnp.sum(p, axis=-1, keepdims=True)
    o = jnp.einsum('bdhnqk,bdhnkc->bdhnqc', p / z, vw).astype(q.dtype)
    lse = (m + jnp.log(z))[..., 0]

    o = o.reshape(B, dilation, H, Lp, Dh)[:, :, :, :L].transpose(0, 3, 1, 2, 4).reshape(B, S, H, Dh)
    lse = lse.reshape(B, dilation, H, Lp)[:, :, :, :L].transpose(0, 3, 1, 2).reshape(B, S, H)
    return o, lse


def mla_attention(q_nope, q_rope, k_nope, k_rope, v):
    B, S, H, _ = q_nope.shape
    nq = S // Q_BLOCK
    scale = (QK_NOPE + QK_ROPE) ** -0.5
    kpos = jnp.arange(S)

    def block(args):
        qn, qr, start = args
        s = (jnp.einsum('bqhc,bkhc->bhqk', qn, k_nope)
             + jnp.einsum('bqhr,bkr->bhqk', qr, k_rope)).astype(jnp.float32) * scale
        qpos = start + jnp.arange(Q_BLOCK)
        s = jnp.where(kpos[None, :] <= qpos[:, None], s, NEG)
        p = jax.nn.softmax(s, axis=-1)
        return jnp.einsum('bhqk,bkhc->bqhc', p, v).astype(v.dtype)

    qn_b = q_nope.reshape(B, nq, Q_BLOCK, H, QK_NOPE).transpose(1, 0, 2, 3, 4)
    qr_b = q_rope.reshape(B, nq, Q_BLOCK, H, QK_ROPE).transpose(1, 0, 2, 3, 4)
    starts = jnp.arange(nq, dtype=jnp.int32) * Q_BLOCK
    out = lax.map(block, (qn_b, qr_b, starts))
    return out.transpose(1, 0, 2, 3, 4).reshape(B, S, H, V_HEAD)


def peer(x, w_query, sub_keys_1, sub_keys_2, expert_down, expert_up):
    B, S, D = x.shape
    q = (x @ w_query).reshape(B, S, PEER_HEADS, 2, PEER_QDIM // 2)
    s1 = jnp.einsum('bshc,kc->bshk', q[..., 0, :], sub_keys_1).astype(jnp.float32)
    s2 = jnp.einsum('bshc,kc->bshk', q[..., 1, :], sub_keys_2).astype(jnp.float32)
    v1, i1 = lax.top_k(s1, PEER_TOPK)
    v2, i2 = lax.top_k(s2, PEER_TOPK)
    cand_s = (v1[..., :, None] + v2[..., None, :]).reshape(B, S, PEER_HEADS, PEER_TOPK * PEER_TOPK)
    cand_i = (i1[..., :, None] * N_KEYS + i2[..., None, :]).reshape(B, S, PEER_HEADS, PEER_TOPK * PEER_TOPK)
    top_s, pos = lax.top_k(cand_s, PEER_TOPK)
    expert_idx = jnp.take_along_axis(cand_i, pos, axis=-1)
    gates = jax.nn.softmax(top_s, axis=-1)

    T = B * S
    nc = T // PEER_CHUNK
    E = PEER_HEADS * PEER_TOPK
    xc = x.reshape(nc, PEER_CHUNK, D)
    ec = expert_idx.reshape(nc, PEER_CHUNK, E)
    gc = gates.reshape(nc, PEER_CHUNK, E).astype(x.dtype)

    def chunk(args):
        xt, et, gt = args
        u = expert_down[et]
        h = jax.nn.gelu(jnp.einsum('cd,ced->ce', xt, u), approximate=False)
        vv = expert_up[et]
        return jnp.einsum('ce,ced->cd', gt * h, vv)

    y = lax.map(chunk, (xc, ec, gc))
    return y.reshape(B, S, D)


def setup_inputs(seed: int = 0) -> dict:
    key = jax.random.key(seed)
    ks = jax.random.split(key, 24)
    f32 = jnp.float32

    def normal(k, shape, scale):
        return jax.random.normal(k, shape, f32) * scale

    x = normal(ks[0], (BATCH, SEQ, D_MODEL), 1.0)
    in_scale = jnp.concatenate([jnp.ones((2 * A_WIDTH,), f32), jnp.full((A_WIDTH,), BETA, f32),
                                jnp.ones((IN_WIDTH - 3 * A_WIDTH,), f32)])
    w_in = normal(ks[1], (DEPTH, D_MODEL, IN_WIDTH), D_MODEL ** -0.5) * in_scale
    b_gates = normal(ks[2], (DEPTH, 2 * D_MODEL), 0.02)
    a_w_out = normal(ks[3], (DEPTH, A_WIDTH, D_MODEL), A_WIDTH ** -0.5)
    mla_q_norm = 1.0 + normal(ks[4], (DEPTH, Q_LORA), 0.02)
    mla_w_uq = normal(ks[5], (DEPTH, Q_LORA, B_HEADS * (QK_NOPE + QK_ROPE)), Q_LORA ** -0.5)
    mla_kv_norm = 1.0 + normal(ks[6], (DEPTH, KV_LORA), 0.02)
    ukv_scale = jnp.concatenate([jnp.ones((QK_NOPE,), f32), jnp.full((V_HEAD,), BETA, f32)])
    mla_w_ukv = (normal(ks[7], (DEPTH, KV_LORA, B_HEADS, QK_NOPE + V_HEAD), KV_LORA ** -0.5)
                 * ukv_scale).reshape(DEPTH, KV_LORA, B_HEADS * (QK_NOPE + V_HEAD))
    mla_w_out = normal(ks[8], (DEPTH, B_HEADS * V_HEAD, D_MODEL), (B_HEADS * V_HEAD) ** -0.5)
    w_out = normal(ks[9], (DEPTH, D_MODEL, D_MODEL), BETA * D_MODEL ** -0.5)
    ln1_g = 1.0 + normal(ks[10], (DEPTH, D_MODEL), 0.02)
    ln1_b = normal(ks[11], (DEPTH, D_MODEL), 0.02)
    peer_w_query = normal(ks[12], (DEPTH, D_MODEL, PEER_HEADS * PEER_QDIM), D_MODEL ** -0.5)
    peer_sub_keys_1 = normal(ks[13], (DEPTH, N_KEYS, PEER_QDIM // 2), (PEER_QDIM // 2) ** -0.5)
    peer_sub_keys_2 = normal(ks[14], (DEPTH, N_KEYS, PEER_QDIM // 2), (PEER_QDIM // 2) ** -0.5)
    peer_expert_down = normal(ks[15], (DEPTH, N_EXPERTS, D_MODEL), D_MODEL ** -0.5)
    peer_expert_up = normal(ks[16], (DEPTH, N_EXPERTS, D_MODEL), BETA)
    ln2_g = 1.0 + normal(ks[17], (DEPTH, D_MODEL), 0.02)
    ln2_b = normal(ks[18], (DEPTH, D_MODEL), 0.02)
    return {'x': x, 'w_in': w_in, 'b_gates': b_gates, 'a_w_out': a_w_out,
            'mla_q_norm': mla_q_norm, 'mla_w_uq': mla_w_uq, 'mla_kv_norm': mla_kv_norm,
            'mla_w_ukv': mla_w_ukv, 'mla_w_out': mla_w_out, 'w_out': w_out,
            'ln1_g': ln1_g, 'ln1_b': ln1_b, 'peer_w_query': peer_w_query,
            'peer_sub_keys_1': peer_sub_keys_1, 'peer_sub_keys_2': peer_sub_keys_2,
            'peer_expert_down': peer_expert_down, 'peer_expert_up': peer_expert_up,
            'ln2_g': ln2_g, 'ln2_b': ln2_b}


def reference(x, w_in, b_gates, a_w_out, mla_q_norm, mla_w_uq, mla_kv_norm, mla_w_ukv,
              mla_w_out, w_out, ln1_g, ln1_b, peer_w_query, peer_sub_keys_1, peer_sub_keys_2,
              peer_expert_down, peer_expert_up, ln2_g, ln2_b):
    B, S, D = x.shape
    positions = jnp.arange(S, dtype=jnp.int32)
    slopes = alibi_slopes(A_HEADS)
    h = x
    for l in range(DEPTH):
        proj = h @ w_in[l]
        qa, ka, va, cq, ckv, kr, gate_pre = jnp.split(proj, IN_SPLITS, axis=-1)
        gates = jax.nn.sigmoid(gate_pre + b_gates[l])
        g_a, g_b = gates[..., :D_MODEL], gates[..., D_MODEL:]

        qa = qa.reshape(B, S, A_HEADS, A_HEAD_DIM)
        ka = ka.reshape(B, S, A_HEADS, A_HEAD_DIM)
        va = va.reshape(B, S, A_HEADS, A_HEAD_DIM)
        outs, lses = [], []
        for window, dilation in A_PATTERNS:
            o_g, lse_g = dilated_window_attention(qa, ka, va, window, dilation, slopes)
            outs.append(o_g)
            lses.append(lse_g)
        w_pat = jax.nn.softmax(jnp.stack(lses, axis=0), axis=0).astype(h.dtype)
        y_a = jnp.einsum('gbsh,gbshc->bshc', w_pat, jnp.stack(outs, axis=0)).reshape(B, S, A_WIDTH)
        y_a = y_a @ a_w_out[l]

        cq = rms_norm(cq, mla_q_norm[l])
        q_b = (cq @ mla_w_uq[l]).reshape(B, S, B_HEADS, QK_NOPE + QK_ROPE)
        q_nope = q_b[..., :QK_NOPE]
        q_rope = apply_rope(q_b[..., QK_NOPE:], positions)
        ckv = rms_norm(ckv, mla_kv_norm[l])
        kv = (ckv @ mla_w_ukv[l]).reshape(B, S, B_HEADS, QK_NOPE + V_HEAD)
        k_nope, v_b = kv[..., :QK_NOPE], kv[..., QK_NOPE:]
        k_rope = apply_rope(kr[:, :, None, :], positions)[:, :, 0]
        y_b = mla_attention(q_nope, q_rope, k_nope, k_rope, v_b).reshape(B, S, B_HEADS * V_HEAD)
        y_b = y_b @ mla_w_out[l]

        mix = (g_a * y_a + g_b * y_b) @ w_out[l]
        h = layer_norm(ALPHA * h + mix, ln1_g[l], ln1_b[l])

        y_p = peer(h, peer_w_query[l], peer_sub_keys_1[l], peer_sub_keys_2[l],
                   peer_expert_down[l], peer_expert_up[l])
        h = layer_norm(ALPHA * h + y_p, ln2_g[l], ln2_b[l])
    return h
```

```cpp
#include <hip/hip_runtime.h>
#include <cstdio>
#include <cstdint>
#define MK_N_LAUNCHES 1

#define GAS __attribute__((address_space(1)))
#define LAS __attribute__((address_space(3)))
typedef unsigned short bf16;
typedef unsigned v4u __attribute__((ext_vector_type(4)));
typedef unsigned v2u __attribute__((ext_vector_type(2)));
typedef int v4i __attribute__((ext_vector_type(4)));
typedef float f32x4 __attribute__((ext_vector_type(4)));
typedef float f32x2 __attribute__((ext_vector_type(2)));
typedef float f32x16 __attribute__((ext_vector_type(16)));
typedef short bf16x8 __attribute__((ext_vector_type(8)));
typedef short s16x4 __attribute__((ext_vector_type(4)));

constexpr int DM = 2048, BATCH = 2, SEQ = 16384, T = BATCH * SEQ;
constexpr int IN_W = 11328;
constexpr int NA = 7424;
constexpr int NGATE = 4096;
constexpr int NQB = 3072, NKV = 4096, QL = 512;
constexpr int NEXP = 16384, PH = 8, PTOPK = 16;
constexpr float LN_EPS = 1e-5f, RMS_EPS = 1e-6f;
constexpr float ALPHA = 1.189207115002721f;
constexpr float LOG2E = 1.4426950408889634f;
constexpr float QSC_A = 0.08838834764831845f * LOG2E;
constexpr float QSC_B = 0.07216878364870322f * LOG2E;
constexpr int NPHASE = 17;

constexpr size_t MiB = 1u << 20;
constexpr size_t WS_CTL = 0, CTL_ZERO_BYTES = 65536;
constexpr size_t WS_WA = 1 * MiB, WS_WG = 30 * MiB, WS_WAO = 46 * MiB, WS_WBO = 54 * MiB, WS_WO = 62 * MiB, WS_WPQ = 70 * MiB, WS_WUQ = 78 * MiB, WS_WUKV = 81 * MiB;
constexpr size_t WS_SK = 85 * MiB, WS_ROPE = 86 * MiB;
constexpr size_t WS_XB = 96 * MiB;
constexpr size_t WS_QKV = 224 * MiB, WS_CQKV = 608 * MiB, WS_KRRAW = 672 * MiB, WS_CQN = 676 * MiB, WS_CKVN = 708 * MiB, WS_KRR = 740 * MiB, WS_LSE = 744 * MiB, WS_OA = 746 * MiB;
constexpr size_t WS_QB = 224 * MiB, WS_KN = 416 * MiB, WS_OB = 544 * MiB, WS_VB = 874 * MiB;
constexpr size_t WS_YA = 224 * MiB, WS_YB = 352 * MiB, WS_U = 874 * MiB;
constexpr size_t WS_R = 224 * MiB, WS_H1B = 480 * MiB, WS_ED = 608 * MiB, WS_EU = 672 * MiB, WS_PQ = 736 * MiB, WS_IDX = 874 * MiB, WS_GATE = 890 * MiB;
constexpr size_t WS_END = 1002 * MiB;
static_assert(WS_WA + (size_t)NA * DM * 2 <= WS_WG && WS_WUKV + (size_t)NKV * QL * 2 <= WS_SK && WS_ROPE + (size_t)SEQ * 64 * 4 <= WS_XB, "weights map");
static_assert(WS_QKV + (size_t)T * 6144 * 2 <= WS_CQKV && WS_OA + (size_t)T * DM * 2 <= WS_VB && WS_VB + (size_t)T * DM * 2 <= WS_END, "activation map");
static_assert(WS_QB + (size_t)T * NQB * 2 <= WS_KN && WS_KN + (size_t)T * DM * 2 <= WS_OB && WS_OB + (size_t)T * DM * 2 <= WS_KRRAW, "mla map");
static_assert(WS_R + (size_t)T * DM * 4 <= WS_H1B && WS_H1B + (size_t)T * DM * 2 <= WS_ED && WS_EU + (size_t)NEXP * DM * 2 <= WS_PQ && WS_PQ + (size_t)T * DM * 2 <= WS_IDX, "peer map");
constexpr int CW_BAR = 1024;

constexpr int RING_BYTES = 131072;
constexpr int MISC_OFF = RING_BYTES;
constexpr int LDS_BYTES = 147456;

#define LDS_WAIT() asm volatile("s_waitcnt lgkmcnt(0)" ::: "memory")
#define VM_WAIT() asm volatile("s_waitcnt vmcnt(0)" ::: "memory")
#define SBAR() __builtin_amdgcn_sched_barrier(0)
__device__ __forceinline__ unsigned f2bf(float f) { unsigned u = __builtin_bit_cast(unsigned, f); return (u + 0x7fffu + ((u >> 16) & 1u)) >> 16; }
__device__ __forceinline__ unsigned pk2(float lo, float hi) { return f2bf(lo) | (f2bf(hi) << 16); }
__device__ __forceinline__ float bf_lo(unsigned w) { return __builtin_bit_cast(float, w << 16); }
__device__ __forceinline__ float bf_hi(unsigned w) { return __builtin_bit_cast(float, w & 0xffff0000u); }
__device__ __forceinline__ float bf2f(bf16 b) { return __builtin_bit_cast(float, ((unsigned)b) << 16); }
__device__ __forceinline__ float wave_sum(float v) {
#pragma unroll
    for (int o = 1; o < 64; o <<= 1) v += __shfl_xor(v, o);
    return v;
}

#define XB_TMO      128
#define XB_XCNT(j)  (256  + 64 * (j))
#define XB_XSUB(j)  (1280 + 64 * (j))
#define XB_XGEN(j)  (2304 + 64 * (j))
#define XB_TOP      3328
#define XB_TOPGEN   3392
#define XCD_BAR_WORDS 3456
#define XB_SPIN_CAP (1u << 24)

__device__ __forceinline__ unsigned xb_ld(unsigned* p)              { return __hip_atomic_load(p, __ATOMIC_RELAXED, __HIP_MEMORY_SCOPE_AGENT); }
__device__ __forceinline__ unsigned xb_add(unsigned* p, unsigned v) { return __hip_atomic_fetch_add(p, v, __ATOMIC_RELAXED, __HIP_MEMORY_SCOPE_AGENT); }
__device__ __forceinline__ unsigned xb_xcc_id() { return (unsigned)__builtin_amdgcn_s_getreg((3 << 11) | 20) & 0xFu; }
#define XB_SPIN(cond, bar) do { unsigned _sp = 0; while (cond) { __builtin_amdgcn_s_sleep(1); \
    if ((++_sp & 255u) == 0u) { if (xb_ld(&(bar)[XB_TMO])) break; if (_sp > XB_SPIN_CAP) { atomicAdd(&(bar)[XB_TMO], 1u); break; } } } } while (0)

struct XcdBarrier {
    unsigned* bar; unsigned x;
    volatile LAS unsigned* st;
};

__device__ __forceinline__ XcdBarrier xcd_barrier_post(unsigned* bar, volatile LAS unsigned* st) {
    XcdBarrier b; b.bar = bar; b.x = xb_xcc_id(); b.st = st;
    if (threadIdx.x == 0) (void)xb_add(&bar[XB_XCNT(b.x)], 1u);
    return b;
}
__device__ __forceinline__ void xcd_barrier_complete(unsigned* bar, unsigned x, unsigned& nloc, unsigned& nx) {
    const unsigned G = gridDim.x * gridDim.y * gridDim.z;
    unsigned sum, cnt, mine, sp = 0u;
    for (;;) {
        sum = 0u; cnt = 0u; mine = 0u;
#pragma unroll
        for (unsigned j = 0; j < 16; ++j) { const unsigned c = xb_ld(&bar[XB_XCNT(j)]); sum += c; cnt += (c > 0u) ? 1u : 0u; mine = (j == x) ? c : mine; }
        if (sum == G) break;
        __builtin_amdgcn_s_sleep(1);
        if ((++sp & 255u) == 0u) { if (xb_ld(&bar[XB_TMO])) break; if (sp > XB_SPIN_CAP) { atomicAdd(&bar[XB_TMO], 1u); break; } }
    }
    nloc = mine > 0u ? mine : 1u; nx = cnt > 0u ? cnt : 1u;
}

__device__ __forceinline__ void xcd_barrier(const XcdBarrier& b) {
    asm volatile("s_waitcnt vmcnt(0)" ::: "memory");
    __syncthreads();
    if (threadIdx.x == 0) {
        unsigned* bar = b.bar;
        __builtin_amdgcn_s_waitcnt(0);
        unsigned nloc = b.st[0], nx = b.st[1];
        if (nloc == 0u) { xcd_barrier_complete(bar, b.x, nloc, nx); b.st[0] = nloc; b.st[1] = nx; }
        const unsigned old = xb_add(&bar[XB_XSUB(b.x)], 1u);
        const unsigned gen = old / nloc;
        if (old + 1u == (gen + 1u) * nloc) {
            __builtin_amdgcn_fence(__ATOMIC_RELEASE, "agent");
            asm volatile("s_waitcnt vmcnt(0)" ::: "memory");
            const unsigned og = xb_add(&bar[XB_TOP], 1u);
            const unsigned tg = og / nx;
            if (og + 1u == (tg + 1u) * nx) xb_add(&bar[XB_TOPGEN], 1u);
            else XB_SPIN(xb_ld(&bar[XB_TOPGEN]) == tg, bar);
            __builtin_amdgcn_fence(__ATOMIC_ACQUIRE, "agent");
            xb_add(&bar[XB_XGEN(b.x)], 1u);
            asm volatile("s_waitcnt vmcnt(0)" ::: "memory");
        } else {
            XB_SPIN(xb_ld(&bar[XB_XGEN(b.x)]) == gen, bar);
            __builtin_amdgcn_fence(__ATOMIC_ACQUIRE, "agent");
            asm volatile("s_waitcnt vmcnt(0)" ::: "memory");
        }
    }
    __syncthreads();
}


namespace pg8 {
#define PG8_LAS __attribute__((address_space(3)))
typedef unsigned short bf16_t;
typedef short bf16x8 __attribute__((ext_vector_type(8)));
typedef float f32x4 __attribute__((ext_vector_type(4)));
typedef unsigned u32x4 __attribute__((ext_vector_type(4)));
constexpr int BM = 256, BK = 64, HALF = 128, HTB = HALF * BK * 2  , STAGE_BYTES = 8 * HTB, NXCD = 8, WGM = 8;

__host__ __device__ __forceinline__ int lds_byte(int r, int c) { const int st = (r >> 4) * 2 + (c >> 5), rr = r & 15, cc = c & 31, ob = rr * 64 + cc * 2; return st * 1024 + (ob ^ (((ob >> 9) & 1) << 5)); }
__host__ __device__ __forceinline__ void stage_rc(int b, int& R, int& C) { const int st = b / 1024, sb = b % 1024, swz = sb ^ (((sb >> 9) & 1) << 5); R = (st >> 1) * 16 + swz / 64; C = (st & 1) * 32 + (swz % 64) / 2; }
__host__ __device__ __forceinline__ int perm32(int rho) { const int n = rho >> 4, i = rho & 15; return 8 * (i >> 2) + 4 * n + (i & 3); }

struct Unit { int pm, pn; };
struct Gemm { const bf16_t* A; const bf16_t* Bt; int M, N, K; };

struct StaticOrder {
    int nM, nN, nwg, G, c;
    __host__ __device__ void init(int M, int N, int G_, int c_) { nM = M / BM; nN = N / BM; nwg = nM * nN; G = G_; c = c_; }
    __host__ __device__ bool next(int i, Unit& u) const {
        const long L = (long)i * G + c; if (L >= nwg) return false;
        int wgid = (int)L; { const int q = nwg / NXCD, r = nwg % NXCD, xcd = wgid % NXCD, off = wgid / NXCD; wgid = (xcd < r ? xcd * (q + 1) : r * (q + 1) + (xcd - r) * q) + off; }
        const int nig = WGM * nN, gid = wgid / nig, fm = gid * WGM, gsz = (nM - fm) < WGM ? (nM - fm) : WGM;
        u.pm = fm + ((wgid % nig) % gsz); u.pn = (wgid % nig) / gsz; return true;
    }
    __device__ __forceinline__ void a_ready(const Unit&) const {}
    __device__ __forceinline__ void done(const Unit&) const {}
};
__device__ __forceinline__ unsigned cvt_pk_bf16(float lo, float hi) { unsigned r; asm volatile("v_cvt_pk_bf16_f32 %0, %1, %2" : "=v"(r) : "v"(lo), "v"(hi)); return r; }
typedef float f32x2 __attribute__((ext_vector_type(2)));
__device__ __forceinline__ f32x2 gelu_pk(f32x2 v) {
    const f32x2 av = __builtin_elementwise_abs(v), d = av * 0.2316418882f + 1.0f;
    f32x2 t; t.x = __builtin_amdgcn_rcpf(d.x); t.y = __builtin_amdgcn_rcpf(d.y);
    f32x2 q = t * 0.5307027145f + (-0.7265760135f); q = q * t + 0.7107068705f; q = q * t + (-0.142248368f); q = q * t + 0.127414796f; q = q * t;
    const f32x2 s = (v * v) * (-0.72134752044f);
    f32x2 e; e.x = __builtin_amdgcn_exp2f(s.x); e.y = __builtin_amdgcn_exp2f(s.y);
    const f32x2 m = v * (q * e), r = v - m;
    f32x2 o; o.x = v.x < 0.f ? m.x : r.x; o.y = v.y < 0.f ? m.y : r.y; return o;
}

__device__ __forceinline__ u32x4 pack8s(f32x4 v0, f32x4 v1, float s) { u32x4 w; w.x = cvt_pk_bf16(v0[0] * s, v0[1] * s); w.y = cvt_pk_bf16(v0[2] * s, v0[3] * s); w.z = cvt_pk_bf16(v1[0] * s, v1[1] * s); w.w = cvt_pk_bf16(v1[2] * s, v1[3] * s); return w; }
struct EpiA {
    static constexpr bool PERM = true, AFTER_DRAIN = false;
    bf16_t* qkv; bf16_t* cqkv; bf16_t* krraw;
    __device__ __forceinline__ void operator()(const f32x4 (&acc)[2][2][4][2], const Unit& u, int wr, int wc, int fr, int fq) const {
        const int row0 = u.pm * BM + wr * 64 + fr, cw = wc * 32 + 8 * fq, pn = u.pn;
        bf16_t* base; int ldc, colt; float sc = 1.f; bool narrow = false;
        if (pn < 24) { base = qkv; ldc = 6144; colt = pn * 256; if (pn < 8) sc = QSC_A; }
        else if (pn < 28) { base = cqkv; ldc = 1024; colt = (pn - 24) * 256; }
        else { base = krraw; ldc = 64; colt = 0; narrow = true; }
#pragma unroll
        for (int ai = 0; ai < 2; ++ai)
#pragma unroll
            for (int m = 0; m < 4; ++m) { bf16_t* rowp = base + (size_t)(row0 + ai * HALF + m * 16) * ldc + colt + cw;
#pragma unroll
                for (int bj = 0; bj < 2; ++bj) { if (narrow && (bj == 1 || cw >= 64)) continue;
                    *(u32x4*)(rowp + bj * HALF) = pack8s(acc[ai][bj][m][0], acc[ai][bj][m][1], sc); } }
    }
};
struct EpiQ {
    static constexpr bool PERM = true, AFTER_DRAIN = false;
    bf16_t* qb; const float* rope;
    __device__ __forceinline__ void operator()(const f32x4 (&acc)[2][2][4][2], const Unit& u, int wr, int wc, int fr, int fq) const {
        const int row0 = u.pm * BM + wr * 64 + fr;
#pragma unroll
        for (int bj = 0; bj < 2; ++bj) { const int c0 = u.pn * BM + bj * HALF + wc * 32 + 8 * fq; const int head = c0 / 192, off = c0 - head * 192;
#pragma unroll
            for (int ai = 0; ai < 2; ++ai)
#pragma unroll
                for (int m = 0; m < 4; ++m) { const int row = row0 + ai * HALF + m * 16; bf16_t* rowp = qb + (size_t)row * NQB + head * 192;
                    const f32x4 v0 = acc[ai][bj][m][0], v1 = acc[ai][bj][m][1];
                    if (off < 128) { *(u32x4*)(rowp + off) = pack8s(v0, v1, QSC_B); }
                    else { const int i0 = (off - 128) >> 1; const float* cs = rope + ((size_t)(row & (SEQ - 1)) * 32 + i0) * 2;
                        const f32x4 ca = *(const f32x4*)cs, cb = *(const f32x4*)(cs + 4);
                        const float a0 = v0[0] * ca[0] - v0[1] * ca[1], b0 = v0[0] * ca[1] + v0[1] * ca[0];
                        const float a1 = v0[2] * ca[2] - v0[3] * ca[3], b1 = v0[2] * ca[3] + v0[3] * ca[2];
                        const float a2 = v1[0] * cb[0] - v1[1] * cb[1], b2 = v1[0] * cb[1] + v1[1] * cb[0];
                        const float a3 = v1[2] * cb[2] - v1[3] * cb[3], b3 = v1[2] * cb[3] + v1[3] * cb[2];
                        typedef unsigned u32x2 __attribute__((ext_vector_type(2)));
                        u32x2 w1, w2; w1.x = cvt_pk_bf16(a0 * QSC_B, a1 * QSC_B); w1.y = cvt_pk_bf16(a2 * QSC_B, a3 * QSC_B); w2.x = cvt_pk_bf16(b0 * QSC_B, b1 * QSC_B); w2.y = cvt_pk_bf16(b2 * QSC_B, b3 * QSC_B);
                        *(u32x2*)(rowp + 128 + i0) = w1; *(u32x2*)(rowp + 160 + i0) = w2; } } }
    }
};
struct EpiKV {
    static constexpr bool PERM = true, AFTER_DRAIN = false;
    bf16_t* kn; bf16_t* vb;
    __device__ __forceinline__ void operator()(const f32x4 (&acc)[2][2][4][2], const Unit& u, int wr, int wc, int fr, int fq) const {
        const int row0 = u.pm * BM + wr * 64 + fr, cw = u.pn * 128 + wc * 32 + 8 * fq;
#pragma unroll
        for (int ai = 0; ai < 2; ++ai)
#pragma unroll
            for (int m = 0; m < 4; ++m) { const size_t ro = (size_t)(row0 + ai * HALF + m * 16) * DM + cw;
                *(u32x4*)(kn + ro) = pack8s(acc[ai][0][m][0], acc[ai][0][m][1], 1.f); *(u32x4*)(vb + ro) = pack8s(acc[ai][1][m][0], acc[ai][1][m][1], 1.f); }
    }
};
struct EpiPlain {
    static constexpr bool PERM = true, AFTER_DRAIN = false;
    bf16_t* O; int ldc;
    __device__ __forceinline__ void operator()(const f32x4 (&acc)[2][2][4][2], const Unit& u, int wr, int wc, int fr, int fq) const {
        const int row0 = u.pm * BM + wr * 64 + fr, c0 = u.pn * BM + wc * 32 + 8 * fq;
#pragma unroll
        for (int ai = 0; ai < 2; ++ai)
#pragma unroll
            for (int m = 0; m < 4; ++m) { bf16_t* rowp = O + (size_t)(row0 + ai * HALF + m * 16) * ldc + c0;
#pragma unroll
                for (int bj = 0; bj < 2; ++bj) *(u32x4*)(rowp + bj * HALF) = pack8s(acc[ai][bj][m][0], acc[ai][bj][m][1], 1.f); }
    }
};
__device__ __forceinline__ float sigmoidf_fast(float x) { return __builtin_amdgcn_rcpf(1.f + __builtin_amdgcn_exp2f(-LOG2E * x)); }
struct EpiGate {
    static constexpr bool PERM = true, AFTER_DRAIN = false;
    const bf16_t* ya; const bf16_t* yb; const float* bg; bf16_t* uo;
    __device__ __forceinline__ void operator()(const f32x4 (&acc)[2][2][4][2], const Unit& u, int wr, int wc, int fr, int fq) const {
        const int row0 = u.pm * BM + wr * 64 + fr, cc = u.pn * 128 + wc * 32 + 8 * fq;
        const f32x4 ba0 = *(const f32x4*)(bg + cc), ba1 = *(const f32x4*)(bg + cc + 4), bb0 = *(const f32x4*)(bg + DM + cc), bb1 = *(const f32x4*)(bg + DM + cc + 4);
#pragma unroll
        for (int ai = 0; ai < 2; ++ai)
#pragma unroll
            for (int m = 0; m < 4; ++m) { const size_t ro = (size_t)(row0 + ai * HALF + m * 16) * DM + cc;
                const u32x4 a8 = *(const u32x4*)(ya + ro), b8 = *(const u32x4*)(yb + ro);
                const f32x4 ga0 = acc[ai][0][m][0] + ba0, ga1 = acc[ai][0][m][1] + ba1, gb0 = acc[ai][1][m][0] + bb0, gb1 = acc[ai][1][m][1] + bb1;
                const float ga[8] = {ga0[0], ga0[1], ga0[2], ga0[3], ga1[0], ga1[1], ga1[2], ga1[3]}, gb[8] = {gb0[0], gb0[1], gb0[2], gb0[3], gb1[0], gb1[1], gb1[2], gb1[3]};
                const unsigned aw[4] = {a8.x, a8.y, a8.z, a8.w}, bw[4] = {b8.x, b8.y, b8.z, b8.w};
                float r[8];
#pragma unroll
                for (int j = 0; j < 8; ++j) { const float yav = (j & 1) ? bf_hi(aw[j >> 1]) : bf_lo(aw[j >> 1]), ybv = (j & 1) ? bf_hi(bw[j >> 1]) : bf_lo(bw[j >> 1]);
                    r[j] = sigmoidf_fast(ga[j]) * yav + sigmoidf_fast(gb[j]) * ybv; }
                u32x4 w; w.x = cvt_pk_bf16(r[0], r[1]); w.y = cvt_pk_bf16(r[2], r[3]); w.z = cvt_pk_bf16(r[4], r[5]); w.w = cvt_pk_bf16(r[6], r[7]);
                *(u32x4*)(uo + ro) = w; }
    }
};
struct EpiResid {
    static constexpr bool PERM = false, AFTER_DRAIN = false;
    const float* x; float* r;
    __device__ __forceinline__ void operator()(const f32x4 (&acc)[2][2][4][2], const Unit& u, int wr, int wc, int fr, int fq) const {
        const int row0 = u.pm * BM + wr * 64 + fr, col0 = u.pn * BM + wc * 32 + 4 * fq;
#pragma unroll
        for (int ai = 0; ai < 2; ++ai)
#pragma unroll
            for (int m = 0; m < 4; ++m) { const size_t ro = (size_t)(row0 + ai * HALF + m * 16) * DM + col0;
#pragma unroll
                for (int bj = 0; bj < 2; ++bj)
#pragma unroll
                    for (int n = 0; n < 2; ++n) { const f32x4 xv = *(const f32x4*)(x + ro + bj * HALF + n * 16); *(f32x4*)(r + ro + bj * HALF + n * 16) = xv * ALPHA + acc[ai][bj][m][n]; } }
    }
};
template <class Epi, class Sched, bool STAMP = false>
__device__ __forceinline__ void gemm_phase(PG8_LAS unsigned char* lds, const Gemm g, const Sched& S, const Epi& E, unsigned long long* stamps) {
    const int tid = threadIdx.x, wid = __builtin_amdgcn_readfirstlane(tid >> 6), lane = tid & 63, wr = wid >> 2, wc = wid & 3, fr = lane & 15, fq = lane >> 4;
    const int K = g.K, nt = K / BK;
    int ts_lo = 0, ts_hi = 0, nts = 0; const unsigned long long rt_entry = STAMP ? (unsigned long long)wall_clock64() : 0ull;
#define PG8_STAMP() do { if (STAMP && wid == 0 && nts < 64) { const unsigned long long _c = (unsigned long long)clock64(); \
        ts_lo = (lane == nts) ? (int)(unsigned)_c : ts_lo; ts_hi = (lane == nts) ? (int)(unsigned)(_c >> 32) : ts_hi; ++nts; } } while (0)
    PG8_STAMP();
    unsigned voffA[2], voffB[2];
#pragma unroll
    for (int i = 0; i < 2; ++i) { int R, C; stage_rc(tid * 16 + i * 8192, R, C); const int Rb = Epi::PERM ? ((R & ~31) + perm32(R & 31)) : R;
        voffA[i] = (unsigned)(R * K + C) * 2u; voffB[i] = (unsigned)(Rb * K + C) * 2u; }
    const size_t kstep = (size_t)(BK * 2);
    const size_t hstep = (size_t)HALF * K * 2;
    const size_t tstep = 2 * hstep;
    const unsigned ldsw = (unsigned)wid * 1024u;
    const int aoff = lds_byte(wr * 64 + fr, fq * 8), boff = lds_byte(wc * 32 + fr, fq * 8);
#define PG8_SA(b, h) (((b) * 2 + (h)) * HTB)
#define PG8_SB(b, h) ((4 + (b) * 2 + (h)) * HTB)
#define PG8_STAGE(bufoff, gbase, voff) do { _Pragma("unroll") for (int _i = 0; _i < 2; ++_i) \
        __builtin_amdgcn_global_load_lds((const unsigned*)((const char*)(gbase) + (voff)[_i]), (PG8_LAS unsigned*)(lds + (bufoff) + ldsw + _i * 8192), 16, 0, 0); } while (0)
#define PG8_LDA(dst, b, h) do { _Pragma("unroll") for (int m = 0; m < 4; ++m) _Pragma("unroll") for (int k = 0; k < 2; ++k) dst[m][k] = *(const PG8_LAS bf16x8*)(lds + PG8_SA(b, h) + aoff + m * 2048 + k * 1024); } while (0)
#define PG8_LDB(dst, b, h) do { _Pragma("unroll") for (int n = 0; n < 2; ++n) _Pragma("unroll") for (int k = 0; k < 2; ++k) dst[n][k] = *(const PG8_LAS bf16x8*)(lds + PG8_SB(b, h) + boff + n * 2048 + k * 1024); } while (0)
#define PG8_MMA(ai, bj, At, Bt) do { __builtin_amdgcn_s_setprio(1); _Pragma("unroll") for (int m = 0; m < 4; ++m) _Pragma("unroll") for (int n = 0; n < 2; ++n) _Pragma("unroll") for (int k = 0; k < 2; ++k) \
        acc[ai][bj][m][n] = __builtin_amdgcn_mfma_f32_16x16x32_bf16(Bt[n][k], At[m][k], acc[ai][bj][m][n], 0, 0, 0); __builtin_amdgcn_s_setprio(0); } while (0)
#define PG8_WAIT_V(n) asm volatile("s_waitcnt vmcnt(" #n ")" ::: "memory")
#define PG8_WAIT_L(n) asm volatile("s_waitcnt lgkmcnt(" #n ")" ::: "memory")
#define PG8_BAR __builtin_amdgcn_s_barrier()
#define PG8_SCHED __builtin_amdgcn_sched_barrier(0)
    Unit cur, nxt; int ui = 0;
    if (!S.next(0, cur)) return;
    f32x4 acc[2][2][4][2];
#pragma unroll
    for (int a = 0; a < 2; ++a)
#pragma unroll
        for (int b = 0; b < 2; ++b)
#pragma unroll
            for (int m = 0; m < 4; ++m)
#pragma unroll
                for (int n = 0; n < 2; ++n) acc[a][b][m][n] = (f32x4){0.f, 0.f, 0.f, 0.f};
    bf16x8 At[4][2], B0[2][2], B1[2][2];
    const char* cA = (const char*)g.A + (size_t)cur.pm * tstep; const char* cB = (const char*)g.Bt + (size_t)cur.pn * tstep;
    S.a_ready(cur);
    PG8_STAGE(PG8_SB(0, 0), cB, voffB); PG8_STAGE(PG8_SA(0, 0), cA, voffA); PG8_STAGE(PG8_SB(0, 1), cB + hstep, voffB); PG8_STAGE(PG8_SA(0, 1), cA + hstep, voffA);
    if (wr == 1) PG8_BAR;
    PG8_WAIT_V(4); PG8_BAR;
    PG8_STAGE(PG8_SB(1, 0), cB + kstep, voffB); PG8_STAGE(PG8_SA(1, 0), cA + kstep, voffA); PG8_STAGE(PG8_SB(1, 1), cB + hstep + kstep, voffB);
    PG8_WAIT_V(6); PG8_BAR;
    PG8_STAMP();
    for (;;) {
        const bool has_next = S.next(ui + 1, nxt);
        const char* nA = has_next ? (const char*)g.A + (size_t)nxt.pm * tstep : cA; const char* nB = has_next ? (const char*)g.Bt + (size_t)nxt.pn * tstep : cB;
        for (int t = 0; t < nt; t += 2) {
            const bool last = (t == nt - 2);
            const char* a1 = cA + (size_t)(t + 1) * kstep;
            const char* a2 = last ? nA : cA + (size_t)(t + 2) * kstep; const char* b2 = last ? nB : cB + (size_t)(t + 2) * kstep;
            const char* a3 = a2 + kstep; const char* b3 = b2 + kstep;
            if (last && has_next) S.a_ready(nxt);
            PG8_LDB(B0, 0, 0); PG8_SCHED; PG8_LDA(At, 0, 0); PG8_STAGE(PG8_SA(1, 1), a1 + hstep, voffA);
            PG8_WAIT_L(8); PG8_BAR; PG8_WAIT_L(0); PG8_MMA(0, 0, At, B0); PG8_BAR; PG8_SCHED;
            PG8_LDB(B1, 0, 1); PG8_STAGE(PG8_SB(0, 0), b2, voffB);
            PG8_BAR; PG8_WAIT_L(0); PG8_MMA(0, 1, At, B1); PG8_BAR;
            PG8_LDA(At, 0, 1); PG8_STAGE(PG8_SA(0, 0), a2, voffA);
            PG8_BAR; PG8_WAIT_L(0); PG8_MMA(1, 0, At, B0); PG8_BAR; PG8_SCHED;
            PG8_STAGE(PG8_SB(0, 1), b2 + hstep, voffB);
            PG8_WAIT_V(6); PG8_BAR; PG8_MMA(1, 1, At, B1); PG8_BAR;
            PG8_LDB(B0, 1, 0); PG8_SCHED; PG8_LDA(At, 1, 0); PG8_STAGE(PG8_SA(0, 1), a2 + hstep, voffA);
            PG8_WAIT_L(8); PG8_BAR; PG8_WAIT_L(0); PG8_MMA(0, 0, At, B0); PG8_BAR; PG8_SCHED;
            PG8_LDB(B1, 1, 1); PG8_STAGE(PG8_SB(1, 0), b3, voffB);
            PG8_BAR; PG8_WAIT_L(0); PG8_MMA(0, 1, At, B1); PG8_BAR;
            PG8_LDA(At, 1, 1); PG8_STAGE(PG8_SA(1, 0), a3, voffA);
            PG8_BAR; PG8_WAIT_L(0); PG8_MMA(1, 0, At, B0); PG8_BAR; PG8_SCHED;
            PG8_STAGE(PG8_SB(1, 1), b3 + hstep, voffB);
            PG8_WAIT_V(6); PG8_BAR; PG8_MMA(1, 1, At, B1); PG8_BAR;
        }
        PG8_STAMP();
        if constexpr (!Epi::AFTER_DRAIN) { E(acc, cur, wr, wc, fr, fq); S.done(cur); }
        PG8_STAMP();
        if (!has_next) break;
#pragma unroll
        for (int a = 0; a < 2; ++a)
#pragma unroll
            for (int b = 0; b < 2; ++b)
#pragma unroll
                for (int m = 0; m < 4; ++m)
#pragma unroll
                    for (int n = 0; n < 2; ++n) acc[a][b][m][n] = (f32x4){0.f, 0.f, 0.f, 0.f};
        cur = nxt; cA = nA; cB = nB; ++ui;
    }
    PG8_WAIT_V(0);
    if (wr == 0) PG8_BAR;
    PG8_BAR;
    if constexpr (Epi::AFTER_DRAIN) { E.fused(acc, cur, wr, wc, fr, fq, lds, wid, lane); S.done(cur); }
    PG8_STAMP();
    if (STAMP && wid == 0) { stamps[lane] = lane < nts ? (((unsigned long long)(unsigned)ts_hi << 32) | (unsigned)ts_lo) : 0ull;
        if (lane == 62) stamps[62] = rt_entry; if (lane == 63) stamps[63] = (unsigned long long)wall_clock64(); }
#undef PG8_STAMP
#undef PG8_SA
#undef PG8_SB
#undef PG8_STAGE
#undef PG8_LDA
#undef PG8_LDB
#undef PG8_MMA
#undef PG8_WAIT_V
#undef PG8_WAIT_L
#undef PG8_BAR
#undef PG8_SCHED
}
}

namespace att {
constexpr int SHM_V = 16384, SHM_K = 24576;
constexpr int OFF_V = 0, OFF_K = 2 * SHM_V, OFF_WS = OFF_K + 2 * SHM_K;
constexpr int ATT_LDS = OFF_WS + 8 * 256;
static_assert(ATT_LDS <= RING_BYTES, "attention LDS");
constexpr float THR = 11.5f;
__device__ __forceinline__ int v_st(int k, int c) { const int kk = (k & ~0xC) | ((k & 4) << 1) | ((k & 8) >> 1); return ((kk >> 3) * 4 + (c >> 5)) * 512 + ((kk & 7) * 32 + (c & 31)) * 2; }
__device__ __forceinline__ int v_rd_base(int lane) { return ((lane & 3) << 3) | (((lane >> 2) & 3) << 6) | (((lane >> 4) & 1) << 5) | (((lane >> 5) & 1) << 8); }
constexpr int v_rd_off(int d0, int ks, int half) { return d0 * 512 + ks * 4096 + half * 2048; }
__device__ __forceinline__ int crow(int r, int hi) { return (r & 3) + 8 * (r >> 2) + 4 * hi; }
__device__ __forceinline__ unsigned cvtpk(float lo, float hi) { unsigned r; asm volatile("v_cvt_pk_bf16_f32 %0, %1, %2" : "=v"(r) : "v"(lo), "v"(hi)); return r; }

struct Desc {
    const bf16* Q; long qs;
    const bf16* K; long ks;
    const bf16* K2; long k2s;
    const bf16* V; long vs;
    bf16* O; long os;
    float* LSE; long ls;
    int q0;
    int j_lo, j_hi;
    float sl;
    int first;
};

template <int MODE>
__device__ __forceinline__ void attn_unit(LAS unsigned char* lds, const Desc& a) {
    constexpr int NQ = MODE == 0 ? 12 : 8;
    constexpr unsigned W = MODE == 0 ? 0x7fffffffu : 129u;
    const int tid = threadIdx.x, wid = __builtin_amdgcn_readfirstlane(tid >> 6), lane = tid & 63, r32 = lane & 31, hi = lane >> 5;
    const unsigned ldsb = (unsigned)(uintptr_t)lds;
    LAS float* wsf = (LAS float*)(lds + OFF_WS) + wid * 64; LAS float* li_l = wsf; LAS float* al_l = wsf + 32;
    bf16x8 qr[NQ];
    { const bf16* qrow = a.Q + (long)(wid * 32 + r32) * a.qs + hi * 8;
#pragma unroll
      for (int d0 = 0; d0 < NQ; ++d0) qr[d0] = *(const bf16x8*)(qrow + d0 * 16); }
    float m_reg = -1e30f, l_reg = 0.f; f32x16 o[4];
#pragma unroll
    for (int d = 0; d < 4; ++d) o[d] = f32x16{};
    if (MODE == 1 && !a.first) {
        m_reg = a.LSE[(long)(wid * 32 + r32) * a.ls]; l_reg = 1.f;
#pragma unroll
        for (int r = 0; r < 16; ++r) { const bf16* orow = a.O + (long)(wid * 32 + crow(r, hi)) * a.os + r32;
#pragma unroll
            for (int d = 0; d < 4; ++d) o[d][r] = bf2f(orow[d * 32]); }
    }
    const int sr = tid >> 4, sc = (tid & 15) * 8;
    const int kwsA = sr * 256 + (((tid & 15) ^ (sr & 7)) << 4);
    const int vst0 = v_st(sr, sc), vst1 = v_st(32 + sr, sc);
    const int rb = tid >> 3, cb = tid & 7; const int kwsB = 16384 + rb * 128 + ((cb ^ ((rb >> 1) & 7)) << 4);
    bf16x8 st_k0, st_k1, st_k2, st_v0, st_v1;
#define AT_LOAD(kb_) do { st_v0 = *(const bf16x8*)(a.V + (long)((kb_) + sr) * a.vs + sc); st_v1 = *(const bf16x8*)(a.V + (long)((kb_) + 32 + sr) * a.vs + sc); \
        st_k0 = *(const bf16x8*)(a.K + (long)((kb_) + sr) * a.ks + sc); st_k1 = *(const bf16x8*)(a.K + (long)((kb_) + 32 + sr) * a.ks + sc); \
        if (MODE == 0) st_k2 = *(const bf16x8*)(a.K2 + (long)((kb_) + rb) * a.k2s + cb * 8); } while (0)
#define AT_WRITE(bf) do { *(LAS bf16x8*)(lds + OFF_K + (bf) * SHM_K + kwsA) = st_k0; *(LAS bf16x8*)(lds + OFF_K + (bf) * SHM_K + kwsA + 8192) = st_k1; \
        if (MODE == 0) *(LAS bf16x8*)(lds + OFF_K + (bf) * SHM_K + kwsB) = st_k2; \
        *(LAS bf16x8*)(lds + OFF_V + (bf) * SHM_V + vst0) = st_v0; *(LAS bf16x8*)(lds + OFF_V + (bf) * SHM_V + vst1) = st_v1; } while (0)
    int kbA[4], kbB[4];
#pragma unroll
    for (int dd = 0; dd < 4; ++dd) { kbA[dd] = r32 * 256 + (((2 * dd + hi) ^ (r32 & 7)) << 4); kbB[dd] = 16384 + r32 * 128 + (((2 * dd + hi) ^ ((r32 >> 1) & 7)) << 4); }
    const unsigned vb0 = ldsb + OFF_V + v_rd_base(lane);
    const int qlo = a.q0 + wid * 32;
    const int qm = qlo + r32 - 4 * hi;
    const int NT = a.j_hi - a.j_lo;
    const float NEGINF = -__builtin_inff();

#define TRRD(dst, off) asm volatile("ds_read_b64_tr_b16 %0, %1 offset:%2" : "=&v"(dst) : "v"(vb0), "i"(off) : "memory")
#define PV_D0(VB, d0) do { s16x4 l0, l1, l2, l3, h0, h1, h2, h3; constexpr int b_ = (VB) * SHM_V + v_rd_off(d0, 0, 0); \
        TRRD(l0, b_); TRRD(h0, b_ + 2048); TRRD(l1, b_ + 4096); TRRD(h1, b_ + 6144); TRRD(l2, b_ + 8192); TRRD(h2, b_ + 10240); TRRD(l3, b_ + 12288); TRRD(h3, b_ + 14336); \
        asm volatile("s_waitcnt lgkmcnt(0)" ::: "memory"); SBAR(); \
        o[d0] = __builtin_amdgcn_mfma_f32_32x32x16_bf16(pa0, (bf16x8){l0[0], l0[1], l0[2], l0[3], h0[0], h0[1], h0[2], h0[3]}, o[d0], 0, 0, 0); \
        o[d0] = __builtin_amdgcn_mfma_f32_32x32x16_bf16(pa1, (bf16x8){l1[0], l1[1], l1[2], l1[3], h1[0], h1[1], h1[2], h1[3]}, o[d0], 0, 0, 0); \
        o[d0] = __builtin_amdgcn_mfma_f32_32x32x16_bf16(pa2, (bf16x8){l2[0], l2[1], l2[2], l2[3], h2[0], h2[1], h2[2], h2[3]}, o[d0], 0, 0, 0); \
        o[d0] = __builtin_amdgcn_mfma_f32_32x32x16_bf16(pa3, (bf16x8){l3[0], l3[1], l3[2], l3[3], h3[0], h3[1], h3[2], h3[3]}, o[d0], 0, 0, 0); } while (0)
#define PK4(P, B_, OUT) do { unsigned a0 = cvtpk(P[B_ + 0], P[B_ + 1]), a1 = cvtpk(P[B_ + 2], P[B_ + 3]); \
        unsigned b0 = cvtpk(P[B_ + 4], P[B_ + 5]), b1 = cvtpk(P[B_ + 6], P[B_ + 7]); \
        auto r0 = __builtin_amdgcn_permlane32_swap(a0, b0, false, false); auto r1 = __builtin_amdgcn_permlane32_swap(a1, b1, false, false); \
        v4u w = {r0[0], r1[0], r0[1], r1[1]}; OUT = __builtin_bit_cast(bf16x8, w); } while (0)

#define AT_STEP(t, BUF) do { \
        const int kb = (a.j_lo + (t)) * 64; \
        if ((t) + 1 < NT) AT_LOAD(kb + 64); \
        const bool act = (kb <= qlo + 31) && (MODE == 0 || kb + 63 >= qlo - 128); \
        if (act) { \
            f32x16 p0 = f32x16{}, p1 = f32x16{}; \
            { LAS const unsigned char* Kb = lds + OFF_K + (BUF) * SHM_K; \
              _Pragma("unroll") for (int d0 = 0; d0 < 8; ++d0) { LAS const unsigned char* ap = Kb + kbA[d0 & 3] + (d0 >> 2) * 128; \
                  const bf16x8 b0 = *(LAS const bf16x8*)ap; const bf16x8 b1 = *(LAS const bf16x8*)(ap + 8192); \
                  p0 = __builtin_amdgcn_mfma_f32_32x32x16_bf16(b0, qr[d0], p0, 0, 0, 0); p1 = __builtin_amdgcn_mfma_f32_32x32x16_bf16(b1, qr[d0], p1, 0, 0, 0); } \
              if (MODE == 0) { _Pragma("unroll") for (int e = 0; e < 4; ++e) { LAS const unsigned char* ap = Kb + kbB[e]; \
                  const bf16x8 b0 = *(LAS const bf16x8*)ap; const bf16x8 b1 = *(LAS const bf16x8*)(ap + 4096); \
                  p0 = __builtin_amdgcn_mfma_f32_32x32x16_bf16(b0, qr[NQ - 4 + e], p0, 0, 0, 0); p1 = __builtin_amdgcn_mfma_f32_32x32x16_bf16(b1, qr[NQ - 4 + e], p1, 0, 0, 0); } } } \
            const int dq = qm - kb; \
            if (MODE == 1) { const float nb = -a.sl * (float)dq; \
                _Pragma("unroll") for (int r = 0; r < 16; ++r) { const float c = (float)((r & 3) + 8 * (r >> 2)); p0[r] += __builtin_fmaf(a.sl, c, nb); p1[r] += __builtin_fmaf(a.sl, c + 32.f, nb); } } \
            if ((kb + 63 > qlo) || (MODE == 1 && kb <= qlo + 31 - 129)) { \
                _Pragma("unroll") for (int r = 0; r < 16; ++r) { const int c = (r & 3) + 8 * (r >> 2); \
                    if ((unsigned)(dq - c) >= W) p0[r] = NEGINF; if ((unsigned)(dq - c - 32) >= W) p1[r] = NEGINF; } } \
            float pmax = p0[0]; \
            _Pragma("unroll") for (int r = 1; r < 16; ++r) pmax = fmaxf(pmax, p0[r]); \
            _Pragma("unroll") for (int r = 0; r < 16; ++r) pmax = fmaxf(pmax, p1[r]); \
            { auto rr = __builtin_amdgcn_permlane32_swap(__float_as_uint(pmax), __float_as_uint(pmax), false, false); pmax = fmaxf(__uint_as_float(rr[0]), __uint_as_float(rr[1])); } \
            float alpha = 1.f; \
            if (!__all(pmax - m_reg <= THR)) { const float mn = fmaxf(m_reg, pmax); alpha = __builtin_amdgcn_exp2f(m_reg - mn); m_reg = mn; } \
            if (__any(alpha < 1.f)) { if (hi == 0) al_l[r32] = alpha; LDS_WAIT(); \
                _Pragma("unroll") for (int r = 0; r < 16; ++r) { const float f = al_l[crow(r, hi)]; o[0][r] *= f; o[1][r] *= f; o[2][r] *= f; o[3][r] *= f; } } \
            float ps = 0.f; \
            _Pragma("unroll") for (int r = 0; r < 16; ++r) { p0[r] = __builtin_amdgcn_exp2f(p0[r] - m_reg); ps += p0[r]; } \
            _Pragma("unroll") for (int r = 0; r < 16; ++r) { p1[r] = __builtin_amdgcn_exp2f(p1[r] - m_reg); ps += p1[r]; } \
            { auto rr = __builtin_amdgcn_permlane32_swap(__float_as_uint(ps), __float_as_uint(ps), false, false); ps = __uint_as_float(rr[0]) + __uint_as_float(rr[1]); } \
            l_reg = l_reg * alpha + ps; \
            bf16x8 pa0, pa1, pa2, pa3; PK4(p0, 0, pa0); PK4(p0, 8, pa1); PK4(p1, 0, pa2); PK4(p1, 8, pa3); \
            PV_D0(BUF, 0); PV_D0(BUF, 1); PV_D0(BUF, 2); PV_D0(BUF, 3); \
        } \
        if ((t) + 1 < NT) { VM_WAIT(); AT_WRITE((BUF) ^ 1); } \
        __syncthreads(); } while (0)

    AT_LOAD(a.j_lo * 64); VM_WAIT(); AT_WRITE(0); __syncthreads();
    for (int t = 0; t < NT; t += 2) { AT_STEP(t, 0); if (t + 1 < NT) AT_STEP(t + 1, 1); }

    if (hi == 0) li_l[r32] = l_reg;
    LDS_WAIT();
    if (MODE == 1 && hi == 0) a.LSE[(long)(wid * 32 + r32) * a.ls] = m_reg + __builtin_amdgcn_logf(l_reg);
#pragma unroll
    for (int r = 0; r < 16; ++r) { const int orow = crow(r, hi); const float rl = __builtin_amdgcn_rcpf(li_l[orow]); bf16* op = a.O + (long)(wid * 32 + orow) * a.os + r32;
#pragma unroll
        for (int d = 0; d < 4; ++d) { const float v = o[d][r] * rl; const float vn = __shfl_xor(v, 1);
            if ((r32 & 1) == 0) *(unsigned*)(op + d * 32) = cvtpk(v, vn); } }
    __syncthreads();
#undef AT_LOAD
#undef AT_WRITE
#undef TRRD
#undef PV_D0
#undef PK4
#undef AT_STEP
}
}

template <class RowMap>
__device__ __forceinline__ void transpose_item(const float* W, int ldw, int K, int k0, int nsrc0, bf16* WT, RowMap rm, LAS float* scr, int lane) {
#pragma unroll 8
    for (int i = 0; i < 32; ++i) { const int kk = 2 * i + (lane >> 5); scr[kk * 33 + (lane & 31)] = W[(size_t)(k0 + kk) * ldw + nsrc0 + (lane & 31)]; }
    LDS_WAIT(); asm volatile("" ::: "memory");
    const int c = lane & 7;
#pragma unroll
    for (int j = 0; j < 4; ++j) { const int n = (lane >> 3) + 8 * j; const LAS float* s = scr + (8 * c) * 33 + n;
        v4u o; o.x = pk2(s[0 * 33], s[1 * 33]); o.y = pk2(s[2 * 33], s[3 * 33]); o.z = pk2(s[4 * 33], s[5 * 33]); o.w = pk2(s[6 * 33], s[7 * 33]);
        *(v4u*)(WT + (size_t)rm(nsrc0 + n) * K + k0 + 8 * c) = o; }
    LDS_WAIT(); asm volatile("" ::: "memory");
}
struct RmIdent { __device__ __forceinline__ int operator()(int c) const { return c; } };
struct RmGate { __device__ __forceinline__ int operator()(int c) const { const int cp = c - 7232, half = cp >> 11, cc = cp & 2047; return 256 * (cc >> 7) + 128 * half + (cc & 127); } };
struct RmUq { __device__ __forceinline__ int operator()(int c) const { const int head = c / 192, off = c - head * 192; if (off < 128) return c; const int j = off - 128; return head * 192 + 128 + 2 * (j & 31) + (j >> 5); } };

__device__ __forceinline__ void sincos_d(double x, float& s, float& c) {
    const double TWO_PI = 6.283185307179586476925286766559;
    const double k = __builtin_rint(x / TWO_PI); double r = x - k * TWO_PI;
    const double r2 = r * r; double ss = 1.0, cc = 1.0, ts = 1.0, tc = 1.0;
#pragma unroll
    for (int i = 1; i <= 14; ++i) { tc *= -r2 / (double)((2 * i - 1) * (2 * i)); ts *= -r2 / (double)((2 * i) * (2 * i + 1)); cc += tc; ss += ts; }
    s = (float)(ss * r); c = (float)cc;
}

namespace peer {
__device__ __forceinline__ unsigned ordf(float f) { const unsigned u = __float_as_uint(f); return u ^ ((unsigned)((int)u >> 31) | 0x80000000u); }
__device__ __forceinline__ float unordf(unsigned o) { return __uint_as_float(o ^ ((unsigned)((~(int)o) >> 31) | 0x80000000u)); }
__device__ __forceinline__ void sort16_desc(unsigned (&v)[16]) {
#pragma unroll
    for (int k = 2; k <= 16; k <<= 1)
#pragma unroll
        for (int j = k >> 1; j > 0; j >>= 1)
#pragma unroll
            for (int i = 0; i < 16; ++i) { const int l = i ^ j; if (l > i) { const bool desc = ((i & k) == 0);
                const unsigned hi = v[i] > v[l] ? v[i] : v[l], lo = v[i] > v[l] ? v[l] : v[i]; v[i] = desc ? hi : lo; v[l] = desc ? lo : hi; } }
}
__device__ __forceinline__ void merge16_desc(unsigned (&a)[16], const unsigned (&b)[16]) {
#pragma unroll
    for (int i = 0; i < 16; ++i) a[i] = a[i] > b[15 - i] ? a[i] : b[15 - i];
#pragma unroll
    for (int j = 8; j > 0; j >>= 1)
#pragma unroll
        for (int i = 0; i < 16; ++i) { const int l = i ^ j; if (l > i) { const unsigned hi = a[i] > a[l] ? a[i] : a[l], lo = a[i] > a[l] ? a[l] : a[i]; a[i] = hi; a[l] = lo; } }
}
__device__ __forceinline__ void insert_desc(unsigned (&a)[16], unsigned x) {
#pragma unroll
    for (int i = 0; i < 16; ++i) { const unsigned hi = a[i] > x ? a[i] : x, lo = a[i] > x ? x : a[i]; a[i] = hi; x = lo; }
}
__device__ __forceinline__ void top16_of_128(const f32x16 (&acc)[4], int hi, unsigned (&out)[16]) {
    unsigned g[4][16];
#pragma unroll
    for (int kb = 0; kb < 4; ++kb)
#pragma unroll
        for (int r = 0; r < 16; ++r) { const unsigned base = (unsigned)(kb * 32 + (r & 3) + 8 * (r >> 2)); g[kb][r] = ((ordf(acc[kb][r]) & ~127u) | (127u - base)) ^ (unsigned)(4 * hi); }
    sort16_desc(g[0]); sort16_desc(g[1]); sort16_desc(g[2]); sort16_desc(g[3]);
    merge16_desc(g[0], g[1]); merge16_desc(g[2], g[3]); merge16_desc(g[0], g[2]);
    unsigned pr[16];
#pragma unroll
    for (int i = 0; i < 16; ++i) { auto rr = __builtin_amdgcn_permlane32_swap(g[0][i], g[0][i], false, false); pr[i] = hi ? rr[0] : rr[1]; }
    merge16_desc(g[0], pr);
#pragma unroll
    for (int i = 0; i < 16; ++i) out[i] = g[0][i];
}
__device__ __forceinline__ unsigned ckey(float v, int tag) { return (ordf(v) & ~255u) | (unsigned)(255 - tag); }
}

__device__ __forceinline__ float gelu_erf(float v) {
    const float av = __builtin_fabsf(v), t = __builtin_amdgcn_rcpf(av * 0.2316418882f + 1.0f);
    float q = t * 0.5307027145f + (-0.7265760135f); q = q * t + 0.7107068705f; q = q * t + (-0.142248368f); q = q * t + 0.127414796f; q = q * t;
    const float e = __builtin_amdgcn_exp2f((v * v) * (-0.72134752044f));
    const float m = v * (q * e);
    return v < 0.f ? m : v - m;
}

constexpr int PTBL_OFF = MISC_OFF + 64;
__device__ __forceinline__ void* ldp(LAS unsigned char* lds, int k) { const v2u w = *(LAS const v2u*)(lds + PTBL_OFF + 8 * k);
    const unsigned lo = (unsigned)__builtin_amdgcn_readfirstlane((int)w.x), hi = (unsigned)__builtin_amdgcn_readfirstlane((int)w.y); return (void*)(((unsigned long long)hi << 32) | lo); }
struct Args { const float* in[19]; float* out; unsigned char* ws; int ph_lo, ph_hi; };
__global__ void __launch_bounds__(512, 2) mk_fwd(Args args) {
    extern __shared__ __attribute__((aligned(16))) unsigned char lds_raw[];
    LAS unsigned char* lds = (LAS unsigned char*)lds_raw;
    const int tid = threadIdx.x, lane = tid & 63, wave = __builtin_amdgcn_readfirstlane(tid >> 6);
    const int G = gridDim.x, bx = blockIdx.x;
    const int vcu = (G % 8 == 0) ? (bx % 8) * (G / 8) + bx / 8 : bx;
    const int gw = vcu * 8 + wave, NGW = G * 8;
    unsigned char* ws = args.ws;
#define p_x ((const float*)ldp(lds, 0))
#define p_w_in ((const float*)ldp(lds, 1))
#define p_b_gates ((const float*)ldp(lds, 2))
#define p_a_w_out ((const float*)ldp(lds, 3))
#define p_q_norm ((const float*)ldp(lds, 4))
#define p_w_uq ((const float*)ldp(lds, 5))
#define p_kv_norm ((const float*)ldp(lds, 6))
#define p_w_ukv ((const float*)ldp(lds, 7))
#define p_mla_w_out ((const float*)ldp(lds, 8))
#define p_w_out ((const float*)ldp(lds, 9))
#define p_ln1_g ((const float*)ldp(lds, 10))
#define p_ln1_b ((const float*)ldp(lds, 11))
#define p_w_pq ((const float*)ldp(lds, 12))
#define p_sk1 ((const float*)ldp(lds, 13))
#define p_sk2 ((const float*)ldp(lds, 14))
#define p_e_down ((const float*)ldp(lds, 15))
#define p_e_up ((const float*)ldp(lds, 16))
#define p_ln2_g ((const float*)ldp(lds, 17))
#define p_ln2_b ((const float*)ldp(lds, 18))
#define p_out ((float*)ldp(lds, 19))
#define WA ((bf16*)(ws + WS_WA))
#define WG ((bf16*)(ws + WS_WG))
#define WAO ((bf16*)(ws + WS_WAO))
#define WBO ((bf16*)(ws + WS_WBO))
#define WO ((bf16*)(ws + WS_WO))
#define WPQ ((bf16*)(ws + WS_WPQ))
#define WUQ ((bf16*)(ws + WS_WUQ))
#define WUKV ((bf16*)(ws + WS_WUKV))
#define SK ((bf16*)(ws + WS_SK))
#define ROPE ((float*)(ws + WS_ROPE))
#define XB ((bf16*)(ws + WS_XB))
#define QKV ((bf16*)(ws + WS_QKV))
#define CQKV ((bf16*)(ws + WS_CQKV))
#define KRRAW ((bf16*)(ws + WS_KRRAW))
#define CQN ((bf16*)(ws + WS_CQN))
#define CKVN ((bf16*)(ws + WS_CKVN))
#define KRR ((bf16*)(ws + WS_KRR))
#define LSEB ((float*)(ws + WS_LSE))
#define OA ((bf16*)(ws + WS_OA))
#define QB ((bf16*)(ws + WS_QB))
#define KN ((bf16*)(ws + WS_KN))
#define OB ((bf16*)(ws + WS_OB))
#define VB ((bf16*)(ws + WS_VB))
#define YA ((bf16*)(ws + WS_YA))
#define YB ((bf16*)(ws + WS_YB))
#define UB ((bf16*)(ws + WS_U))
#define RB ((float*)(ws + WS_R))
#define H1B ((bf16*)(ws + WS_H1B))
#define ED ((bf16*)(ws + WS_ED))
#define EU ((bf16*)(ws + WS_EU))
#define PQ ((bf16*)(ws + WS_PQ))
#define IDX ((int*)(ws + WS_IDX))
#define GATE ((float*)(ws + WS_GATE))

    if (tid == 0) {
#define PT(k, p) *(LAS unsigned long long*)(lds + PTBL_OFF + 8 * (k)) = (unsigned long long)(uintptr_t)(p)
        PT(0, args.in[0]); PT(1, args.in[1]); PT(2, args.in[2]); PT(3, args.in[3]); PT(4, args.in[4]); PT(5, args.in[5]); PT(6, args.in[6]); PT(7, args.in[7]); PT(8, args.in[8]); PT(9, args.in[9]);
        PT(10, args.in[10]); PT(11, args.in[11]); PT(12, args.in[12]); PT(13, args.in[13]); PT(14, args.in[14]); PT(15, args.in[15]); PT(16, args.in[16]); PT(17, args.in[17]); PT(18, args.in[18]); PT(19, args.out);
#undef PT
    }
    if (tid < 4) ((LAS unsigned*)(lds + MISC_OFF))[tid] = 0u;
    __syncthreads();
    const int lo = args.ph_lo, hi = args.ph_hi;
    const bool use_bar = (hi - lo) > 1;
    XcdBarrier bar; bar.bar = (unsigned*)(ws + WS_CTL) + CW_BAR; bar.x = 0; bar.st = nullptr;
    if (use_bar) bar = xcd_barrier_post((unsigned*)(ws + WS_CTL) + CW_BAR, (volatile LAS unsigned*)(lds + MISC_OFF));
#ifndef MK_PHASES
#define MK_PHASES 0xFFFFFFFFu
#endif
#define IN(k) ((((MK_PHASES) >> (k)) & 1u) && lo <= (k) && (k) < hi)
#define SEAM(k) do { if (IN(k) && IN((k) + 1)) xcd_barrier(bar); } while (0)

    if (IN(0)) {
        LAS float* scr = (LAS float*)(lds + wave * 16384);
        const float* c_w_in = p_w_in; const float* c_a_w_out = p_a_w_out; const float* c_mla_w_out = p_mla_w_out; const float* c_w_out = p_w_out; const float* c_w_pq = p_w_pq; const float* c_w_uq = p_w_uq; const float* c_w_ukv = p_w_ukv;
        const float* c_x = p_x; const float* c_sk1 = p_sk1; const float* c_sk2 = p_sk2;
        constexpr int I_A = 32 * 226, I_G = 32 * 128, I_SQ = 32 * 64, I_UQ = 8 * 96, I_UKV = 8 * 128;
        constexpr int NITEMS = I_A + I_G + 4 * I_SQ + I_UQ + I_UKV;
        for (int it = gw; it < NITEMS; it += NGW) {
            int r = it;
            if (r < I_A) { transpose_item(c_w_in, IN_W, DM, 64 * (r / 226), 32 * (r % 226), WA, RmIdent(), scr, lane); continue; } r -= I_A;
            if (r < I_G) { transpose_item(c_w_in, IN_W, DM, 64 * (r / 128), 7232 + 32 * (r % 128), WG, RmGate(), scr, lane); continue; } r -= I_G;
            if (r < I_SQ) { transpose_item(c_a_w_out, DM, DM, 64 * (r / 64), 32 * (r % 64), WAO, RmIdent(), scr, lane); continue; } r -= I_SQ;
            if (r < I_SQ) { transpose_item(c_mla_w_out, DM, DM, 64 * (r / 64), 32 * (r % 64), WBO, RmIdent(), scr, lane); continue; } r -= I_SQ;
            if (r < I_SQ) { transpose_item(c_w_out, DM, DM, 64 * (r / 64), 32 * (r % 64), WO, RmIdent(), scr, lane); continue; } r -= I_SQ;
            if (r < I_SQ) { transpose_item(c_w_pq, DM, DM, 64 * (r / 64), 32 * (r % 64), WPQ, RmIdent(), scr, lane); continue; } r -= I_SQ;
            if (r < I_UQ) { transpose_item(c_w_uq, NQB, QL, 64 * (r / 96), 32 * (r % 96), WUQ, RmUq(), scr, lane); continue; } r -= I_UQ;
            transpose_item(c_w_ukv, NKV, QL, 64 * (r / 128), 32 * (r % 128), WUKV, RmIdent(), scr, lane);
        }
        const size_t gt = (size_t)vcu * 512 + tid, NT_ = (size_t)G * 512;
        for (size_t i = gt; i < (size_t)192 * DM / 8; i += NT_) *(v4u*)(WA + (size_t)7232 * DM + i * 8) = (v4u){0u, 0u, 0u, 0u};
        for (size_t i = gt; i < (size_t)T * DM / 8; i += NT_) { const f32x4 a = *(const f32x4*)(c_x + i * 8), b = *(const f32x4*)(c_x + i * 8 + 4);
            *(v4u*)(XB + i * 8) = (v4u){pk2(a[0], a[1]), pk2(a[2], a[3]), pk2(b[0], b[1]), pk2(b[2], b[3])}; }
        for (size_t i = gt; i < 2 * 16384; i += NT_) SK[i] = (bf16)f2bf(i < 16384 ? c_sk1[i] : c_sk2[i - 16384]);
        for (size_t i = gt; i < (size_t)SEQ * 32; i += NT_) { const int pos = (int)(i >> 5), j = (int)(i & 31);
            const float inv = (float)exp2(-(double)j / 32.0 * 13.287712379549449);
            const float ang = (float)pos * inv; float s, c; sincos_d((double)ang, s, c); ROPE[2 * i] = c; ROPE[2 * i + 1] = s; }
    }
    SEAM(0);

    if (IN(1)) {
        pg8::Gemm g{XB, WA, T, NA, DM}; pg8::StaticOrder S; S.init(T, NA, G, bx);
        pg8::EpiA E{QKV, CQKV, KRRAW};
        pg8::gemm_phase<pg8::EpiA, pg8::StaticOrder>(lds, g, S, E, nullptr);
    }
    SEAM(1);

    if (IN(2)) {
        const float* c_q_norm = p_q_norm; const float* c_kv_norm = p_kv_norm;
        for (int t = gw; t < T; t += NGW) {
            const v4u cq = *(const v4u*)(CQKV + (size_t)t * 1024 + lane * 8), ck = *(const v4u*)(CQKV + (size_t)t * 1024 + 512 + lane * 8);
            float fq[8] = {bf_lo(cq.x), bf_hi(cq.x), bf_lo(cq.y), bf_hi(cq.y), bf_lo(cq.z), bf_hi(cq.z), bf_lo(cq.w), bf_hi(cq.w)};
            float fk[8] = {bf_lo(ck.x), bf_hi(ck.x), bf_lo(ck.y), bf_hi(ck.y), bf_lo(ck.z), bf_hi(ck.z), bf_lo(ck.w), bf_hi(ck.w)};
            float sq = 0.f, sk = 0.f;
#pragma unroll
            for (int e = 0; e < 8; ++e) { sq += fq[e] * fq[e]; sk += fk[e] * fk[e]; }
            const float rq = 1.f / sqrtf(wave_sum(sq) * (1.f / 512.f) + RMS_EPS), rk = 1.f / sqrtf(wave_sum(sk) * (1.f / 512.f) + RMS_EPS);
            const f32x4 gq0 = *(const f32x4*)(c_q_norm + lane * 8), gq1 = *(const f32x4*)(c_q_norm + lane * 8 + 4), gk0 = *(const f32x4*)(c_kv_norm + lane * 8), gk1 = *(const f32x4*)(c_kv_norm + lane * 8 + 4);
            *(v4u*)(CQN + (size_t)t * 512 + lane * 8) = (v4u){pk2(fq[0] * rq * gq0[0], fq[1] * rq * gq0[1]), pk2(fq[2] * rq * gq0[2], fq[3] * rq * gq0[3]), pk2(fq[4] * rq * gq1[0], fq[5] * rq * gq1[1]), pk2(fq[6] * rq * gq1[2], fq[7] * rq * gq1[3])};
            *(v4u*)(CKVN + (size_t)t * 512 + lane * 8) = (v4u){pk2(fk[0] * rk * gk0[0], fk[1] * rk * gk0[1]), pk2(fk[2] * rk * gk0[2], fk[3] * rk * gk0[3]), pk2(fk[4] * rk * gk1[0], fk[5] * rk * gk1[1]), pk2(fk[6] * rk * gk1[2], fk[7] * rk * gk1[3])};
            const int i = lane & 31; const float t1 = bf2f(KRRAW[(size_t)t * 64 + i]), t2 = bf2f(KRRAW[(size_t)t * 64 + 32 + i]);
            const f32x2 cs = *(const f32x2*)(ROPE + ((size_t)(t & (SEQ - 1)) * 32 + i) * 2);
            const float o1 = t1 * cs.x - t2 * cs.y, o2 = t1 * cs.y + t2 * cs.x;
            KRR[(size_t)t * 64 + lane] = (bf16)f2bf(lane < 32 ? o1 : o2);
        }
    }

#define DIL_PASS(PH, DIL, LOG2D) \
    if (IN(PH)) { \
        constexpr int nblk = SEQ / (DIL) / 256; \
        for (int u = vcu; u < 2048; u += G) { \
            const int bh = u >> 6, rem = u & 63, rr = rem / nblk, blk = rem % nblk, b = bh >> 4, h = bh & 15; \
            const size_t tok0 = (size_t)b * SEQ + rr, tq0 = tok0 + (size_t)blk * 256 * (DIL); \
            att::Desc d; d.Q = QKV + tq0 * 6144 + h * 128; d.qs = (long)(DIL) * 6144; \
            d.K = QKV + tok0 * 6144 + 2048 + h * 128; d.ks = (long)(DIL) * 6144; d.K2 = nullptr; d.k2s = 0; \
            d.V = QKV + tok0 * 6144 + 4096 + h * 128; d.vs = (long)(DIL) * 6144; \
            d.O = OA + tq0 * DM + h * 128; d.os = (long)(DIL) * DM; d.LSE = LSEB + tq0 * 16 + h; d.ls = (long)(DIL) * 16; \
            d.q0 = blk * 256; d.j_lo = blk == 0 ? 0 : blk * 4 - 2; d.j_hi = blk * 4 + 4; \
            d.sl = __builtin_exp2f(-0.5f * (float)(h + 1)) * (float)(DIL) * LOG2E; d.first = ((PH) == 3); \
            att::attn_unit<1>(lds, d); } }
    DIL_PASS(3, 1, 0)
    SEAM(3);
    DIL_PASS(4, 4, 2)
    SEAM(4);
    DIL_PASS(5, 16, 4)
    SEAM(5);

    if (IN(6)) {
        pg8::Gemm g{CQN, WUQ, T, NQB, QL}; pg8::StaticOrder S; S.init(T, NQB, G, bx);
        pg8::EpiQ E{QB, ROPE};
        pg8::gemm_phase<pg8::EpiQ, pg8::StaticOrder>(lds, g, S, E, nullptr);
    }
    if (IN(7)) {
        pg8::Gemm g{CKVN, WUKV, T, NKV, QL}; pg8::StaticOrder S; S.init(T, NKV, G, bx);
        pg8::EpiKV E{KN, VB};
        pg8::gemm_phase<pg8::EpiKV, pg8::StaticOrder>(lds, g, S, E, nullptr);
    }
    SEAM(7);

    if (IN(8)) {
        for (int it = vcu; it < 1024; it += G) {
            const int bh = it >> 5, y = it & 31, b = bh >> 4, h = bh & 15;
#pragma unroll 1
            for (int s = 0; s < 2; ++s) { const int xb_ = s == 0 ? 63 - y : y;
                att::Desc d; const size_t tb = (size_t)b * SEQ;
                d.Q = QB + (tb + (size_t)xb_ * 256) * NQB + h * 192; d.qs = NQB;
                d.K = KN + tb * DM + h * 128; d.ks = DM; d.K2 = KRR + tb * 64; d.k2s = 64;
                d.V = VB + tb * DM + h * 128; d.vs = DM; d.O = OB + (tb + (size_t)xb_ * 256) * DM + h * 128; d.os = DM; d.LSE = nullptr; d.ls = 0;
                d.q0 = xb_ * 256; d.j_lo = 0; d.j_hi = xb_ * 4 + 4; d.sl = 0.f; d.first = 1;
                att::attn_unit<0>(lds, d); }
        }
    }
    SEAM(8);

    if (IN(9)) {
        pg8::Gemm g{OA, WAO, T, DM, DM}; pg8::StaticOrder S; S.init(T, DM, G, bx);
        pg8::EpiPlain E{YA, DM};
        pg8::gemm_phase<pg8::EpiPlain, pg8::StaticOrder>(lds, g, S, E, nullptr);
    }
    if (IN(10)) {
        pg8::Gemm g{OB, WBO, T, DM, DM}; pg8::StaticOrder S; S.init(T, DM, G, bx);
        pg8::EpiPlain E{YB, DM};
        pg8::gemm_phase<pg8::EpiPlain, pg8::StaticOrder>(lds, g, S, E, nullptr);
    }
    SEAM(10);

    if (IN(11)) {
        pg8::Gemm g{XB, WG, T, NGATE, DM}; pg8::StaticOrder S; S.init(T, NGATE, G, bx);
        pg8::EpiGate E{YA, YB, p_b_gates, UB};
        pg8::gemm_phase<pg8::EpiGate, pg8::StaticOrder>(lds, g, S, E, nullptr);
    }
    SEAM(11);

    if (IN(12)) {
        pg8::Gemm g{UB, WO, T, DM, DM}; pg8::StaticOrder S; S.init(T, DM, G, bx);
        pg8::EpiResid E{p_x, RB};
        pg8::gemm_phase<pg8::EpiResid, pg8::StaticOrder>(lds, g, S, E, nullptr);
    }
    SEAM(12);

    if (IN(13)) {
        const float* c_ln1_g = p_ln1_g; const float* c_ln1_b = p_ln1_b; const float* c_e_down = p_e_down; const float* c_e_up = p_e_up;
        for (int t = gw; t < T; t += NGW) {
            f32x4* rr = (f32x4*)(RB + (size_t)t * DM) + lane; f32x4 v[8]; float s = 0.f;
#pragma unroll
            for (int j = 0; j < 8; ++j) { v[j] = rr[64 * j]; s += (v[j].x + v[j].y) + (v[j].z + v[j].w); }
            const float mean = wave_sum(s) * (1.f / DM); float s2 = 0.f;
#pragma unroll
            for (int j = 0; j < 8; ++j) { v[j] = v[j] - mean; s2 += (v[j].x * v[j].x + v[j].y * v[j].y) + (v[j].z * v[j].z + v[j].w * v[j].w); }
            const float rstd = 1.f / sqrtf(wave_sum(s2) * (1.f / DM) + LN_EPS);
            v2u* hb = (v2u*)(H1B + (size_t)t * DM) + lane;
#pragma unroll
            for (int j = 0; j < 8; ++j) { const f32x4 gg = *((const f32x4*)c_ln1_g + lane + 64 * j), bb = *((const f32x4*)c_ln1_b + lane + 64 * j);
                const f32x4 o = v[j] * rstd * gg + bb; rr[64 * j] = o; hb[64 * j] = (v2u){pk2(o.x, o.y), pk2(o.z, o.w)}; }
        }
        const size_t gt = (size_t)vcu * 512 + tid, NT_ = (size_t)G * 512;
        for (size_t i = gt; i < (size_t)NEXP * DM / 8; i += NT_) {
            const f32x4 a = *(const f32x4*)(c_e_down + i * 8), b = *(const f32x4*)(c_e_down + i * 8 + 4), c = *(const f32x4*)(c_e_up + i * 8), d = *(const f32x4*)(c_e_up + i * 8 + 4);
            *(v4u*)(ED + i * 8) = (v4u){pk2(a[0], a[1]), pk2(a[2], a[3]), pk2(b[0], b[1]), pk2(b[2], b[3])};
            *(v4u*)(EU + i * 8) = (v4u){pk2(c[0], c[1]), pk2(c[2], c[3]), pk2(d[0], d[1]), pk2(d[2], d[3])}; }
    }
    SEAM(13);

    if (IN(14)) {
        pg8::Gemm g{H1B, WPQ, T, DM, DM}; pg8::StaticOrder S; S.init(T, DM, G, bx);
        pg8::EpiPlain E{PQ, DM};
        pg8::gemm_phase<pg8::EpiPlain, pg8::StaticOrder>(lds, g, S, E, nullptr);
    }
    SEAM(14);

    if (IN(15)) {
        for (int c = tid; c < 4096; c += 512) { const int which = c >> 11, row = (c >> 4) & 127, ch = c & 15;
            *(LAS v4u*)(lds + which * 32768 + row * 256 + ((ch ^ (row & 7)) << 4)) = *(const v4u*)(SK + (size_t)which * 16384 + row * 128 + ch * 8); }
        __syncthreads();
        const int r32 = lane & 31, lh = lane >> 5;
        LAS unsigned char* iscr = lds + 65536 + wave * 1024 + r32 * 32;
        for (int task = gw; task < T * PH / 32; task += NGW) {
            const int Rr = task * 32 + r32;
            const bf16* qp = PQ + (size_t)Rr * 256;
            unsigned K1[16], K2[16];
#pragma unroll
            for (int half = 0; half < 2; ++half) {
                bf16x8 qf[8];
#pragma unroll
                for (int ks = 0; ks < 8; ++ks) qf[ks] = *(const bf16x8*)(qp + half * 128 + ks * 16 + lh * 8);
                f32x16 acc[4];
#pragma unroll
                for (int kb = 0; kb < 4; ++kb) { acc[kb] = f32x16{};
#pragma unroll
                    for (int ks = 0; ks < 8; ++ks) { const bf16x8 af = *(LAS const bf16x8*)(lds + half * 32768 + (kb * 32 + r32) * 256 + (((2 * ks + lh) ^ (r32 & 7)) << 4));
                        acc[kb] = __builtin_amdgcn_mfma_f32_32x32x16_bf16(af, qf[ks], acc[kb], 0, 0, 0); } }
                if (half == 0) peer::top16_of_128(acc, lh, K1); else peer::top16_of_128(acc, lh, K2);
            }
            float v1[16], v2[16]; unsigned i1[16], i2[16];
#pragma unroll
            for (int a = 0; a < 16; ++a) { v1[a] = peer::unordf(K1[a] & ~127u); i1[a] = 127u - (K1[a] & 127u); v2[a] = peer::unordf(K2[a] & ~127u); i2[a] = 127u - (K2[a] & 127u); }
            if (lh == 0) {
                *(LAS v4u*)(iscr) = (v4u){i1[0] | (i1[1] << 8) | (i1[2] << 16) | (i1[3] << 24), i1[4] | (i1[5] << 8) | (i1[6] << 16) | (i1[7] << 24), i1[8] | (i1[9] << 8) | (i1[10] << 16) | (i1[11] << 24), i1[12] | (i1[13] << 8) | (i1[14] << 16) | (i1[15] << 24)};
                *(LAS v4u*)(iscr + 16) = (v4u){i2[0] | (i2[1] << 8) | (i2[2] << 16) | (i2[3] << 24), i2[4] | (i2[5] << 8) | (i2[6] << 16) | (i2[7] << 24), i2[8] | (i2[9] << 8) | (i2[10] << 16) | (i2[11] << 24), i2[12] | (i2[13] << 8) | (i2[14] << 16) | (i2[15] << 24)};
            }
            unsigned g0[16], g1[16], g2[16];
#pragma unroll
            for (int b = 0; b < 16; ++b) g0[b] = peer::ckey(v1[0] + v2[b], b);
#pragma unroll
            for (int a = 1; a < 16; ++a) g1[a - 1] = peer::ckey(v1[a] + v2[0], a * 16);
            g1[15] = 0u;
#define CK(a, b) peer::ckey(v1[a] + v2[b], (a) * 16 + (b))
            g2[0] = CK(1, 1); g2[1] = CK(1, 2); g2[2] = CK(1, 3); g2[3] = CK(1, 4); g2[4] = CK(1, 5); g2[5] = CK(1, 6); g2[6] = CK(1, 7);
            g2[7] = CK(2, 1); g2[8] = CK(2, 2); g2[9] = CK(2, 3); g2[10] = CK(2, 4); g2[11] = CK(3, 1); g2[12] = CK(3, 2); g2[13] = CK(3, 3);
            g2[14] = CK(4, 1); g2[15] = CK(4, 2);
            peer::sort16_desc(g2);
            peer::merge16_desc(g0, g1); peer::merge16_desc(g0, g2);
            peer::insert_desc(g0, CK(5, 1)); peer::insert_desc(g0, CK(6, 1)); peer::insert_desc(g0, CK(7, 1));
#undef CK
            LDS_WAIT();
            float sv[16]; int ev[16];
#pragma unroll
            for (int k = 0; k < 16; ++k) { sv[k] = peer::unordf(g0[k] & ~255u); const unsigned tag = 255u - (g0[k] & 255u);
                const unsigned e1 = *(LAS const unsigned char*)(iscr + (tag >> 4)), e2 = *(LAS const unsigned char*)(iscr + 16 + (tag & 15u)); ev[k] = (int)(e1 * 128u + e2); }
            float ex[16], es = 0.f;
#pragma unroll
            for (int k = 0; k < 16; ++k) { ex[k] = __builtin_amdgcn_exp2f((sv[k] - sv[0]) * LOG2E); es += ex[k]; }
            const float inv = 1.f / es;
            if (lh == 0) {
#pragma unroll
                for (int q = 0; q < 4; ++q) *(f32x4*)(GATE + (size_t)Rr * 16 + 4 * q) = (f32x4){ex[4 * q] * inv, ex[4 * q + 1] * inv, ex[4 * q + 2] * inv, ex[4 * q + 3] * inv};
            } else {
#pragma unroll
                for (int q = 0; q < 4; ++q) *(v4i*)(IDX + (size_t)Rr * 16 + 4 * q) = (v4i){ev[4 * q], ev[4 * q + 1], ev[4 * q + 2], ev[4 * q + 3]};
            }
            LDS_WAIT();
        }
    }
    SEAM(15);

    if (IN(16)) {
        const float* c_ln2_g = p_ln2_g; const float* c_ln2_b = p_ln2_b; float* c_out = p_out;
        for (int t = gw; t < T; t += NGW) {
            v4u xv[4];
#pragma unroll
            for (int j = 0; j < 4; ++j) xv[j] = *(const v4u*)(H1B + (size_t)t * DM + 512 * j + 8 * lane);
            const int iv0 = IDX[(size_t)t * 128 + lane], iv1 = IDX[(size_t)t * 128 + 64 + lane];
            const float gv0 = GATE[(size_t)t * 128 + lane], gv1 = GATE[(size_t)t * 128 + 64 + lane];
            float y[32];
#pragma unroll
            for (int i = 0; i < 32; ++i) y[i] = 0.f;
#pragma unroll 1
            for (int k0 = 0; k0 < 128; k0 += 2) {
                v4u dr[2][4], ur[2][4]; float gk[2];
#pragma unroll
                for (int u = 0; u < 2; ++u) { const int k = k0 + u; const int e = __builtin_amdgcn_readlane(k0 < 64 ? iv0 : iv1, k & 63);
                    gk[u] = __builtin_bit_cast(float, __builtin_amdgcn_readlane(__builtin_bit_cast(int, k0 < 64 ? gv0 : gv1), k & 63));
                    const bf16* dp = ED + (size_t)e * DM + 8 * lane; const bf16* up = EU + (size_t)e * DM + 8 * lane;
#pragma unroll
                    for (int j = 0; j < 4; ++j) { dr[u][j] = *(const v4u*)(dp + 512 * j); ur[u][j] = *(const v4u*)(up + 512 * j); } }
#pragma unroll
                for (int u = 0; u < 2; ++u) { float dot = 0.f;
#pragma unroll
                    for (int j = 0; j < 4; ++j) { const unsigned dw[4] = {dr[u][j].x, dr[u][j].y, dr[u][j].z, dr[u][j].w}, xw[4] = {xv[j].x, xv[j].y, xv[j].z, xv[j].w};
#pragma unroll
                        for (int q = 0; q < 4; ++q) { dot = __builtin_fmaf(bf_lo(dw[q]), bf_lo(xw[q]), dot); dot = __builtin_fmaf(bf_hi(dw[q]), bf_hi(xw[q]), dot); } }
                    dot = wave_sum(dot);
                    const float w = gk[u] * gelu_erf(dot);
#pragma unroll
                    for (int j = 0; j < 4; ++j) { const unsigned uw[4] = {ur[u][j].x, ur[u][j].y, ur[u][j].z, ur[u][j].w};
#pragma unroll
                        for (int q = 0; q < 4; ++q) { y[8 * j + 2 * q] = __builtin_fmaf(w, bf_lo(uw[q]), y[8 * j + 2 * q]); y[8 * j + 2 * q + 1] = __builtin_fmaf(w, bf_hi(uw[q]), y[8 * j + 2 * q + 1]); } } }
            }
            float s = 0.f;
#pragma unroll
            for (int j = 0; j < 4; ++j) { const f32x4 h0 = *(const f32x4*)(RB + (size_t)t * DM + 512 * j + 8 * lane), h1v = *(const f32x4*)(RB + (size_t)t * DM + 512 * j + 8 * lane + 4);
#pragma unroll
                for (int e = 0; e < 4; ++e) { y[8 * j + e] += ALPHA * h0[e]; y[8 * j + 4 + e] += ALPHA * h1v[e]; s += y[8 * j + e] + y[8 * j + 4 + e]; } }
            const float mean = wave_sum(s) * (1.f / DM); float s2 = 0.f;
#pragma unroll
            for (int i = 0; i < 32; ++i) { y[i] -= mean; s2 += y[i] * y[i]; }
            const float rstd = 1.f / sqrtf(wave_sum(s2) * (1.f / DM) + LN_EPS);
#pragma unroll
            for (int j = 0; j < 4; ++j) { const int c = 512 * j + 8 * lane;
                const f32x4 g0 = *(const f32x4*)(c_ln2_g + c), g1 = *(const f32x4*)(c_ln2_g + c + 4), b0 = *(const f32x4*)(c_ln2_b + c), b1 = *(const f32x4*)(c_ln2_b + c + 4);
                *(f32x4*)(c_out + (size_t)t * DM + c) = (f32x4){y[8 * j] * rstd * g0[0] + b0[0], y[8 * j + 1] * rstd * g0[1] + b0[1], y[8 * j + 2] * rstd * g0[2] + b0[2], y[8 * j + 3] * rstd * g0[3] + b0[3]};
                *(f32x4*)(c_out + (size_t)t * DM + c + 4) = (f32x4){y[8 * j + 4] * rstd * g1[0] + b1[0], y[8 * j + 5] * rstd * g1[1] + b1[1], y[8 * j + 6] * rstd * g1[2] + b1[2], y[8 * j + 7] * rstd * g1[3] + b1[3]}; }
        }
    }
#undef IN
#undef SEAM
#undef DIL_PASS
#undef p_x
#undef p_w_in
#undef p_b_gates
#undef p_a_w_out
#undef p_q_norm
#undef p_w_uq
#undef p_kv_norm
#undef p_w_ukv
#undef p_mla_w_out
#undef p_w_out
#undef p_ln1_g
#undef p_ln1_b
#undef p_w_pq
#undef p_sk1
#undef p_sk2
#undef p_e_down
#undef p_e_up
#undef p_ln2_g
#undef p_ln2_b
#undef p_out
#undef WA
#undef WG
#undef WAO
#undef WBO
#undef WO
#undef WPQ
#undef WUQ
#undef WUKV
#undef SK
#undef ROPE
#undef XB
#undef QKV
#undef CQKV
#undef KRRAW
#undef CQN
#undef CKVN
#undef KRR
#undef LSEB
#undef OA
#undef QB
#undef KN
#undef OB
#undef VB
#undef YA
#undef YB
#undef UB
#undef RB
#undef H1B
#undef ED
#undef EU
#undef PQ
#undef IDX
#undef GATE
}

extern "C" void kernel_launch(void* const* d_in, const int* in_sizes, int n_in, void* d_out, int out_size, void* d_ws, size_t ws_size, hipStream_t stream) {
    static int grid = 0;
    if (grid == 0) {
        if (n_in != 19 || in_sizes[0] != T * DM || out_size != T * DM || ws_size < WS_END) { fprintf(stderr, "kernel_launch: unexpected shapes (n_in %d, in0 %d, out %d, ws %zu)\n", n_in, n_in > 0 ? in_sizes[0] : -1, out_size, ws_size); grid = -1; return; }
        int dev = 0, cus = 0, per_cu = 0;
        if (hipGetDevice(&dev) != hipSuccess || hipDeviceGetAttribute(&cus, hipDeviceAttributeMultiprocessorCount, dev) != hipSuccess) { grid = -1; return; }
        if (hipFuncSetAttribute((const void*)mk_fwd, hipFuncAttributeMaxDynamicSharedMemorySize, LDS_BYTES) != hipSuccess) { fprintf(stderr, "kernel_launch: hipFuncSetAttribute failed\n"); grid = -1; return; }
        if (hipOccupancyMaxActiveBlocksPerMultiprocessor(&per_cu, (const void*)mk_fwd, 512, LDS_BYTES) != hipSuccess || per_cu < 1) { fprintf(stderr, "kernel_launch: occupancy query says %d blocks per CU\n", per_cu); }
        (void)hipGetLastError();
        grid = cus;
    }
    if (grid < 0) return;
    if (hipMemsetAsync((char*)d_ws + WS_CTL, 0, CTL_ZERO_BYTES, stream) != hipSuccess) return;
    Args a{};
    for (int i = 0; i < 19; ++i) a.in[i] = (const float*)d_in[i];
    a.out = (float*)d_out; a.ws = (unsigned char*)d_ws;
#ifndef MK_N_LAUNCHES
#define MK_N_LAUNCHES 1
#endif
#if MK_N_LAUNCHES == 1
    a.ph_lo = 0; a.ph_hi = NPHASE;
    hipLaunchKernelGGL(mk_fwd, dim3(grid), dim3(512), LDS_BYTES, stream, a);
#else
    for (int p = 0; p < NPHASE; ++p) { a.ph_lo = p; a.ph_hi = p + 1; hipLaunchKernelGGL(mk_fwd, dim3(grid), dim3(512), LDS_BYTES, stream, a); }
#endif
}
```

```cpp
#include <hip/hip_runtime.h>
#include <cstdio>
#include <cstdint>

#define GAS __attribute__((address_space(1)))
#define LAS __attribute__((address_space(3)))
typedef unsigned short bf16;
typedef unsigned v4u __attribute__((ext_vector_type(4)));
typedef unsigned v2u __attribute__((ext_vector_type(2)));
struct v3u { unsigned x, y, z; };
typedef unsigned v6u __attribute__((ext_vector_type(6)));
typedef float v32f __attribute__((ext_vector_type(32)));
typedef float f32x16_t __attribute__((ext_vector_type(16)));
typedef int v4i __attribute__((ext_vector_type(4)));
typedef float f32x4 __attribute__((ext_vector_type(4)));
typedef float f32x2 __attribute__((ext_vector_type(2)));
typedef float f32x16 __attribute__((ext_vector_type(16)));
typedef short bf16x8 __attribute__((ext_vector_type(8)));
typedef short s16x4 __attribute__((ext_vector_type(4)));

constexpr int DM = 2048, BATCH = 2, SEQ = 16384, T = BATCH * SEQ;
constexpr int IN_W = 11328;
constexpr int NA = 7424;
constexpr int NGATE = 4096;
constexpr int NQB = 3072, NKV = 4096, QL = 512;
constexpr int NEXP = 16384, PH = 8, PTOPK = 16;
constexpr float LN_EPS = 1e-5f, RMS_EPS = 1e-6f;
constexpr float ALPHA = 1.189207115002721f;
constexpr float LOG2E = 1.4426950408889634f;
constexpr float QSC_A = 0.08838834764831845f * LOG2E;
constexpr float QSC_B = 0.07216878364870322f * LOG2E;
constexpr int NPHASE = 17;

constexpr size_t MiB = 1u << 20;
constexpr size_t WS_CTL = 0, CTL_ZERO_BYTES = 262144;
constexpr size_t WS_WA = 1 * MiB, WS_WG = 30 * MiB, WS_WAO = 46 * MiB, WS_WBO = 54 * MiB, WS_WO = 62 * MiB, WS_WPQ = 70 * MiB, WS_WUQ = 78 * MiB, WS_WUKV = 81 * MiB;
constexpr size_t WS_SK = 85 * MiB, WS_ROPE = 86 * MiB;
constexpr size_t WS_XB = 96 * MiB, WS_OA8 = 160 * MiB;
constexpr size_t WS_QKV = 224 * MiB, WS_CQKV = 608 * MiB, WS_KRRAW = 672 * MiB, WS_CQN = 676 * MiB, WS_CKVN = 708 * MiB, WS_KRR = 740 * MiB, WS_LSE = 744 * MiB, WS_OA = 746 * MiB;
constexpr size_t WS_QB = 224 * MiB, WS_KN = 416 * MiB, WS_VT = 480 * MiB, WS_OB = 544 * MiB, WS_VB = 874 * MiB;
constexpr size_t WS_YA = 224 * MiB, WS_YB = 352 * MiB, WS_U = 874 * MiB;
constexpr size_t WS_R = 224 * MiB, WS_H1B = 480 * MiB, WS_ED = 608 * MiB, WS_EU = 640 * MiB, WS_SD = 672 * MiB, WS_SU = 672 * MiB + 65536, WS_PQ = 736 * MiB, WS_IDX = 874 * MiB, WS_GATE = 890 * MiB;
constexpr size_t WS_END = 1002 * MiB;
static_assert(WS_WA + (size_t)NA * DM * 2 <= WS_WG && WS_WUKV + (size_t)NKV * QL * 2 <= WS_SK && WS_ROPE + (size_t)SEQ * 64 * 4 <= WS_XB, "weights map");
static_assert(WS_QKV + (size_t)T * 6144 * 2 <= WS_CQKV && WS_OA + (size_t)T * DM * 2 <= WS_VB && WS_VB + (size_t)T * DM * 2 <= WS_END, "activation map");
static_assert(WS_QB + (size_t)T * NQB * 2 <= WS_KN && WS_KN + (size_t)T * DM * 2 <= WS_OB && WS_OB + (size_t)T * DM * 2 <= WS_KRRAW, "mla map");
static_assert(WS_R + (size_t)T * DM * 2 <= WS_H1B && WS_H1B + (size_t)T * DM * 2 <= WS_ED && WS_ED + (size_t)NEXP * 1536 <= WS_EU && WS_EU + (size_t)NEXP * DM <= WS_SD && WS_SU + (size_t)NEXP * 4 <= WS_PQ && WS_PQ + (size_t)T * DM * 2 <= WS_IDX, "peer map");
constexpr int CW_BAR = 1024;

constexpr int RING_BYTES = 131072;
constexpr int MISC_OFF = RING_BYTES;
constexpr int LDS_BYTES = 147456;

#define LDS_WAIT() asm volatile("s_waitcnt lgkmcnt(0)" ::: "memory")
#define VM_WAIT() asm volatile("s_waitcnt vmcnt(0)" ::: "memory")
#define SBAR() __builtin_amdgcn_sched_barrier(0)
__device__ __forceinline__ unsigned f2bf(float f) { unsigned u = __builtin_bit_cast(unsigned, f); return (u + 0x7fffu + ((u >> 16) & 1u)) >> 16; }
__device__ __forceinline__ unsigned pk2(float lo, float hi) { return f2bf(lo) | (f2bf(hi) << 16); }
__device__ __forceinline__ float bf_lo(unsigned w) { return __builtin_bit_cast(float, w << 16); }
__device__ __forceinline__ float bf_hi(unsigned w) { return __builtin_bit_cast(float, w & 0xffff0000u); }
__device__ __forceinline__ float bf2f(bf16 b) { return __builtin_bit_cast(float, ((unsigned)b) << 16); }
__device__ __forceinline__ unsigned pk4_fp8(float a, float b, float c, float d) { int w = __builtin_amdgcn_cvt_pk_fp8_f32(a, b, 0, false); w = __builtin_amdgcn_cvt_pk_fp8_f32(c, d, w, true); return (unsigned)w; }
__device__ __forceinline__ float wave_sum(float v) {
    int x = __builtin_bit_cast(int, v);
#define WS_DPP_ADD(ctrl_, rmask_) do { const int t_ = __builtin_amdgcn_update_dpp(0, x, ctrl_, rmask_, 0xf, false); x = __builtin_bit_cast(int, __builtin_bit_cast(float, x) + __builtin_bit_cast(float, t_)); } while (0)
    WS_DPP_ADD(0xB1, 0xf); WS_DPP_ADD(0x4E, 0xf); WS_DPP_ADD(0x141, 0xf); WS_DPP_ADD(0x140, 0xf); WS_DPP_ADD(0x142, 0xa); WS_DPP_ADD(0x143, 0xc);
#undef WS_DPP_ADD
    return __builtin_bit_cast(float, __builtin_amdgcn_readlane(x, 63));
}

#define XB_TMO      128
#define XB_XCNT(j)  (256  + 64 * (j))
#define XB_XSUB(j)  (1280 + 64 * (j))
#define XB_XGEN(j)  (2304 + 64 * (j))
#define XB_TOP      3328
#define XB_TOPGEN   3392
#define XCD_BAR_WORDS 3456
#define XB_SPIN_CAP (1u << 24)

__device__ __forceinline__ unsigned xb_ld(unsigned* p)              { return __hip_atomic_load(p, __ATOMIC_RELAXED, __HIP_MEMORY_SCOPE_AGENT); }
__device__ __forceinline__ unsigned xb_add(unsigned* p, unsigned v) { return __hip_atomic_fetch_add(p, v, __ATOMIC_RELAXED, __HIP_MEMORY_SCOPE_AGENT); }
__device__ __forceinline__ unsigned xb_xcc_id() { return (unsigned)__builtin_amdgcn_s_getreg((3 << 11) | 20) & 0xFu; }
#define XB_SPIN(cond, bar) do { unsigned _sp = 0; while (cond) { __builtin_amdgcn_s_sleep(1); \
    if ((++_sp & 255u) == 0u) { if (xb_ld(&(bar)[XB_TMO])) break; if (_sp > XB_SPIN_CAP) { atomicAdd(&(bar)[XB_TMO], 1u); break; } } } } while (0)

struct XcdBarrier {
    unsigned* bar; unsigned x;
    volatile LAS unsigned* st;
};

__device__ __forceinline__ XcdBarrier xcd_barrier_post(unsigned* bar, volatile LAS unsigned* st) {
    XcdBarrier b; b.bar = bar; b.x = xb_xcc_id(); b.st = st;
    if (threadIdx.x == 0) (void)xb_add(&bar[XB_XCNT(b.x)], 1u);
    return b;
}
__device__ __forceinline__ void xcd_barrier_complete(unsigned* bar, unsigned x, unsigned& nloc, unsigned& nx) {
    const unsigned G = gridDim.x * gridDim.y * gridDim.z;
    unsigned sum, cnt, mine, sp = 0u;
    for (;;) {
        sum = 0u; cnt = 0u; mine = 0u;
#pragma unroll
        for (unsigned j = 0; j < 16; ++j) { const unsigned c = xb_ld(&bar[XB_XCNT(j)]); sum += c; cnt += (c > 0u) ? 1u : 0u; mine = (j == x) ? c : mine; }
        if (sum == G) break;
        __builtin_amdgcn_s_sleep(1);
        if ((++sp & 255u) == 0u) { if (xb_ld(&bar[XB_TMO])) break; if (sp > XB_SPIN_CAP) { atomicAdd(&bar[XB_TMO], 1u); break; } }
    }
    nloc = mine > 0u ? mine : 1u; nx = cnt > 0u ? cnt : 1u;
}

__device__ __forceinline__ void xcd_barrier(const XcdBarrier& b) {
    asm volatile("s_waitcnt vmcnt(0)" ::: "memory");
    __syncthreads();
    if (threadIdx.x == 0) {
        unsigned* bar = b.bar;
        __builtin_amdgcn_s_waitcnt(0);
        unsigned nloc = b.st[0], nx = b.st[1];
        if (nloc == 0u) { xcd_barrier_complete(bar, b.x, nloc, nx); b.st[0] = nloc; b.st[1] = nx; }
        const unsigned old = xb_add(&bar[XB_XSUB(b.x)], 1u);
        const unsigned gen = old / nloc;
        if (old + 1u == (gen + 1u) * nloc) {
            __builtin_amdgcn_fence(__ATOMIC_RELEASE, "agent");
            asm volatile("s_waitcnt vmcnt(0)" ::: "memory");
            const unsigned og = xb_add(&bar[XB_TOP], 1u);
            const unsigned tg = og / nx;
            if (og + 1u == (tg + 1u) * nx) xb_add(&bar[XB_TOPGEN], 1u);
            else XB_SPIN(xb_ld(&bar[XB_TOPGEN]) == tg, bar);
            __builtin_amdgcn_fence(__ATOMIC_ACQUIRE, "agent");
            xb_add(&bar[XB_XGEN(b.x)], 1u);
            asm volatile("s_waitcnt vmcnt(0)" ::: "memory");
        } else {
            XB_SPIN(xb_ld(&bar[XB_XGEN(b.x)]) == gen, bar);
            __builtin_amdgcn_fence(__ATOMIC_ACQUIRE, "agent");
            asm volatile("s_waitcnt vmcnt(0)" ::: "memory");
        }
    }
    __syncthreads();
}


namespace pg8 {
#define PG8_LAS __attribute__((address_space(3)))
typedef unsigned short bf16_t;
typedef short bf16x8 __attribute__((ext_vector_type(8)));
typedef float f32x4 __attribute__((ext_vector_type(4)));
typedef unsigned u32x4 __attribute__((ext_vector_type(4)));
constexpr int BM = 256, BK = 64, HALF = 128, HTB = HALF * BK * 2  , STAGE_BYTES = 8 * HTB, NXCD = 8, WGM = 4;

__host__ __device__ __forceinline__ int lds_byte(int r, int c) { const int st = (r >> 4) * 2 + (c >> 5), rr = r & 15, cc = c & 31, ob = rr * 64 + cc * 2; return st * 1024 + (ob ^ (((ob >> 9) & 1) << 5)); }
__host__ __device__ __forceinline__ void stage_rc(int b, int& R, int& C) { const int st = b / 1024, sb = b % 1024, swz = sb ^ (((sb >> 9) & 1) << 5); R = (st >> 1) * 16 + swz / 64; C = (st & 1) * 32 + (swz % 64) / 2; }
__host__ __device__ __forceinline__ int perm32(int rho) { const int n = rho >> 4, i = rho & 15; return 8 * (i >> 2) + 4 * n + (i & 3); }

struct Unit { int pm, pn; };
struct Gemm { const bf16_t* A; const bf16_t* Bt; int M, N, K; };

struct StaticOrder {
    int nM, nN, nwg, G, c;
    __host__ __device__ void init(int M, int N, int G_, int c_) { nM = M / BM; nN = N / BM; nwg = nM * nN; G = G_; c = c_; }
    __host__ __device__ bool next(int i, Unit& u) const {
        const long L = (long)i * G + c; if (L >= nwg) return false;
        int wgid = (int)L; { const int q = nwg / NXCD, r = nwg % NXCD, xcd = wgid % NXCD, off = wgid / NXCD; wgid = (xcd < r ? xcd * (q + 1) : r * (q + 1) + (xcd - r) * q) + off; }
        const int nig = WGM * nN, gid = wgid / nig, fm = gid * WGM, gsz = (nM - fm) < WGM ? (nM - fm) : WGM;
        u.pm = fm + ((wgid % nig) % gsz); u.pn = (wgid % nig) / gsz; return true;
    }
    __device__ __forceinline__ void a_ready(const Unit&) const {}
    __device__ __forceinline__ void done(const Unit&) const {}
};
__device__ __forceinline__ unsigned cvt_pk_bf16(float lo, float hi) { unsigned r; asm volatile("v_cvt_pk_bf16_f32 %0, %1, %2" : "=v"(r) : "v"(lo), "v"(hi)); return r; }
typedef float f32x2 __attribute__((ext_vector_type(2)));
__device__ __forceinline__ f32x2 gelu_pk(f32x2 v) {
    const f32x2 av = __builtin_elementwise_abs(v), d = av * 0.2316418882f + 1.0f;
    f32x2 t; t.x = __builtin_amdgcn_rcpf(d.x); t.y = __builtin_amdgcn_rcpf(d.y);
    f32x2 q = t * 0.5307027145f + (-0.7265760135f); q = q * t + 0.7107068705f; q = q * t + (-0.142248368f); q = q * t + 0.127414796f; q = q * t;
    const f32x2 s = (v * v) * (-0.72134752044f);
    f32x2 e; e.x = __builtin_amdgcn_exp2f(s.x); e.y = __builtin_amdgcn_exp2f(s.y);
    const f32x2 m = v * (q * e), r = v - m;
    f32x2 o; o.x = v.x < 0.f ? m.x : r.x; o.y = v.y < 0.f ? m.y : r.y; return o;
}

__device__ __forceinline__ u32x4 pack8s(f32x4 v0, f32x4 v1, float s) { u32x4 w; w.x = cvt_pk_bf16(v0[0] * s, v0[1] * s); w.y = cvt_pk_bf16(v0[2] * s, v0[3] * s); w.z = cvt_pk_bf16(v1[0] * s, v1[1] * s); w.w = cvt_pk_bf16(v1[2] * s, v1[3] * s); return w; }
struct EpiA {
    static constexpr bool PERM = true, AFTER_DRAIN = false;
    bf16_t* qkv; bf16_t* cqkv; bf16_t* krraw; float accs;
    __device__ __forceinline__ void operator()(const f32x4 (&acc)[2][2][4][2], const Unit& u, int wr, int wc, int fr, int fq) const {
        const int row0 = u.pm * BM + wr * 64 + fr, cw = wc * 32 + 8 * fq, pn = u.pn;
        bf16_t* base; int ldc, colt; float sc = accs; bool narrow = false;
        if (pn < 24) { base = qkv; ldc = 6144; colt = pn * 256; if (pn < 8) sc = QSC_A * accs; }
        else if (pn < 28) { base = cqkv; ldc = 1024; colt = (pn - 24) * 256; }
        else { base = krraw; ldc = 64; colt = 0; narrow = true; }
#pragma unroll
        for (int ai = 0; ai < 2; ++ai)
#pragma unroll
            for (int m = 0; m < 4; ++m) { bf16_t* rowp = base + (size_t)(row0 + ai * HALF + m * 16) * ldc + colt + cw;
#pragma unroll
                for (int bj = 0; bj < 2; ++bj) { if (narrow && (bj == 1 || cw >= 64)) continue;
                    *(u32x4*)(rowp + bj * HALF) = pack8s(acc[ai][bj][m][0], acc[ai][bj][m][1], sc); } }
    }
};
struct EpiQ {
    static constexpr bool PERM = true, AFTER_DRAIN = false;
    unsigned char* qb; const float* rope; float qsc;
    __device__ __forceinline__ void operator()(const f32x4 (&acc)[2][2][4][2], const Unit& u, int wr, int wc, int fr, int fq) const {
        const int row0 = u.pm * BM + wr * 64 + fr;
#pragma unroll
        for (int bj = 0; bj < 2; ++bj) { const int c0 = u.pn * BM + bj * HALF + wc * 32 + 8 * fq; const int head = c0 / 192, off = c0 - head * 192;
#pragma unroll
            for (int ai = 0; ai < 2; ++ai)
#pragma unroll
                for (int m = 0; m < 4; ++m) { const int row = row0 + ai * HALF + m * 16; unsigned char* rowp = qb + (size_t)row * NQB + head * 192; typedef unsigned u32x2 __attribute__((ext_vector_type(2)));
                    const f32x4 v0 = acc[ai][bj][m][0], v1 = acc[ai][bj][m][1];
                    if (off < 128) { u32x2 w; w.x = pk4_fp8(v0[0] * qsc, v0[1] * qsc, v0[2] * qsc, v0[3] * qsc); w.y = pk4_fp8(v1[0] * qsc, v1[1] * qsc, v1[2] * qsc, v1[3] * qsc); *(u32x2*)(rowp + off) = w; }
                    else { const int i0 = (off - 128) >> 1; const float* cs = rope + ((size_t)(row & (SEQ - 1)) * 32 + i0) * 2;
                        const f32x4 ca = *(const f32x4*)cs, cb = *(const f32x4*)(cs + 4);
                        const float a0 = v0[0] * ca[0] - v0[1] * ca[1], b0 = v0[0] * ca[1] + v0[1] * ca[0];
                        const float a1 = v0[2] * ca[2] - v0[3] * ca[3], b1 = v0[2] * ca[3] + v0[3] * ca[2];
                        const float a2 = v1[0] * cb[0] - v1[1] * cb[1], b2 = v1[0] * cb[1] + v1[1] * cb[0];
                        const float a3 = v1[2] * cb[2] - v1[3] * cb[3], b3 = v1[2] * cb[3] + v1[3] * cb[2];
                        *(unsigned*)(rowp + 128 + i0) = pk4_fp8(a0 * qsc, a1 * qsc, a2 * qsc, a3 * qsc); *(unsigned*)(rowp + 160 + i0) = pk4_fp8(b0 * qsc, b1 * qsc, b2 * qsc, b3 * qsc); } } }
    }
};
struct EpiKV {
    static constexpr bool PERM = true, AFTER_DRAIN = false;
    unsigned char* kn; unsigned char* vt; PG8_LAS unsigned char* scr; float accs;
    __device__ __forceinline__ void operator()(const f32x4 (&acc)[2][2][4][2], const Unit& u, int wr, int wc, int fr, int fq) const {
        const int row0 = u.pm * BM + wr * 64 + fr, cw = u.pn * 128 + wc * 32 + 8 * fq;
        const int lane = threadIdx.x & 63;
        const int bb = (u.pm * BM) / SEQ, key0 = (u.pm * BM) % SEQ + wr * 64;
        unsigned char* vrow = vt + ((size_t)(bb * 16 + u.pn) * 128 + wc * 32 + (lane >> 1)) * SEQ + key0 + 32 * (lane & 1);
#pragma unroll
        for (int ai = 0; ai < 2; ++ai) {
#pragma unroll
            for (int m = 0; m < 4; ++m) { const size_t ro = (size_t)(row0 + ai * HALF + m * 16) * DM + cw;
                { typedef unsigned u32x2 __attribute__((ext_vector_type(2))); const f32x4 k0 = acc[ai][0][m][0] * accs, k1 = acc[ai][0][m][1] * accs; u32x2 w; w.x = pk4_fp8(k0[0], k0[1], k0[2], k0[3]); w.y = pk4_fp8(k1[0], k1[1], k1[2], k1[3]); *(u32x2*)(kn + ro) = w; } }
#pragma unroll
            for (int mp = 0; mp < 2; ++mp) {
#pragma unroll
                for (int mm = 0; mm < 2; ++mm) { const int k = mm * 16 + fr, lp = 16 * ((k >> 2) & 1) + 4 * ((k >> 3) & 3) + (k & 3);
#pragma unroll
                    for (int n = 0; n < 2; ++n) { const f32x4 v = acc[ai][1][2 * mp + mm][n] * accs; const unsigned w = pk4_fp8(v[0], v[1], v[2], v[3]);
#pragma unroll
                        for (int i = 0; i < 4; ++i) scr[(8 * fq + 4 * n + i) * 48 + lp] = (unsigned char)((w >> (8 * i)) & 0xffu); } }
                const u32x4 piece = *(const PG8_LAS u32x4*)(scr + (lane >> 1) * 48 + 16 * (lane & 1));
                *(u32x4*)(vrow + ai * HALF + 16 * mp) = piece; }
        }
    }
};
struct EpiPlain {
    static constexpr bool PERM = true, AFTER_DRAIN = false;
    bf16_t* O; int ldc; float accs;
    __device__ __forceinline__ void operator()(const f32x4 (&acc)[2][2][4][2], const Unit& u, int wr, int wc, int fr, int fq) const {
        const int row0 = u.pm * BM + wr * 64 + fr, c0 = u.pn * BM + wc * 32 + 8 * fq;
#pragma unroll
        for (int ai = 0; ai < 2; ++ai)
#pragma unroll
            for (int m = 0; m < 4; ++m) { bf16_t* rowp = O + (size_t)(row0 + ai * HALF + m * 16) * ldc + c0;
#pragma unroll
                for (int bj = 0; bj < 2; ++bj) *(u32x4*)(rowp + bj * HALF) = pack8s(acc[ai][bj][m][0], acc[ai][bj][m][1], accs); }
    }
};
struct EpiPlain8 {
    static constexpr bool PERM = true, AFTER_DRAIN = false;
    unsigned char* O; int ldc; float accs;
    __device__ __forceinline__ void operator()(const f32x4 (&acc)[2][2][4][2], const Unit& u, int wr, int wc, int fr, int fq) const {
        const int row0 = u.pm * BM + wr * 64 + fr, c0 = u.pn * BM + wc * 32 + 8 * fq;
        typedef unsigned u32x2 __attribute__((ext_vector_type(2)));
#pragma unroll
        for (int ai = 0; ai < 2; ++ai)
#pragma unroll
            for (int m = 0; m < 4; ++m) { unsigned char* rowp = O + (size_t)(row0 + ai * HALF + m * 16) * ldc + c0;
#pragma unroll
                for (int bj = 0; bj < 2; ++bj) { const f32x4 v0 = acc[ai][bj][m][0] * accs, v1 = acc[ai][bj][m][1] * accs; u32x2 w; w.x = pk4_fp8(v0[0], v0[1], v0[2], v0[3]); w.y = pk4_fp8(v1[0], v1[1], v1[2], v1[3]); *(u32x2*)(rowp + bj * HALF) = w; } }
    }
};
__device__ __forceinline__ float sigmoidf_fast(float x) { return __builtin_amdgcn_rcpf(1.f + __builtin_amdgcn_exp2f(-LOG2E * x)); }
struct EpiGate {
    static constexpr bool PERM = true, AFTER_DRAIN = false;
    const unsigned char* ya; const unsigned char* yb; const float* bg; unsigned char* uo; float accs;
    __device__ __forceinline__ void operator()(const f32x4 (&acc)[2][2][4][2], const Unit& u, int wr, int wc, int fr, int fq) const {
        const int row0 = u.pm * BM + wr * 64 + fr, cc = u.pn * 128 + wc * 32 + 8 * fq;
        const f32x4 ba0 = *(const f32x4*)(bg + cc), ba1 = *(const f32x4*)(bg + cc + 4), bb0 = *(const f32x4*)(bg + DM + cc), bb1 = *(const f32x4*)(bg + DM + cc + 4);
#pragma unroll
        for (int ai = 0; ai < 2; ++ai)
#pragma unroll
            for (int m = 0; m < 4; ++m) { const size_t ro = (size_t)(row0 + ai * HALF + m * 16) * DM + cc;
                typedef unsigned u32x2 __attribute__((ext_vector_type(2))); typedef float f32x2_ __attribute__((ext_vector_type(2)));
                const u32x2 a8 = *(const u32x2*)(ya + ro), b8 = *(const u32x2*)(yb + ro);
                const f32x4 ga0 = acc[ai][0][m][0] * accs + ba0, ga1 = acc[ai][0][m][1] * accs + ba1, gb0 = acc[ai][1][m][0] * accs + bb0, gb1 = acc[ai][1][m][1] * accs + bb1;
                const float ga[8] = {ga0[0], ga0[1], ga0[2], ga0[3], ga1[0], ga1[1], ga1[2], ga1[3]}, gb[8] = {gb0[0], gb0[1], gb0[2], gb0[3], gb1[0], gb1[1], gb1[2], gb1[3]};
                float yav[8], ybv[8];
                { const f32x2_ t0 = __builtin_amdgcn_cvt_pk_f32_fp8((int)a8.x, false), t1 = __builtin_amdgcn_cvt_pk_f32_fp8((int)a8.x, true), t2 = __builtin_amdgcn_cvt_pk_f32_fp8((int)a8.y, false), t3 = __builtin_amdgcn_cvt_pk_f32_fp8((int)a8.y, true);
                  yav[0] = t0[0]; yav[1] = t0[1]; yav[2] = t1[0]; yav[3] = t1[1]; yav[4] = t2[0]; yav[5] = t2[1]; yav[6] = t3[0]; yav[7] = t3[1]; }
                { const f32x2_ t0 = __builtin_amdgcn_cvt_pk_f32_fp8((int)b8.x, false), t1 = __builtin_amdgcn_cvt_pk_f32_fp8((int)b8.x, true), t2 = __builtin_amdgcn_cvt_pk_f32_fp8((int)b8.y, false), t3 = __builtin_amdgcn_cvt_pk_f32_fp8((int)b8.y, true);
                  ybv[0] = t0[0]; ybv[1] = t0[1]; ybv[2] = t1[0]; ybv[3] = t1[1]; ybv[4] = t2[0]; ybv[5] = t2[1]; ybv[6] = t3[0]; ybv[7] = t3[1]; }
                float r[8];
#pragma unroll
                for (int j = 0; j < 8; ++j) r[j] = sigmoidf_fast(ga[j]) * yav[j] + sigmoidf_fast(gb[j]) * ybv[j];
                u32x2 w; w.x = pk4_fp8(r[0], r[1], r[2], r[3]); w.y = pk4_fp8(r[4], r[5], r[6], r[7]);
                *(u32x2*)(uo + ro) = w; }
    }
};
struct EpiResid {
    static constexpr bool PERM = true, AFTER_DRAIN = false;
    const float* x; bf16_t* r; float accs;
    __device__ __forceinline__ void operator()(const f32x4 (&acc)[2][2][4][2], const Unit& u, int wr, int wc, int fr, int fq) const {
        const int row0 = u.pm * BM + wr * 64 + fr, c0 = u.pn * BM + wc * 32 + 8 * fq;
#pragma unroll
        for (int ai = 0; ai < 2; ++ai)
#pragma unroll
            for (int m = 0; m < 4; ++m) { const size_t ro = (size_t)(row0 + ai * HALF + m * 16) * DM + c0;
#pragma unroll
                for (int bj = 0; bj < 2; ++bj) { const f32x4 x0 = *(const f32x4*)(x + ro + bj * HALF), x1 = *(const f32x4*)(x + ro + bj * HALF + 4); const f32x4 a0 = acc[ai][bj][m][0] * accs + x0 * ALPHA, a1 = acc[ai][bj][m][1] * accs + x1 * ALPHA;
                    *(u32x4*)(r + ro + bj * HALF) = pack8s(a0, a1, 1.f); } }
    }
};
template <class Epi, class Sched, bool STAMP = false>
__device__ __forceinline__ void gemm_phase(PG8_LAS unsigned char* lds, const Gemm g, const Sched& S, const Epi& E, unsigned long long* stamps) {
    const int tid = threadIdx.x, wid = __builtin_amdgcn_readfirstlane(tid >> 6), lane = tid & 63, wr = wid >> 2, wc = wid & 3, fr = lane & 15, fq = lane >> 4;
    const int K = g.K, nt = K / BK;
    int ts_lo = 0, ts_hi = 0, nts = 0; const unsigned long long rt_entry = STAMP ? (unsigned long long)wall_clock64() : 0ull;
#define PG8_STAMP() do { if (STAMP && wid == 0 && nts < 64) { const unsigned long long _c = (unsigned long long)clock64(); \
        ts_lo = (lane == nts) ? (int)(unsigned)_c : ts_lo; ts_hi = (lane == nts) ? (int)(unsigned)(_c >> 32) : ts_hi; ++nts; } } while (0)
    PG8_STAMP();
    unsigned voffA[2], voffB[2];
#pragma unroll
    for (int i = 0; i < 2; ++i) { int R, C; stage_rc(tid * 16 + i * 8192, R, C); const int Rb = Epi::PERM ? ((R & ~31) + perm32(R & 31)) : R;
        voffA[i] = (unsigned)(R * K + C) * 2u; voffB[i] = (unsigned)(Rb * K + C) * 2u; }
    const size_t kstep = (size_t)(BK * 2);
    const size_t hstep = (size_t)HALF * K * 2;
    const size_t tstep = 2 * hstep;
    const unsigned ldsw = (unsigned)wid * 1024u;
    const int aoff = lds_byte(wr * 64 + fr, fq * 8), boff = lds_byte(wc * 32 + fr, fq * 8);
#define PG8_SA(b, h) (((b) * 2 + (h)) * HTB)
#define PG8_SB(b, h) ((4 + (b) * 2 + (h)) * HTB)
#define PG8_STAGE(bufoff, gbase, voff) do { _Pragma("unroll") for (int _i = 0; _i < 2; ++_i) \
        __builtin_amdgcn_global_load_lds((const unsigned*)((const char*)(gbase) + (voff)[_i]), (PG8_LAS unsigned*)(lds + (bufoff) + ldsw + _i * 8192), 16, 0, 0); } while (0)
#define PG8_LDA(dst, b, h) do { _Pragma("unroll") for (int m = 0; m < 4; ++m) _Pragma("unroll") for (int k = 0; k < 2; ++k) dst[m][k] = *(const PG8_LAS bf16x8*)(lds + PG8_SA(b, h) + aoff + m * 2048 + k * 1024); } while (0)
#define PG8_LDB(dst, b, h) do { _Pragma("unroll") for (int n = 0; n < 2; ++n) _Pragma("unroll") for (int k = 0; k < 2; ++k) dst[n][k] = *(const PG8_LAS bf16x8*)(lds + PG8_SB(b, h) + boff + n * 2048 + k * 1024); } while (0)
#define PG8_MMA(ai, bj, At, Bt) do { __builtin_amdgcn_s_setprio(1); _Pragma("unroll") for (int m = 0; m < 4; ++m) _Pragma("unroll") for (int n = 0; n < 2; ++n) _Pragma("unroll") for (int k = 0; k < 2; ++k) \
        acc[ai][bj][m][n] = __builtin_amdgcn_mfma_f32_16x16x32_bf16(Bt[n][k], At[m][k], acc[ai][bj][m][n], 0, 0, 0); __builtin_amdgcn_s_setprio(0); } while (0)
#define PG8_WAIT_V(n) asm volatile("s_waitcnt vmcnt(" #n ")" ::: "memory")
#define PG8_WAIT_L(n) asm volatile("s_waitcnt lgkmcnt(" #n ")" ::: "memory")
#define PG8_BAR __builtin_amdgcn_s_barrier()
#define PG8_SCHED __builtin_amdgcn_sched_barrier(0)
    Unit cur, nxt; int ui = 0;
    if (!S.next(0, cur)) return;
    f32x4 acc[2][2][4][2];
#pragma unroll
    for (int a = 0; a < 2; ++a)
#pragma unroll
        for (int b = 0; b < 2; ++b)
#pragma unroll
            for (int m = 0; m < 4; ++m)
#pragma unroll
                for (int n = 0; n < 2; ++n) acc[a][b][m][n] = (f32x4){0.f, 0.f, 0.f, 0.f};
    bf16x8 At[4][2], B0[2][2], B1[2][2];
    const char* cA = (const char*)g.A + (size_t)cur.pm * tstep; const char* cB = (const char*)g.Bt + (size_t)cur.pn * tstep;
    S.a_ready(cur);
    PG8_STAGE(PG8_SB(0, 0), cB, voffB); PG8_STAGE(PG8_SA(0, 0), cA, voffA); PG8_STAGE(PG8_SB(0, 1), cB + hstep, voffB); PG8_STAGE(PG8_SA(0, 1), cA + hstep, voffA);
    if (wr == 1) PG8_BAR;
    PG8_WAIT_V(4); PG8_BAR;
    PG8_STAGE(PG8_SB(1, 0), cB + kstep, voffB); PG8_STAGE(PG8_SA(1, 0), cA + kstep, voffA); PG8_STAGE(PG8_SB(1, 1), cB + hstep + kstep, voffB);
    PG8_WAIT_V(6); PG8_BAR;
    PG8_STAMP();
    for (;;) {
        const bool has_next = S.next(ui + 1, nxt);
        const char* nA = has_next ? (const char*)g.A + (size_t)nxt.pm * tstep : cA; const char* nB = has_next ? (const char*)g.Bt + (size_t)nxt.pn * tstep : cB;
        for (int t = 0; t < nt; t += 2) {
            const bool last = (t == nt - 2);
            const char* a1 = cA + (size_t)(t + 1) * kstep;
            const char* a2 = last ? nA : cA + (size_t)(t + 2) * kstep; const char* b2 = last ? nB : cB + (size_t)(t + 2) * kstep;
            const char* a3 = a2 + kstep; const char* b3 = b2 + kstep;
            if (last && has_next) S.a_ready(nxt);
            PG8_LDB(B0, 0, 0); PG8_SCHED; PG8_LDA(At, 0, 0); PG8_STAGE(PG8_SA(1, 1), a1 + hstep, voffA);
            PG8_WAIT_L(8); PG8_BAR; PG8_WAIT_L(0); PG8_MMA(0, 0, At, B0); PG8_BAR; PG8_SCHED;
            PG8_LDB(B1, 0, 1); PG8_STAGE(PG8_SB(0, 0), b2, voffB);
            PG8_BAR; PG8_WAIT_L(0); PG8_MMA(0, 1, At, B1); PG8_BAR;
            PG8_LDA(At, 0, 1); PG8_STAGE(PG8_SA(0, 0), a2, voffA);
            PG8_BAR; PG8_WAIT_L(0); PG8_MMA(1, 0, At, B0); PG8_BAR; PG8_SCHED;
            PG8_STAGE(PG8_SB(0, 1), b2 + hstep, voffB);
            PG8_WAIT_V(6); PG8_BAR; PG8_MMA(1, 1, At, B1); PG8_BAR;
            PG8_LDB(B0, 1, 0); PG8_SCHED; PG8_LDA(At, 1, 0); PG8_STAGE(PG8_SA(0, 1), a2 + hstep, voffA);
            PG8_WAIT_L(8); PG8_BAR; PG8_WAIT_L(0); PG8_MMA(0, 0, At, B0); PG8_BAR; PG8_SCHED;
            PG8_LDB(B1, 1, 1); PG8_STAGE(PG8_SB(1, 0), b3, voffB);
            PG8_BAR; PG8_WAIT_L(0); PG8_MMA(0, 1, At, B1); PG8_BAR;
            PG8_LDA(At, 1, 1); PG8_STAGE(PG8_SA(1, 0), a3, voffA);
            PG8_BAR; PG8_WAIT_L(0); PG8_MMA(1, 0, At, B0); PG8_BAR; PG8_SCHED;
            PG8_STAGE(PG8_SB(1, 1), b3 + hstep, voffB);
            PG8_WAIT_V(6); PG8_BAR; PG8_MMA(1, 1, At, B1); PG8_BAR;
        }
        PG8_STAMP();
        if constexpr (!Epi::AFTER_DRAIN) { E(acc, cur, wr, wc, fr, fq); S.done(cur); }
        PG8_STAMP();
        if (!has_next) break;
#pragma unroll
        for (int a = 0; a < 2; ++a)
#pragma unroll
            for (int b = 0; b < 2; ++b)
#pragma unroll
                for (int m = 0; m < 4; ++m)
#pragma unroll
                    for (int n = 0; n < 2; ++n) acc[a][b][m][n] = (f32x4){0.f, 0.f, 0.f, 0.f};
        cur = nxt; cA = nA; cB = nB; ++ui;
    }
    PG8_WAIT_V(0);
    if (wr == 0) PG8_BAR;
    PG8_BAR;
    if constexpr (Epi::AFTER_DRAIN) { E.fused(acc, cur, wr, wc, fr, fq, lds, wid, lane); S.done(cur); }
    PG8_STAMP();
    if (STAMP && wid == 0) { stamps[lane] = lane < nts ? (((unsigned long long)(unsigned)ts_hi << 32) | (unsigned)ts_lo) : 0ull;
        if (lane == 62) stamps[62] = rt_entry; if (lane == 63) stamps[63] = (unsigned long long)wall_clock64(); }
#undef PG8_STAMP
#undef PG8_SA
#undef PG8_SB
#undef PG8_STAGE
#undef PG8_LDA
#undef PG8_LDB
#undef PG8_MMA
#undef PG8_WAIT_V
#undef PG8_WAIT_L
#undef PG8_BAR
#undef PG8_SCHED
}
typedef int i32x4 __attribute__((ext_vector_type(4)));
typedef int i32x8 __attribute__((ext_vector_type(8)));
template <class Epi, class Sched, bool STAMP = false>
__device__ __forceinline__ void gemm_phase8(PG8_LAS unsigned char* lds, const Gemm g, const Sched& S, const Epi& E, unsigned long long* stamps) {
    const int tid = threadIdx.x, wid = __builtin_amdgcn_readfirstlane(tid >> 6), lane = tid & 63, wr = wid >> 2, wc = wid & 3, fr = lane & 15, fq = lane >> 4;
    const int K = g.K, nt = K / BK;
    int ts_lo = 0, ts_hi = 0, nts = 0; const unsigned long long rt_entry = STAMP ? (unsigned long long)wall_clock64() : 0ull;
#define PG8_STAMP() do { if (STAMP && wid == 0 && nts < 64) { const unsigned long long _c = (unsigned long long)clock64(); \
        ts_lo = (lane == nts) ? (int)(unsigned)_c : ts_lo; ts_hi = (lane == nts) ? (int)(unsigned)(_c >> 32) : ts_hi; ++nts; } } while (0)
    PG8_STAMP();
    unsigned voffA[2], voffB[2];
#pragma unroll
    for (int i = 0; i < 2; ++i) { int R, C; stage_rc(tid * 16 + i * 8192, R, C); const int Rb = Epi::PERM ? ((R & ~31) + perm32(R & 31)) : R;
        voffA[i] = (unsigned)(R * K + C) * 2u; voffB[i] = (unsigned)(Rb * K + C) * 2u; }
    const size_t kstep = (size_t)(BK * 2);
    const size_t hstep = (size_t)HALF * K * 2;
    const size_t tstep = 2 * hstep;
    const unsigned ldsw = (unsigned)wid * 1024u;
    const int aoff = lds_byte(wr * 64 + fr, fq * 16), boff = lds_byte(wc * 32 + fr, fq * 16);
    const int hsw = (fq & 1) * 16, aofL = aoff + hsw, aofH = aoff + 16 - hsw, bofL = boff + hsw, bofH = boff + 16 - hsw;
#define PG8_SA(b, h) (((b) * 2 + (h)) * HTB)
#define PG8_SB(b, h) ((4 + (b) * 2 + (h)) * HTB)
#define PG8_STAGE(bufoff, gbase, voff) do { _Pragma("unroll") for (int _i = 0; _i < 2; ++_i) \
        __builtin_amdgcn_global_load_lds((const unsigned*)((const char*)(gbase) + (voff)[_i]), (PG8_LAS unsigned*)(lds + (bufoff) + ldsw + _i * 8192), 16, 0, 0); } while (0)
#define PG8_LDA(dst, b, h) do { _Pragma("unroll") for (int m = 0; m < 4; ++m) { const i32x4 lo_ = *(const PG8_LAS i32x4*)(lds + PG8_SA(b, h) + aofL + m * 2048), hi_ = *(const PG8_LAS i32x4*)(lds + PG8_SA(b, h) + aofH + m * 2048); dst[m] = (i32x8){lo_[0], lo_[1], lo_[2], lo_[3], hi_[0], hi_[1], hi_[2], hi_[3]}; } } while (0)
#define PG8_LDB(dst, b, h) do { _Pragma("unroll") for (int n = 0; n < 2; ++n) { const i32x4 lo_ = *(const PG8_LAS i32x4*)(lds + PG8_SB(b, h) + bofL + n * 2048), hi_ = *(const PG8_LAS i32x4*)(lds + PG8_SB(b, h) + bofH + n * 2048); dst[n] = (i32x8){lo_[0], lo_[1], lo_[2], lo_[3], hi_[0], hi_[1], hi_[2], hi_[3]}; } } while (0)
#define PG8_MMA(ai, bj, At, Bt) do { __builtin_amdgcn_s_setprio(1); _Pragma("unroll") for (int m = 0; m < 4; ++m) _Pragma("unroll") for (int n = 0; n < 2; ++n) \
        asm volatile("v_mfma_scale_f32_16x16x128_f8f6f4 %0, %1, %2, %0, %3, %3 op_sel_hi:[0,0,0]" : "+v"(acc[ai][bj][m][n]) : "v"(Bt[n]), "v"(At[m]), "v"(sc1)); __builtin_amdgcn_s_setprio(0); } while (0)
#define PG8_WAIT_V(n) asm volatile("s_waitcnt vmcnt(" #n ")" ::: "memory")
#define PG8_WAIT_L(n) asm volatile("s_waitcnt lgkmcnt(" #n ")" ::: "memory")
#define PG8_BAR __builtin_amdgcn_s_barrier()
#define PG8_SCHED __builtin_amdgcn_sched_barrier(0)
    const int sc1 = 0x7f7f7f7f;
    Unit cur, nxt; int ui = 0;
    if (!S.next(0, cur)) return;
    f32x4 acc[2][2][4][2];
#pragma unroll
    for (int a = 0; a < 2; ++a)
#pragma unroll
        for (int b = 0; b < 2; ++b)
#pragma unroll
            for (int m = 0; m < 4; ++m)
#pragma unroll
                for (int n = 0; n < 2; ++n) acc[a][b][m][n] = (f32x4){0.f, 0.f, 0.f, 0.f};
    i32x8 At[4], B0[2], B1[2];
    const char* cA = (const char*)g.A + (size_t)cur.pm * tstep; const char* cB = (const char*)g.Bt + (size_t)cur.pn * tstep;
    S.a_ready(cur);
    PG8_STAGE(PG8_SB(0, 0), cB, voffB); PG8_STAGE(PG8_SA(0, 0), cA, voffA); PG8_STAGE(PG8_SB(0, 1), cB + hstep, voffB); PG8_STAGE(PG8_SA(0, 1), cA + hstep, voffA);
    if (wr == 1) PG8_BAR;
    PG8_WAIT_V(4); PG8_BAR;
    PG8_STAGE(PG8_SB(1, 0), cB + kstep, voffB); PG8_STAGE(PG8_SA(1, 0), cA + kstep, voffA); PG8_STAGE(PG8_SB(1, 1), cB + hstep + kstep, voffB);
    PG8_WAIT_V(6); PG8_BAR;
    PG8_STAMP();
    for (;;) {
        const bool has_next = S.next(ui + 1, nxt);
        const char* nA = has_next ? (const char*)g.A + (size_t)nxt.pm * tstep : cA; const char* nB = has_next ? (const char*)g.Bt + (size_t)nxt.pn * tstep : cB;
        for (int t = 0; t < nt; t += 2) {
            const bool last = (t == nt - 2);
            const char* a1 = cA + (size_t)(t + 1) * kstep;
            const char* a2 = last ? nA : cA + (size_t)(t + 2) * kstep; const char* b2 = last ? nB : cB + (size_t)(t + 2) * kstep;
            const char* a3 = a2 + kstep; const char* b3 = b2 + kstep;
            if (last && has_next) S.a_ready(nxt);
            PG8_LDB(B0, 0, 0); PG8_SCHED; PG8_LDA(At, 0, 0); PG8_STAGE(PG8_SA(1, 1), a1 + hstep, voffA);
            PG8_WAIT_L(8); PG8_BAR; PG8_WAIT_L(0); PG8_MMA(0, 0, At, B0); PG8_BAR; PG8_SCHED;
            PG8_LDB(B1, 0, 1); PG8_STAGE(PG8_SB(0, 0), b2, voffB);
            PG8_BAR; PG8_WAIT_L(0); PG8_MMA(0, 1, At, B1); PG8_BAR;
            PG8_LDA(At, 0, 1); PG8_STAGE(PG8_SA(0, 0), a2, voffA);
            PG8_BAR; PG8_WAIT_L(0); PG8_MMA(1, 0, At, B0); PG8_BAR; PG8_SCHED;
            PG8_STAGE(PG8_SB(0, 1), b2 + hstep, voffB);
            PG8_WAIT_V(6); PG8_BAR; PG8_MMA(1, 1, At, B1); PG8_BAR;
            PG8_LDB(B0, 1, 0); PG8_SCHED; PG8_LDA(At, 1, 0); PG8_STAGE(PG8_SA(0, 1), a2 + hstep, voffA);
            PG8_WAIT_L(8); PG8_BAR; PG8_WAIT_L(0); PG8_MMA(0, 0, At, B0); PG8_BAR; PG8_SCHED;
            PG8_LDB(B1, 1, 1); PG8_STAGE(PG8_SB(1, 0), b3, voffB);
            PG8_BAR; PG8_WAIT_L(0); PG8_MMA(0, 1, At, B1); PG8_BAR;
            PG8_LDA(At, 1, 1); PG8_STAGE(PG8_SA(1, 0), a3, voffA);
            PG8_BAR; PG8_WAIT_L(0); PG8_MMA(1, 0, At, B0); PG8_BAR; PG8_SCHED;
            PG8_STAGE(PG8_SB(1, 1), b3 + hstep, voffB);
            PG8_WAIT_V(6); PG8_BAR; PG8_MMA(1, 1, At, B1); PG8_BAR;
        }
        PG8_STAMP();
        asm volatile("s_nop 15\n\ts_nop 15" ::: "memory");
        if constexpr (!Epi::AFTER_DRAIN) { E(acc, cur, wr, wc, fr, fq); S.done(cur); }
        PG8_STAMP();
        if (!has_next) break;
#pragma unroll
        for (int a = 0; a < 2; ++a)
#pragma unroll
            for (int b = 0; b < 2; ++b)
#pragma unroll
                for (int m = 0; m < 4; ++m)
#pragma unroll
                    for (int n = 0; n < 2; ++n) acc[a][b][m][n] = (f32x4){0.f, 0.f, 0.f, 0.f};
        cur = nxt; cA = nA; cB = nB; ++ui;
    }
    PG8_WAIT_V(0);
    if (wr == 0) PG8_BAR;
    PG8_BAR;
    if constexpr (Epi::AFTER_DRAIN) { E.fused(acc, cur, wr, wc, fr, fq, lds, wid, lane); S.done(cur); }
    PG8_STAMP();
    if (STAMP && wid == 0) { stamps[lane] = lane < nts ? (((unsigned long long)(unsigned)ts_hi << 32) | (unsigned)ts_lo) : 0ull;
        if (lane == 62) stamps[62] = rt_entry; if (lane == 63) stamps[63] = (unsigned long long)wall_clock64(); }
#undef PG8_STAMP
#undef PG8_SA
#undef PG8_SB
#undef PG8_STAGE
#undef PG8_LDA
#undef PG8_LDB
#undef PG8_MMA
#undef PG8_WAIT_V
#undef PG8_WAIT_L
#undef PG8_BAR
#undef PG8_SCHED
}
}

namespace att {
constexpr int SHM_V = 16384, SHM_K = 24576;
constexpr int OFF_V = 0, OFF_K = 2 * SHM_V, OFF_WS = OFF_K + 2 * SHM_K;
constexpr int ATT_LDS = OFF_WS + 8 * 256;
static_assert(ATT_LDS <= RING_BYTES, "attention LDS");
constexpr float THR = 11.5f;
__device__ __forceinline__ int v_st(int k, int c) { const int kk = (k & ~0xC) | ((k & 4) << 1) | ((k & 8) >> 1); return ((kk >> 3) * 4 + (c >> 5)) * 512 + ((kk & 7) * 32 + (c & 31)) * 2; }
__device__ __forceinline__ int v_rd_base(int lane) { return ((lane & 3) << 3) | (((lane >> 2) & 3) << 6) | (((lane >> 4) & 1) << 5) | (((lane >> 5) & 1) << 8); }
constexpr int v_rd_off(int d0, int ks, int half) { return d0 * 512 + ks * 4096 + half * 2048; }
__device__ __forceinline__ int crow(int r, int hi) { return (r & 3) + 8 * (r >> 2) + 4 * hi; }
__device__ __forceinline__ unsigned cvtpk(float lo, float hi) { unsigned r; asm volatile("v_cvt_pk_bf16_f32 %0, %1, %2" : "=v"(r) : "v"(lo), "v"(hi)); return r; }

struct Desc {
    const bf16* Q; long qs;
    const bf16* K; long ks;
    const bf16* K2; long k2s;
    const bf16* V; long vs;
    bf16* O; long os;
    float* LSE; long ls;
    int q0;
    int j_lo, j_hi;
    float sl;
    int first;
    unsigned char* O8; long o8s;
};

template <int MODE>
__device__ __forceinline__ void attn_prime(LAS unsigned char* lds, const Desc& a, bf16x8 (&qr)[MODE == 0 ? 12 : 8]) {
    constexpr int NQ = MODE == 0 ? 12 : 8;
    const int tid = threadIdx.x, wid = __builtin_amdgcn_readfirstlane(tid >> 6), lane = tid & 63, r32 = lane & 31, hi = lane >> 5;
    { const bf16* qrow = a.Q + (long)(wid * 32 + r32) * a.qs + hi * 8;
#pragma unroll
      for (int d0 = 0; d0 < NQ; ++d0) qr[d0] = *(const bf16x8*)(qrow + d0 * 16); }
#pragma unroll
    for (int r = 0; r < 2; ++r) { const int sidx = r * 512 + wid * 64 + lane; const int row = sidx >> 4, c = (sidx & 15) ^ (row & 15); const int oA = row * (int)a.ks + c * 8;
        const int sub = sidx >> 5, within = sidx & 31, kk = (sub >> 2) * 8 + (within >> 2), kq = (kk & ~0xC) | ((kk & 4) << 1) | ((kk & 8) >> 1), cc = (sub & 3) * 32 + (within & 3) * 8; const int oV = kq * (int)a.vs + cc;
        __builtin_amdgcn_global_load_lds((const unsigned*)(a.K + (long)(a.j_lo * 64) * a.ks + oA), (LAS unsigned*)(lds + OFF_K + r * 8192 + wid * 1024), 16, 0, 0);
        __builtin_amdgcn_global_load_lds((const unsigned*)(a.V + (long)(a.j_lo * 64) * a.vs + oV), (LAS unsigned*)(lds + OFF_V + r * 8192 + wid * 1024), 16, 0, 0); }
}
template <int MODE>
__device__ __forceinline__ void attn_unit(LAS unsigned char* lds, const Desc& a, const Desc& nx, bool has_next, bf16x8 (&qr)[MODE == 0 ? 12 : 8]) {
    constexpr int NQ = MODE == 0 ? 12 : 8;
    constexpr unsigned W = MODE == 0 ? 0x7fffffffu : 129u;
    const int tid = threadIdx.x, wid = __builtin_amdgcn_readfirstlane(tid >> 6), lane = tid & 63, r32 = lane & 31, hi = lane >> 5;
    const unsigned ldsb = (unsigned)(uintptr_t)lds;
    LAS float* wsf = (LAS float*)(lds + OFF_WS) + wid * 64; LAS float* li_l = wsf; LAS float* al_l = wsf + 32;
    float m_reg = -1e30f, l_reg = 0.f; f32x16 o[4];
#pragma unroll
    for (int d = 0; d < 4; ++d) o[d] = f32x16{};
    if (MODE == 1 && !a.first) {
        m_reg = a.LSE[(long)(wid * 32 + r32) * a.ls]; l_reg = 1.f;
#pragma unroll
        for (int r = 0; r < 16; ++r) { const v2u w = *(const v2u*)(a.O + (long)(wid * 32 + crow(r, hi)) * a.os + 4 * r32);
            o[0][r] = bf_lo(w.x); o[1][r] = bf_hi(w.x); o[2][r] = bf_lo(w.y); o[3][r] = bf_hi(w.y); }
    }
    int offA[2], offV[2], offB;
#pragma unroll
    for (int r = 0; r < 2; ++r) { const int sidx = r * 512 + wid * 64 + lane; const int row = sidx >> 4, c = (sidx & 15) ^ (row & 15); offA[r] = row * (int)a.ks + c * 8;
        const int sub = sidx >> 5, within = sidx & 31, kk = (sub >> 2) * 8 + (within >> 2), kq = (kk & ~0xC) | ((kk & 4) << 1) | ((kk & 8) >> 1), cc = (sub & 3) * 32 + (within & 3) * 8; offV[r] = kq * (int)a.vs + cc; }
    { const int sidx = wid * 64 + lane; const int row = sidx >> 3, c = (sidx & 7) ^ ((row >> 1) & 7); offB = row * (int)a.k2s + c * 8; }
#define AT_DMA(kb_, bf) do { \
        _Pragma("unroll") for (int r_ = 0; r_ < 2; ++r_) { \
            __builtin_amdgcn_global_load_lds((const unsigned*)(a.K + (long)(kb_) * a.ks + offA[r_]), (LAS unsigned*)(lds + OFF_K + (bf) * SHM_K + r_ * 8192 + wid * 1024), 16, 0, 0); \
            __builtin_amdgcn_global_load_lds((const unsigned*)(a.V + (long)(kb_) * a.vs + offV[r_]), (LAS unsigned*)(lds + OFF_V + (bf) * SHM_V + r_ * 8192 + wid * 1024), 16, 0, 0); } \
        if (MODE == 0) __builtin_amdgcn_global_load_lds((const unsigned*)(a.K2 + (long)(kb_) * a.k2s + offB), (LAS unsigned*)(lds + OFF_K + (bf) * SHM_K + 16384 + wid * 1024), 16, 0, 0); } while (0)
    int kbA[8], kbB[4];
#pragma unroll
    for (int dd = 0; dd < 8; ++dd) kbA[dd] = r32 * 256 + (((2 * dd + hi) ^ (r32 & 15)) << 4);
#pragma unroll
    for (int dd = 0; dd < 4; ++dd) kbB[dd] = 16384 + r32 * 128 + (((2 * dd + hi) ^ ((r32 >> 1) & 7)) << 4);
    const unsigned vb0 = ldsb + OFF_V + v_rd_base(lane);
    const int qlo = a.q0 + wid * 32;
    const int qm = qlo + r32 - 4 * hi;
    const int NT = a.j_hi - a.j_lo;
    const float NEGINF = -__builtin_inff();
    f32x16 cvec;
#pragma unroll
    for (int r = 0; r < 16; ++r) cvec[r] = MODE == 1 ? a.sl * (float)((r & 3) + 8 * (r >> 2)) : 0.f;

    unsigned kaA[8], kaB[4];
#pragma unroll
    for (int dd = 0; dd < 8; ++dd) kaA[dd] = ldsb + OFF_K + kbA[dd];
#pragma unroll
    for (int dd = 0; dd < 4; ++dd) kaB[dd] = ldsb + OFF_K + kbB[dd];
#define KRD(dst, base, off) asm volatile("ds_read_b128 %0, %1 offset:%2" : "=&v"(dst) : "v"(base), "i"(off) : "memory")
#define KRD2(x0, x1, d0_, BUF) do { if constexpr ((d0_) < 8) { KRD(x0, kaA[(d0_)], (BUF) * SHM_K); KRD(x1, kaA[(d0_)], (BUF) * SHM_K + 8192); } \
        else { KRD(x0, kaB[((d0_) - 8) & 3], (BUF) * SHM_K); KRD(x1, kaB[((d0_) - 8) & 3], (BUF) * SHM_K + 4096); } } while (0)
#define KBATCH(f, bt, BUF) do { KRD2(f[0], f[1], 2 * (bt), BUF); KRD2(f[2], f[3], 2 * (bt) + 1, BUF); } while (0)
#define QK_MMA(f, bt) do { p0 = __builtin_amdgcn_mfma_f32_32x32x16_bf16(f[0], qr[2 * (bt)], p0, 0, 0, 0); p1 = __builtin_amdgcn_mfma_f32_32x32x16_bf16(f[1], qr[2 * (bt)], p1, 0, 0, 0); \
        p0 = __builtin_amdgcn_mfma_f32_32x32x16_bf16(f[2], qr[2 * (bt) + 1], p0, 0, 0, 0); p1 = __builtin_amdgcn_mfma_f32_32x32x16_bf16(f[3], qr[2 * (bt) + 1], p1, 0, 0, 0); } while (0)
#define QK_MMA0(f, c_) do { p0 = __builtin_amdgcn_mfma_f32_32x32x16_bf16(f[0], qr[0], c_, 0, 0, 0); p1 = __builtin_amdgcn_mfma_f32_32x32x16_bf16(f[1], qr[0], c_, 0, 0, 0); \
        p0 = __builtin_amdgcn_mfma_f32_32x32x16_bf16(f[2], qr[1], p0, 0, 0, 0); p1 = __builtin_amdgcn_mfma_f32_32x32x16_bf16(f[3], qr[1], p1, 0, 0, 0); } while (0)
#define MAX3(acc_, x_, y_) asm("v_max3_f32 %0, %0, %1, %2" : "+v"(acc_) : "v"(x_), "v"(y_))
#define ADD1(acc_, x_) asm("v_add_f32 %0, %0, %1" : "+v"(acc_) : "v"(x_))
#define LGK(n) asm volatile("s_waitcnt lgkmcnt(" #n ")" ::: "memory")
#define TRRD(dst, off) asm volatile("ds_read_b64_tr_b16 %0, %1 offset:%2" : "=&v"(dst) : "v"(vb0), "i"(off) : "memory")
#define VRD8(S, VB, d0) do { constexpr int b_ = (VB) * SHM_V + v_rd_off(d0, 0, 0); \
        TRRD(S[0], b_); TRRD(S[1], b_ + 2048); TRRD(S[2], b_ + 4096); TRRD(S[3], b_ + 6144); TRRD(S[4], b_ + 8192); TRRD(S[5], b_ + 10240); TRRD(S[6], b_ + 12288); TRRD(S[7], b_ + 14336); } while (0)
#define PV_MMA(S, d0) do { \
        o[d0] = __builtin_amdgcn_mfma_f32_32x32x16_bf16(pa0, (bf16x8){S[0][0], S[0][1], S[0][2], S[0][3], S[1][0], S[1][1], S[1][2], S[1][3]}, o[d0], 0, 0, 0); \
        o[d0] = __builtin_amdgcn_mfma_f32_32x32x16_bf16(pa1, (bf16x8){S[2][0], S[2][1], S[2][2], S[2][3], S[3][0], S[3][1], S[3][2], S[3][3]}, o[d0], 0, 0, 0); \
        o[d0] = __builtin_amdgcn_mfma_f32_32x32x16_bf16(pa2, (bf16x8){S[4][0], S[4][1], S[4][2], S[4][3], S[5][0], S[5][1], S[5][2], S[5][3]}, o[d0], 0, 0, 0); \
        o[d0] = __builtin_amdgcn_mfma_f32_32x32x16_bf16(pa3, (bf16x8){S[6][0], S[6][1], S[6][2], S[6][3], S[7][0], S[7][1], S[7][2], S[7][3]}, o[d0], 0, 0, 0); } while (0)
#define PK4(P, B_, OUT) do { unsigned a0 = cvtpk(P[B_ + 0], P[B_ + 1]), a1 = cvtpk(P[B_ + 2], P[B_ + 3]); \
        unsigned b0 = cvtpk(P[B_ + 4], P[B_ + 5]), b1 = cvtpk(P[B_ + 6], P[B_ + 7]); \
        auto r0 = __builtin_amdgcn_permlane32_swap(a0, b0, false, false); auto r1 = __builtin_amdgcn_permlane32_swap(a1, b1, false, false); \
        v4u w = {r0[0], r1[0], r0[1], r1[1]}; OUT = __builtin_bit_cast(bf16x8, w); } while (0)

#define AT_STEP(t, BUF) do { \
        const int kb = (a.j_lo + (t)) * 64; \
        if ((t) + 1 < NT) AT_DMA(kb + 64, (BUF) ^ 1); \
        const bool act = (kb <= qlo + 31) && (MODE == 0 || kb + 63 >= qlo - 128); \
        if (act) { \
            f32x16 p0, p1; \
            { bf16x8 fa[4], fb[4]; \
              KBATCH(fa, 0, BUF); KBATCH(fb, 1, BUF); \
              LGK(4); SBAR(); QK_MMA0(fa, cvec); SBAR(); KBATCH(fa, 2, BUF); \
              LGK(4); SBAR(); QK_MMA(fb, 1); SBAR(); KBATCH(fb, 3, BUF); \
              if constexpr (MODE == 0) { \
                  LGK(4); SBAR(); QK_MMA(fa, 2); SBAR(); KBATCH(fa, 4, BUF); \
                  LGK(4); SBAR(); QK_MMA(fb, 3); SBAR(); KBATCH(fb, 5, BUF); \
                  LGK(4); SBAR(); QK_MMA(fa, 4); SBAR(); \
                  LGK(0); SBAR(); QK_MMA(fb, 5); SBAR(); \
              } else { \
                  LGK(4); SBAR(); QK_MMA(fa, 2); SBAR(); \
                  LGK(0); SBAR(); QK_MMA(fb, 3); SBAR(); } } \
            const int dq = qm - kb; \
            const float nb = MODE == 1 ? -a.sl * (float)dq : 0.f, off1 = MODE == 1 ? 32.f * a.sl : 0.f;     \
            if ((kb + 63 > qlo) || (MODE == 1 && kb <= qlo + 31 - 129)) { \
                _Pragma("unroll") for (int r = 0; r < 16; ++r) { const int c = (r & 3) + 8 * (r >> 2); \
                    if ((unsigned)(dq - c) >= W) p0[r] = NEGINF; if ((unsigned)(dq - c - 32) >= W) p1[r] = NEGINF; } } \
            asm volatile("s_nop 15" : "+v"(p0), "+v"(p1));                   \
            float pmax; { float x0 = p0[0], x1 = p0[1], y0 = p1[0], y1 = p1[1]; \
                _Pragma("unroll") for (int r = 2; r < 16; r += 4) { MAX3(x0, p0[r], p0[r + 1]); MAX3(y0, p1[r], p1[r + 1]); } \
                _Pragma("unroll") for (int r = 4; r < 16; r += 4) { MAX3(x1, p0[r], p0[r + 1]); MAX3(y1, p1[r], p1[r + 1]); } \
                pmax = fmaxf(fmaxf(x0, x1), fmaxf(y0, y1) + off1) + nb; } \
            { auto rr = __builtin_amdgcn_permlane32_swap(__float_as_uint(pmax), __float_as_uint(pmax), false, false); pmax = fmaxf(__uint_as_float(rr[0]), __uint_as_float(rr[1])); } \
            float alpha = 1.f; \
            if (!__all(pmax - m_reg <= THR)) { const float mn = fmaxf(m_reg, pmax); alpha = __builtin_amdgcn_exp2f(m_reg - mn); m_reg = mn; } \
            if (__any(alpha < 1.f)) { if (hi == 0) al_l[r32] = alpha; LDS_WAIT(); \
                _Pragma("unroll") for (int r = 0; r < 16; ++r) { const float f = al_l[crow(r, hi)]; o[0][r] *= f; o[1][r] *= f; o[2][r] *= f; o[3][r] *= f; } } \
            float ps; { const float e0 = nb - m_reg, e1 = e0 + off1; float psa[4]; \
                _Pragma("unroll") for (int r = 0; r < 16; ++r) p0[r] = __builtin_amdgcn_exp2f(p0[r] + e0); \
                _Pragma("unroll") for (int r = 0; r < 16; ++r) p1[r] = __builtin_amdgcn_exp2f(p1[r] + e1); \
                asm volatile("s_nop 0" : "+v"(p0), "+v"(p1));            \
                _Pragma("unroll") for (int r = 0; r < 4; ++r) psa[r] = p0[r]; \
                _Pragma("unroll") for (int r = 4; r < 16; ++r) ADD1(psa[r & 3], p0[r]); \
                _Pragma("unroll") for (int r = 0; r < 16; ++r) ADD1(psa[r & 3], p1[r]); \
                ADD1(psa[0], psa[1]); ADD1(psa[2], psa[3]); ADD1(psa[0], psa[2]); ps = psa[0]; } \
            { auto rr = __builtin_amdgcn_permlane32_swap(__float_as_uint(ps), __float_as_uint(ps), false, false); ps = __uint_as_float(rr[0]) + __uint_as_float(rr[1]); } \
            l_reg = l_reg * alpha + ps; \
            bf16x8 pa0, pa1, pa2, pa3; PK4(p0, 0, pa0); PK4(p0, 8, pa1); PK4(p1, 0, pa2); PK4(p1, 8, pa3); \
            { s16x4 va[8], vb_[8]; \
              VRD8(va, BUF, 0); VRD8(vb_, BUF, 1); \
              LGK(8); SBAR(); PV_MMA(va, 0); SBAR(); VRD8(va, BUF, 2); \
              LGK(8); SBAR(); PV_MMA(vb_, 1); SBAR(); VRD8(vb_, BUF, 3); \
              LGK(8); SBAR(); PV_MMA(va, 2); SBAR(); \
              LGK(0); SBAR(); PV_MMA(vb_, 3); SBAR(); } \
        } \
        VM_WAIT(); __syncthreads(); } while (0)

    VM_WAIT(); __syncthreads();
    for (int t = 0; t < NT; t += 2) { AT_STEP(t, 0); if (t + 1 < NT) AT_STEP(t + 1, 1); }

    if (has_next) {
        { const bf16* qrow = nx.Q + (long)(wid * 32 + r32) * nx.qs + hi * 8;
#pragma unroll
          for (int d0 = 0; d0 < NQ; ++d0) qr[d0] = *(const bf16x8*)(qrow + d0 * 16); }
#pragma unroll
        for (int r_ = 0; r_ < 2; ++r_) {
            __builtin_amdgcn_global_load_lds((const unsigned*)(nx.K + (long)(nx.j_lo * 64) * nx.ks + offA[r_]), (LAS unsigned*)(lds + OFF_K + r_ * 8192 + wid * 1024), 16, 0, 0);
            __builtin_amdgcn_global_load_lds((const unsigned*)(nx.V + (long)(nx.j_lo * 64) * nx.vs + offV[r_]), (LAS unsigned*)(lds + OFF_V + r_ * 8192 + wid * 1024), 16, 0, 0); }
        SBAR(); }
    if (hi == 0) li_l[r32] = l_reg;
    LDS_WAIT();
    if (MODE == 1 && !a.O8 && hi == 0) a.LSE[(long)(wid * 32 + r32) * a.ls] = m_reg + __builtin_amdgcn_logf(l_reg);
    if (a.O8) {
#pragma unroll
        for (int r = 0; r < 16; ++r) { const int orow = crow(r, hi); const float rl = 64.f * __builtin_amdgcn_rcpf(li_l[orow]);
            *(unsigned*)(a.O8 + (long)(wid * 32 + orow) * a.o8s + 4 * r32) = pk4_fp8(o[0][r] * rl, o[1][r] * rl, o[2][r] * rl, o[3][r] * rl); }
    } else {
#pragma unroll
        for (int r = 0; r < 16; ++r) { const int orow = crow(r, hi); const float rl = __builtin_amdgcn_rcpf(li_l[orow]);
            *(v2u*)(a.O + (long)(wid * 32 + orow) * a.os + 4 * r32) = (v2u){cvtpk(o[0][r] * rl, o[1][r] * rl), cvtpk(o[2][r] * rl, o[3][r] * rl)}; }
    }
    asm volatile("s_waitcnt lgkmcnt(0)\n\ts_barrier" ::: "memory");
#undef AT_DMA
#undef TRRD
#undef KRD
#undef KRD2
#undef KBATCH
#undef QK_MMA
#undef LGK
#undef VRD8
#undef PV_MMA
#undef PK4
#undef AT_STEP
#undef QK_MMA0
#undef MAX3
#undef ADD1
}
}

namespace att8 {
typedef int i32x8 __attribute__((ext_vector_type(8)));
typedef int i32x4 __attribute__((ext_vector_type(4)));
constexpr int SHM_V = 8192, SHM_K = 12288;
constexpr int OFF_V = 0, OFF_K = 4 * SHM_V, OFF_WS = OFF_K + 3 * SHM_K;
constexpr float THR = 4.f;
constexpr float QPRE = 8.f;
__device__ __forceinline__ int pk4u_fp8(float a, float b, float c, float d) { int w; asm volatile("" : "=v"(w)); w = __builtin_amdgcn_cvt_pk_fp8_f32(a, b, w, false); return __builtin_amdgcn_cvt_pk_fp8_f32(c, d, w, true); }
#define PK4U(a_, b_, c_, d_) pk4u_fp8(a_, b_, c_, d_)
__device__ __forceinline__ int crow8(int r, int hi) { return (r & 3) + 8 * (r >> 2) + 4 * hi; }
__host__ __device__ __forceinline__ int vperm(int key) { return 32 * ((key >> 2) & 1) + 4 * (((key >> 3) & 3) + 4 * (key >> 5)) + (key & 3); }

struct Desc {
    const unsigned char* Q; long qs;
    const unsigned char* K; long ks;
    const unsigned char* K2; long k2s;
    const unsigned char* VT; long vts;
    unsigned char* O8; long o8s;
    int q0, j_hi;
    int trail;
};

__device__ __forceinline__ void attn_unit(LAS unsigned char* lds, const Desc& a) {
    const int tid = threadIdx.x, wid = __builtin_amdgcn_readfirstlane(tid >> 6), lane = tid & 63, r32 = lane & 31, hi = lane >> 5;
    const unsigned ldsb = (unsigned)(uintptr_t)lds;
    LAS float* wsf = (LAS float*)(lds + OFF_WS) + wid * 64; LAS float* li_l = wsf; LAS float* al_l = wsf + 32;
    const int sc1 = 0x7f7f7f7f, scq = 0x7c7c7c7c;
    i32x8 qf[3];
    { const unsigned char* qrow = a.Q + (long)(wid * 32 + r32) * a.qs + 32 * hi;
#pragma unroll
      for (int s = 0; s < 3; ++s) { const i32x4 lo_ = *(const i32x4*)(qrow + 64 * s), hi_ = *(const i32x4*)(qrow + 64 * s + 16); qf[s] = (i32x8){lo_[0], lo_[1], lo_[2], lo_[3], hi_[0], hi_[1], hi_[2], hi_[3]}; } }
    float m_reg = -1e30f, l_reg = 0.f; f32x16 o[4];
#pragma unroll
    for (int d = 0; d < 4; ++d) o[d] = f32x16{};
    int offA, offB, offV;
    { const int sidx = wid * 64 + lane; { const int row = sidx >> 3, c = (sidx & 7) ^ ((row >> 1) & 7); offA = row * (int)a.ks + 16 * c; }
      { const int row = (sidx & 255) >> 2, c = (sidx & 3) ^ ((row >> 2) & 3); offB = row * (int)a.k2s + 16 * c; }
      { const int d = sidx >> 2, c = (sidx & 3) ^ ((d >> 2) & 3); offV = d * (int)a.vts + 16 * c; } }
#define A8_DMA(kb_, bf, vs_) do { \
        __builtin_amdgcn_global_load_lds((const unsigned*)(a.K + (long)(kb_) * a.ks + offA), (LAS unsigned*)(lds + OFF_K + (bf) * SHM_K + wid * 1024), 16, 0, 0); \
        __builtin_amdgcn_global_load_lds((const unsigned*)(a.VT + (kb_) + offV), (LAS unsigned*)(lds + OFF_V + (vs_) * SHM_V + wid * 1024), 16, 0, 0); \
        if (wid < 4) __builtin_amdgcn_global_load_lds((const unsigned*)(a.K2 + (long)(kb_) * a.k2s + offB), (LAS unsigned*)(lds + OFF_K + (bf) * SHM_K + 8192 + wid * 1024), 16, 0, 0); } while (0)
    unsigned kaA[2][2], kaB[2], va[2];
#pragma unroll
    for (int e = 0; e < 2; ++e) {
#pragma unroll
        for (int s = 0; s < 2; ++s) kaA[s][e] = ldsb + OFF_K + r32 * 128 + (((4 * s + 2 * hi + e) ^ ((r32 >> 1) & 7)) << 4);
        kaB[e] = ldsb + OFF_K + 8192 + r32 * 64 + (((2 * hi + e) ^ ((r32 >> 2) & 3)) << 4);
        va[e] = ldsb + OFF_V + r32 * 64 + (((2 * hi + e) ^ ((r32 >> 2) & 3)) << 4); }
    const int qlo = a.q0 + wid * 32, qm = qlo + r32 - 4 * hi, NT = a.j_hi;
    const float NEGINF = -__builtin_inff();
#define RD16(dst, base, off) asm volatile("ds_read_b128 %0, %1 offset:%2" : "=&v"(dst) : "v"(base), "i"(off) : "memory")
#define LGK(n) asm volatile("s_waitcnt lgkmcnt(" #n ")" ::: "memory")
#define MMA8(acc_, a_, b_) asm volatile("s_nop 1\n\tv_mfma_scale_f32_32x32x64_f8f6f4 %0, %1, %2, %0, %3, %3 op_sel_hi:[0,0,0]" : "+v"(acc_) : "v"(a_), "v"(b_), "v"(sc1))
#define MMA8Z(acc_, a_, b_) asm volatile("s_nop 1\n\tv_mfma_scale_f32_32x32x64_f8f6f4 %0, %1, %2, 0, %3, %3 op_sel_hi:[0,0,0]" : "=&v"(acc_) : "v"(a_), "v"(b_), "v"(sc1))
#define MMAQ(acc_, a_, b_) asm volatile("s_nop 1\n\tv_mfma_scale_f32_32x32x64_f8f6f4 %0, %1, %2, %0, %3, %4 op_sel_hi:[0,0,0]" : "+v"(acc_) : "v"(a_), "v"(b_), "v"(sc1), "v"(scq))
#define MMAQZ(acc_, a_, b_) asm volatile("s_nop 1\n\tv_mfma_scale_f32_32x32x64_f8f6f4 %0, %1, %2, 0, %3, %4 op_sel_hi:[0,0,0]" : "=&v"(acc_) : "v"(a_), "v"(b_), "v"(sc1), "v"(scq))
#define MMAQC(acc_, a_, b_, c_) asm volatile("s_nop 1\n\tv_mfma_scale_f32_32x32x64_f8f6f4 %0, %1, %2, %3, %4, %5 op_sel_hi:[0,0,0]" : "=&v"(acc_) : "v"(a_), "v"(b_), "v"(c_), "v"(sc1), "v"(scq))
#define MK8(x_, l_, h_) x_ = (i32x8){l_[0], l_[1], l_[2], l_[3], h_[0], h_[1], h_[2], h_[3]}
#define KRD(s_, BUF, l0, h0, l1, h1) do { if constexpr ((s_) < 2) { RD16(l0, kaA[s_][0], (BUF) * SHM_K); RD16(h0, kaA[s_][1], (BUF) * SHM_K); RD16(l1, kaA[s_][0], (BUF) * SHM_K + 4096); RD16(h1, kaA[s_][1], (BUF) * SHM_K + 4096); } \
        else { RD16(l0, kaB[0], (BUF) * SHM_K); RD16(h0, kaB[1], (BUF) * SHM_K); RD16(l1, kaB[0], (BUF) * SHM_K + 2048); RD16(h1, kaB[1], (BUF) * SHM_K + 2048); } } while (0)
#define VRD(d0_, vb0_, vb1_, l0, h0) do { RD16(l0, vb0_, (d0_) * 2048); RD16(h0, vb1_, (d0_) * 2048); } while (0)

#define PV_PRE(vb0_, vb1_) do { i32x4 yl, yh; i32x8 fv; \
        VRD(0, vb0_, vb1_, vxl, vxh); VRD(1, vb0_, vb1_, yl, yh); \
        asm volatile("s_nop 3" : "+v"(pa)); \
        LGK(2); SBAR(); MK8(fv, vxl, vxh); MMA8(o[0], pa, fv); SBAR(); VRD(2, vb0_, vb1_, vxl, vxh); \
        LGK(2); SBAR(); MK8(fv, yl, yh); MMA8(o[1], pa, fv); SBAR(); VRD(3, vb0_, vb1_, yl, yh); \
        LGK(2); SBAR(); MK8(fv, vxl, vxh); MMA8(o[2], pa, fv); SBAR(); \
        LGK(0); SBAR(); MK8(fv, yl, yh); MMA8(o[3], pa, fv); SBAR(); } while (0)
#define MAX3(acc_, x_, y_) asm("v_max3_f32 %0, %0, %1, %2" : "+v"(acc_) : "v"(x_), "v"(y_))
#define ADD1(acc_, x_) asm("v_add_f32 %0, %0, %1" : "+v"(acc_) : "v"(x_))
#define BAR_RAW() asm volatile("s_barrier" ::: "memory")
#define BAR_DMA() asm volatile("s_waitcnt vmcnt(0) lgkmcnt(0)\n\ts_barrier" ::: "memory")
#define SEG_M(t, BUF, FIRST_) do { \
        const int kb = (t) * 64; \
        act = kb <= qlo + 31; \
        if (act_prev) PV_PRE(vp0, vp1);                                  \
        if (act) { \
            i32x4 xl0, xh0, xl1, xh1, yl0, yh0, yl1, yh1; i32x8 f0, f1; \
            KRD(0, BUF, xl0, xh0, xl1, xh1); KRD(1, BUF, yl0, yh0, yl1, yh1); \
            LGK(4); SBAR(); MK8(f0, xl0, xh0); MK8(f1, xl1, xh1); \
            if (FIRST_) { MMAQZ(p0, f0, qf[0]); MMAQZ(p1, f1, qf[0]); } else { MMAQC(p0, f0, qf[0], nm); MMAQC(p1, f1, qf[0], nm); } \
            SBAR(); KRD(2, BUF, xl0, xh0, xl1, xh1); \
            LGK(4); SBAR(); MK8(f0, yl0, yh0); MK8(f1, yl1, yh1); MMAQ(p0, f0, qf[1]); MMAQ(p1, f1, qf[1]); SBAR(); \
            LGK(0); SBAR(); MK8(f0, xl0, xh0); MK8(f1, xl1, xh1); MMAQ(p0, f0, qf[2]); MMAQ(p1, f1, qf[2]); SBAR(); } \
          \
        VM_WAIT(); \
        if ((t) + 2 < NT) A8_DMA(kb + 128, ((BUF) + 2) % 3, ((vsel + 2) & 3)); \
        asm volatile("s_nop 15\n\ts_nop 7" : "+v"(p0), "+v"(p1)); \
        BAR_RAW(); \
    } while (0)
#define SEG_V(t, BUF, FIRST_) do { \
        const int kb = (t) * 64; \
        if (act) { \
            const int dq = qm - kb; \
            if (kb + 63 > qlo) { \
                _Pragma("unroll") for (int r = 0; r < 16; ++r) { const int c = (r & 3) + 8 * (r >> 2); if (dq - c < 0) p0[r] = NEGINF; if (dq - c - 32 < 0) p1[r] = NEGINF; } } \
            float pmx[4] = {p0[0], p0[1], p0[2], p0[3]}; \
            _Pragma("unroll") for (int r = 4; r < 16; r += 2) MAX3(pmx[(r >> 1) & 3], p0[r], p0[r + 1]); \
            _Pragma("unroll") for (int r = 0; r < 16; r += 2) MAX3(pmx[(r >> 1) & 3], p1[r], p1[r + 1]); \
            float pmax; asm("v_max3_f32 %0, %1, %2, %3" : "=v"(pmax) : "v"(pmx[0]), "v"(pmx[1]), "v"(pmx[2])); asm("v_max_f32 %0, %0, %1" : "+v"(pmax) : "v"(pmx[3])); \
            { auto rr = __builtin_amdgcn_permlane32_swap(__float_as_uint(pmax), __float_as_uint(pmax), false, false); pmax = fmaxf(__uint_as_float(rr[0]), __uint_as_float(rr[1])); } \
            float alpha = 1.f; \
            if (FIRST_) {     \
                const float mn = fmaxf(m_reg, pmax); alpha = __builtin_amdgcn_exp2f(m_reg - mn); m_reg = mn; const float moff = 4.f - m_reg; \
                _Pragma("unroll") for (int r = 0; r < 16; ++r) { p0[r] += moff; p1[r] += moff; } \
                _Pragma("unroll") for (int r = 0; r < 16; ++r) nm[r] = moff; \
            } else if (!__all(pmax - 4.f <= THR)) {     \
                const float delta = fmaxf(pmax - 4.f, 0.f); alpha = __builtin_amdgcn_exp2f(-delta); m_reg += delta; const float moff = 4.f - m_reg; \
                _Pragma("unroll") for (int r = 0; r < 16; ++r) { p0[r] -= delta; p1[r] -= delta; } \
                _Pragma("unroll") for (int r = 0; r < 16; ++r) nm[r] = moff; } \
            if (__any(alpha < 1.f)) { if (hi == 0) al_l[r32] = alpha; LDS_WAIT(); \
                asm volatile("s_nop 15\n\ts_nop 7" : "+v"(o[0]), "+v"(o[1]), "+v"(o[2]), "+v"(o[3])); \
                _Pragma("unroll") for (int r = 0; r < 16; ++r) { const float f = al_l[crow8(r, hi)]; o[0][r] *= f; o[1][r] *= f; o[2][r] *= f; o[3][r] *= f; } } \
            float ps, psa[4];     \
            _Pragma("unroll") for (int r = 0; r < 16; ++r) p0[r] = __builtin_amdgcn_exp2f(p0[r]); \
            _Pragma("unroll") for (int r = 0; r < 16; ++r) p1[r] = __builtin_amdgcn_exp2f(p1[r]); \
            asm volatile("s_nop 0" : "+v"(p0), "+v"(p1));                \
            _Pragma("unroll") for (int r = 0; r < 4; ++r) psa[r] = p0[r]; \
            _Pragma("unroll") for (int r = 4; r < 16; ++r) ADD1(psa[r & 3], p0[r]); \
            _Pragma("unroll") for (int r = 0; r < 16; ++r) ADD1(psa[r & 3], p1[r]); \
            ADD1(psa[0], psa[1]); ADD1(psa[2], psa[3]); ADD1(psa[0], psa[2]); ps = psa[0]; \
            { auto rr = __builtin_amdgcn_permlane32_swap(__float_as_uint(ps), __float_as_uint(ps), false, false); ps = __uint_as_float(rr[0]) + __uint_as_float(rr[1]); } \
            l_reg = l_reg * alpha + ps; \
            _Pragma("unroll") for (int j = 0; j < 4; ++j) { pa[j] = PK4U(p0[4 * j], p0[4 * j + 1], p0[4 * j + 2], p0[4 * j + 3]); pa[4 + j] = PK4U(p1[4 * j], p1[4 * j + 1], p1[4 * j + 2], p1[4 * j + 3]); } \
        } \
        act_prev = act; vp0 = vc0; vp1 = vc1; vsel = (vsel + 1) & 3; vc0 = va[0] + (unsigned)vsel * SHM_V; vc1 = va[1] + (unsigned)vsel * SHM_V; \
        BAR_RAW(); \
    } while (0)

    f32x16 nm = f32x16{}, p0 = f32x16{}, p1 = f32x16{};
    i32x8 pa = i32x8{}; bool act = false, act_prev = false; int vsel = 0; unsigned vc0 = va[0], vc1 = va[1], vp0 = va[0], vp1 = va[1];
    i32x4 vxl, vxh;
    A8_DMA(0, 0, 0); if (1 < NT) A8_DMA(64, 1, 1);
    BAR_DMA();
    if (a.trail) BAR_RAW();
    SEG_M(0, 0, 1); SEG_V(0, 0, 1);
    for (int t = 1; t < NT; t += 3) {
        SEG_M(t, 1, 0); SEG_V(t, 1, 0);
        if (t + 1 < NT) { SEG_M(t + 1, 2, 0); SEG_V(t + 1, 2, 0); }
        if (t + 2 < NT) { SEG_M(t + 2, 0, 0); SEG_V(t + 2, 0, 0); } }
    if (act_prev) PV_PRE(vp0, vp1);
    if (!a.trail) BAR_RAW();

    asm volatile("s_nop 15\n\ts_nop 7" : "+v"(o[0]), "+v"(o[1]), "+v"(o[2]), "+v"(o[3]));
    if (hi == 0) li_l[r32] = l_reg;
    LDS_WAIT();
#pragma unroll
    for (int r = 0; r < 16; ++r) { const int orow = crow8(r, hi); const float rl = 64.f * __builtin_amdgcn_rcpf(li_l[orow]);
        *(unsigned*)(a.O8 + (long)(wid * 32 + orow) * a.o8s + 4 * r32) = pk4_fp8(o[0][r] * rl, o[1][r] * rl, o[2][r] * rl, o[3][r] * rl); }
    asm volatile("s_waitcnt lgkmcnt(0)\n\ts_barrier" ::: "memory");
#undef A8_DMA
#undef RD16
#undef LGK
#undef MMA8
#undef MMA8Z
#undef MMAQ
#undef MMAQZ
#undef MMAQC
#undef MK8
#undef KRD
#undef VRD
#undef SEG_M
#undef MAX3
#undef ADD1
#undef PK4U
#undef SEG_V
#undef BAR_RAW
#undef BAR_DMA
#undef PV_PRE
}
}

template <class RowMap>
__device__ __forceinline__ void transpose_item(const float* W, int ldw, int K, int k0, int nsrc0, bf16* WT, RowMap rm, LAS float* scr, int lane) {
#pragma unroll
    for (int i = 0; i < 8; ++i) { const int kk = 8 * i + (lane >> 3); const f32x4 v = *(const f32x4*)(W + (size_t)(k0 + kk) * ldw + nsrc0 + 4 * (lane & 7)); LAS float* d = scr + kk * 33 + 4 * (lane & 7); d[0] = v.x; d[1] = v.y; d[2] = v.z; d[3] = v.w; }
    LDS_WAIT(); asm volatile("" ::: "memory");
    const int c = lane & 7;
#pragma unroll
    for (int j = 0; j < 4; ++j) { const int n = (lane >> 3) + 8 * j; const LAS float* s = scr + (8 * c) * 33 + n;
        v4u o; o.x = pk2(s[0 * 33], s[1 * 33]); o.y = pk2(s[2 * 33], s[3 * 33]); o.z = pk2(s[4 * 33], s[5 * 33]); o.w = pk2(s[6 * 33], s[7 * 33]);
        *(v4u*)(WT + (size_t)rm(nsrc0 + n) * K + k0 + 8 * c) = o; }
    LDS_WAIT(); asm volatile("" ::: "memory");
}
struct KmIdent { __device__ __forceinline__ int operator()(int k) const { return k; } };
struct KmAttn { __device__ __forceinline__ int operator()(int k) const { return (k & ~127) + 32 * (k & 3) + ((k & 127) >> 2); } };
template <class RowMap, class KMap = KmIdent>
__device__ __forceinline__ void transpose_item8(const float* W, int ldw, int K, int k0, int nsrc0, unsigned char* WT, RowMap rm, LAS float* scr, int lane, KMap km = KMap()) {
#pragma unroll
    for (int i = 0; i < 8; ++i) { const int kk = 8 * i + (lane >> 3); const f32x4 v = *(const f32x4*)(W + (size_t)km(k0 + kk) * ldw + nsrc0 + 4 * (lane & 7)); LAS float* d = scr + kk * 33 + 4 * (lane & 7); d[0] = v.x; d[1] = v.y; d[2] = v.z; d[3] = v.w; }
    LDS_WAIT(); asm volatile("" ::: "memory");
    const int c = lane & 7;
#pragma unroll
    for (int j = 0; j < 4; ++j) { const int n = (lane >> 3) + 8 * j; const LAS float* s = scr + (8 * c) * 33 + n;
        v2u o; o.x = pk4_fp8(64.f * s[0 * 33], 64.f * s[1 * 33], 64.f * s[2 * 33], 64.f * s[3 * 33]); o.y = pk4_fp8(64.f * s[4 * 33], 64.f * s[5 * 33], 64.f * s[6 * 33], 64.f * s[7 * 33]);
        *(v2u*)(WT + (size_t)rm(nsrc0 + n) * K + k0 + 8 * c) = o; }
    LDS_WAIT(); asm volatile("" ::: "memory");
}
struct RmIdent { __device__ __forceinline__ int operator()(int c) const { return c; } };
struct RmGate { __device__ __forceinline__ int operator()(int c) const { const int cp = c - 7232, half = cp >> 11, cc = cp & 2047; return 256 * (cc >> 7) + 128 * half + (cc & 127); } };
struct RmUq { __device__ __forceinline__ int operator()(int c) const { const int head = c / 192, off = c - head * 192; if (off < 128) return c; const int j = off - 128; return head * 192 + 128 + 2 * (j & 31) + (j >> 5); } };

__device__ __forceinline__ void sincos_d(double x, float& s, float& c) {
    const double TWO_PI = 6.283185307179586476925286766559;
    const double k = __builtin_rint(x * (1.0 / TWO_PI)); double r = x - k * TWO_PI;
    const double r2 = r * r; double ss = 1.0, cc = 1.0, ts = 1.0, tc = 1.0;
#pragma unroll
    for (int i = 1; i <= 14; ++i) { tc *= -r2 * (1.0 / (double)((2 * i - 1) * (2 * i))); ts *= -r2 * (1.0 / (double)((2 * i) * (2 * i + 1))); cc += tc; ss += ts; }
    s = (float)(ss * r); c = (float)cc;
}

namespace peer {
__device__ __forceinline__ unsigned ordf(float f) { const unsigned u = __float_as_uint(f); return u ^ ((unsigned)((int)u >> 31) | 0x80000000u); }
__device__ __forceinline__ float unordf(unsigned o) { return __uint_as_float(o ^ ((unsigned)((~(int)o) >> 31) | 0x80000000u)); }
__device__ __forceinline__ void sort16_desc(unsigned (&v)[16]) {
#pragma unroll
    for (int k = 2; k <= 16; k <<= 1)
#pragma unroll
        for (int j = k >> 1; j > 0; j >>= 1)
#pragma unroll
            for (int i = 0; i < 16; ++i) { const int l = i ^ j; if (l > i) { const bool desc = ((i & k) == 0);
                const unsigned hi = v[i] > v[l] ? v[i] : v[l], lo = v[i] > v[l] ? v[l] : v[i]; v[i] = desc ? hi : lo; v[l] = desc ? lo : hi; } }
}
__device__ __forceinline__ void merge16_desc(unsigned (&a)[16], const unsigned (&b)[16]) {
#pragma unroll
    for (int i = 0; i < 16; ++i) a[i] = a[i] > b[15 - i] ? a[i] : b[15 - i];
#pragma unroll
    for (int j = 8; j > 0; j >>= 1)
#pragma unroll
        for (int i = 0; i < 16; ++i) { const int l = i ^ j; if (l > i) { const unsigned hi = a[i] > a[l] ? a[i] : a[l], lo = a[i] > a[l] ? a[l] : a[i]; a[i] = hi; a[l] = lo; } }
}
__device__ __forceinline__ void insert_desc(unsigned (&a)[16], unsigned x) {
#pragma unroll
    for (int i = 0; i < 16; ++i) { const unsigned hi = a[i] > x ? a[i] : x, lo = a[i] > x ? x : a[i]; a[i] = hi; x = lo; }
}
__device__ __forceinline__ void top16_of_128(const f32x16 (&acc)[4], int hi, unsigned (&out)[16]) {
    unsigned g[4][16];
#pragma unroll
    for (int kb = 0; kb < 4; ++kb)
#pragma unroll
        for (int r = 0; r < 16; ++r) { const unsigned base = (unsigned)(kb * 32 + (r & 3) + 8 * (r >> 2)); g[kb][r] = ((ordf(acc[kb][r]) & ~127u) | (127u - base)) ^ (unsigned)(4 * hi); }
    sort16_desc(g[0]); sort16_desc(g[1]); sort16_desc(g[2]); sort16_desc(g[3]);
    merge16_desc(g[0], g[1]); merge16_desc(g[2], g[3]); merge16_desc(g[0], g[2]);
    unsigned pr[16];
#pragma unroll
    for (int i = 0; i < 16; ++i) { auto rr = __builtin_amdgcn_permlane32_swap(g[0][i], g[0][i], false, false); pr[i] = hi ? rr[0] : rr[1]; }
    merge16_desc(g[0], pr);
#pragma unroll
    for (int i = 0; i < 16; ++i) out[i] = g[0][i];
}
__device__ __forceinline__ unsigned ckey(float v, int tag) { return (ordf(v) & ~255u) | (unsigned)(255 - tag); }
}

__device__ __forceinline__ float wave_total_dpp(float v) {
    int x = __builtin_bit_cast(int, v);
#define DPP_ADD(ctrl_, rmask_) do { const int t_ = __builtin_amdgcn_update_dpp(0, x, ctrl_, rmask_, 0xf, false); x = __builtin_bit_cast(int, __builtin_bit_cast(float, x) + __builtin_bit_cast(float, t_)); } while (0)
    DPP_ADD(0xB1, 0xf);
    DPP_ADD(0x4E, 0xf);
    DPP_ADD(0x141, 0xf);
    DPP_ADD(0x140, 0xf);
    DPP_ADD(0x142, 0xa);
    DPP_ADD(0x143, 0xc);
#undef DPP_ADD
    return __builtin_bit_cast(float, __builtin_amdgcn_readlane(x, 63));
}
__device__ __forceinline__ void wave_total_dpp4(float (&v)[4]) {
#define DPP_ADD8(ctrl_, rmask_) do { _Pragma("unroll") for (int u = 0; u < 4; ++u) { const int x_ = __builtin_bit_cast(int, v[u]); const int t_ = __builtin_amdgcn_update_dpp(0, x_, ctrl_, rmask_, 0xf, false); v[u] += __builtin_bit_cast(float, t_); } } while (0)
    DPP_ADD8(0xB1, 0xf); DPP_ADD8(0x4E, 0xf); DPP_ADD8(0x141, 0xf); DPP_ADD8(0x140, 0xf); DPP_ADD8(0x142, 0xa); DPP_ADD8(0x143, 0xc);
#undef DPP_ADD8
}
__device__ __forceinline__ float wave_max_nonneg_dpp(float v) {
    int x = __builtin_bit_cast(int, v);
#define DPP_MAX(ctrl_, rmask_) do { const int t_ = __builtin_amdgcn_update_dpp(0, x, ctrl_, rmask_, 0xf, false); x = __builtin_bit_cast(int, fmaxf(__builtin_bit_cast(float, x), __builtin_bit_cast(float, t_))); } while (0)
    DPP_MAX(0xB1, 0xf); DPP_MAX(0x4E, 0xf); DPP_MAX(0x141, 0xf); DPP_MAX(0x140, 0xf); DPP_MAX(0x142, 0xa); DPP_MAX(0x143, 0xc);
#undef DPP_MAX
    return __builtin_bit_cast(float, __builtin_amdgcn_readlane(x, 63));
}
__device__ __forceinline__ float gelu_erf(float v) {
    const float av = __builtin_fabsf(v), t = __builtin_amdgcn_rcpf(av * 0.2316418882f + 1.0f);
    float q = t * 0.5307027145f + (-0.7265760135f); q = q * t + 0.7107068705f; q = q * t + (-0.142248368f); q = q * t + 0.127414796f; q = q * t;
    const float e = __builtin_amdgcn_exp2f((v * v) * (-0.72134752044f));
    const float m = v * (q * e);
    return v < 0.f ? m : v - m;
}

constexpr int PTBL_OFF = MISC_OFF + 64;
__device__ __forceinline__ void* ldp(LAS unsigned char* lds, int k) { const v2u w = *(LAS const v2u*)(lds + PTBL_OFF + 8 * k);
    const unsigned lo = (unsigned)__builtin_amdgcn_readfirstlane((int)w.x), hi = (unsigned)__builtin_amdgcn_readfirstlane((int)w.y); return (void*)(((unsigned long long)hi << 32) | lo); }
struct Args { const float* in[19]; float* out; unsigned char* ws; int ph_lo, ph_hi, bli, pad; };
__global__ void __launch_bounds__(512, 2) mk_fwd(Args args) {
    extern __shared__ __attribute__((aligned(16))) unsigned char lds_raw[];
    LAS unsigned char* lds = (LAS unsigned char*)lds_raw;
    const int tid = threadIdx.x, lane = tid & 63, wave = __builtin_amdgcn_readfirstlane(tid >> 6);
    const int G = gridDim.x, bx = blockIdx.x;
    const int vcu = (G % 8 == 0) ? (bx % 8) * (G / 8) + bx / 8 : bx;
    const int gw = vcu * 8 + wave, NGW = G * 8;
    unsigned char* ws = args.ws;
#define p_x ((const float*)ldp(lds, 0))
#define p_w_in ((const float*)ldp(lds, 1))
#define p_b_gates ((const float*)ldp(lds, 2))
#define p_a_w_out ((const float*)ldp(lds, 3))
#define p_q_norm ((const float*)ldp(lds, 4))
#define p_w_uq ((const float*)ldp(lds, 5))
#define p_kv_norm ((const float*)ldp(lds, 6))
#define p_w_ukv ((const float*)ldp(lds, 7))
#define p_mla_w_out ((const float*)ldp(lds, 8))
#define p_w_out ((const float*)ldp(lds, 9))
#define p_ln1_g ((const float*)ldp(lds, 10))
#define p_ln1_b ((const float*)ldp(lds, 11))
#define p_w_pq ((const float*)ldp(lds, 12))
#define p_sk1 ((const float*)ldp(lds, 13))
#define p_sk2 ((const float*)ldp(lds, 14))
#define p_e_down ((const float*)ldp(lds, 15))
#define p_e_up ((const float*)ldp(lds, 16))
#define p_ln2_g ((const float*)ldp(lds, 17))
#define p_ln2_b ((const float*)ldp(lds, 18))
#define p_out ((float*)ldp(lds, 19))
#define WA8 ((unsigned char*)(ws + WS_WA))
#define WG8 ((unsigned char*)(ws + WS_WG))
#define WAO ((unsigned char*)(ws + WS_WAO))
#define WBO ((unsigned char*)(ws + WS_WBO))
#define WO ((unsigned char*)(ws + WS_WO))
#define WPQ ((bf16*)(ws + WS_WPQ))
#define WUQ ((unsigned char*)(ws + WS_WUQ))
#define WUKV ((unsigned char*)(ws + WS_WUKV))
#define SK ((bf16*)(ws + WS_SK))
#define ROPE ((float*)(ws + WS_ROPE))
#define XB8 ((unsigned char*)(ws + WS_XB))
#define QKV ((bf16*)(ws + WS_QKV))
#define CQKV ((bf16*)(ws + WS_CQKV))
#define KRRAW ((bf16*)(ws + WS_KRRAW))
#define CQN ((unsigned char*)(ws + WS_CQN))
#define CKVN ((unsigned char*)(ws + WS_CKVN))
#define KRR ((unsigned char*)(ws + WS_KRR))
#define LSEB ((float*)(ws + WS_LSE))
#define OA ((bf16*)(ws + WS_OA))
#define OA8 ((unsigned char*)(ws + WS_OA8))
#define QB ((unsigned char*)(ws + WS_QB))
#define KN ((unsigned char*)(ws + WS_KN))
#define VT8 ((unsigned char*)(ws + WS_VT))
#define OB8 ((unsigned char*)(ws + WS_OB))
#define VB ((bf16*)(ws + WS_VB))
#define YA ((unsigned char*)(ws + WS_YA))
#define YB ((unsigned char*)(ws + WS_YB))
#define UB ((unsigned char*)(ws + WS_U))
#define RB ((bf16*)(ws + WS_R))
#define H1B ((bf16*)(ws + WS_H1B))
#define ED8 ((unsigned char*)(ws + WS_ED))
#define EU8 ((unsigned char*)(ws + WS_EU))
#define SD ((float*)(ws + WS_SD))
#define SU ((float*)(ws + WS_SU))
#define PQ ((bf16*)(ws + WS_PQ))
#define IDX ((int*)(ws + WS_IDX))
#define GATE ((float*)(ws + WS_GATE))

    if (tid == 0) {
#define PT(k, p) *(LAS unsigned long long*)(lds + PTBL_OFF + 8 * (k)) = (unsigned long long)(uintptr_t)(p)
        PT(0, args.in[0]); PT(1, args.in[1]); PT(2, args.in[2]); PT(3, args.in[3]); PT(4, args.in[4]); PT(5, args.in[5]); PT(6, args.in[6]); PT(7, args.in[7]); PT(8, args.in[8]); PT(9, args.in[9]);
        PT(10, args.in[10]); PT(11, args.in[11]); PT(12, args.in[12]); PT(13, args.in[13]); PT(14, args.in[14]); PT(15, args.in[15]); PT(16, args.in[16]); PT(17, args.in[17]); PT(18, args.in[18]); PT(19, args.out);
#undef PT
    }
    if (tid < 4) ((LAS unsigned*)(lds + MISC_OFF))[tid] = 0u;
    __syncthreads();
    const int lo = args.ph_lo, hi = args.ph_hi;
    const bool use_bar = true;
    XcdBarrier bar; bar.bar = (unsigned*)(ws + WS_CTL) + CW_BAR + args.bli * XCD_BAR_WORDS; bar.x = 0; bar.st = nullptr;
    if (use_bar) bar = xcd_barrier_post((unsigned*)(ws + WS_CTL) + CW_BAR + args.bli * XCD_BAR_WORDS, (volatile LAS unsigned*)(lds + MISC_OFF));
#ifndef MK_PHASES
#define MK_PHASES 0xFFFFFFFFu
#endif
#define IN(k) ((((MK_PHASES) >> (k)) & 1u) && lo <= (k) && (k) < hi)
#define SEAM(k) do { if (IN(k) && IN((k) + 1)) xcd_barrier(bar); } while (0)

    if (IN(0)) {
        LAS float* scr = (LAS float*)(lds + wave * 16384);
        const float* c_w_in = p_w_in; const float* c_a_w_out = p_a_w_out; const float* c_mla_w_out = p_mla_w_out; const float* c_w_out = p_w_out; const float* c_w_pq = p_w_pq; const float* c_w_uq = p_w_uq; const float* c_w_ukv = p_w_ukv;
        const float* c_x = p_x; const float* c_sk1 = p_sk1; const float* c_sk2 = p_sk2;
        constexpr int I_A = 32 * 226, I_G = 32 * 128, I_SQ = 32 * 64, I_UQ = 8 * 96, I_UKV = 8 * 128;
        constexpr int NITEMS = I_A + I_G + 4 * I_SQ + I_UQ + I_UKV;
        for (int it = gw; it < NITEMS; it += NGW) {
            int r = it;
            if (r < I_A) { transpose_item8(c_w_in, IN_W, DM, 64 * (r / 226), 32 * (r % 226), WA8, RmIdent(), scr, lane); continue; } r -= I_A;
            if (r < I_G) { transpose_item8(c_w_in, IN_W, DM, 64 * (r / 128), 7232 + 32 * (r % 128), WG8, RmGate(), scr, lane); continue; } r -= I_G;
            if (r < I_SQ) { transpose_item8(c_a_w_out, DM, DM, 64 * (r / 64), 32 * (r % 64), WAO, RmIdent(), scr, lane, KmAttn()); continue; } r -= I_SQ;
            if (r < I_SQ) { transpose_item8(c_mla_w_out, DM, DM, 64 * (r / 64), 32 * (r % 64), WBO, RmIdent(), scr, lane, KmAttn()); continue; } r -= I_SQ;
            if (r < I_SQ) { transpose_item8(c_w_out, DM, DM, 64 * (r / 64), 32 * (r % 64), WO, RmIdent(), scr, lane); continue; } r -= I_SQ;
            if (r < I_SQ) { transpose_item(c_w_pq, DM, DM, 64 * (r / 64), 32 * (r % 64), WPQ, RmIdent(), scr, lane); continue; } r -= I_SQ;
            if (r < I_UQ) { transpose_item8(c_w_uq, NQB, QL, 64 * (r / 96), 32 * (r % 96), WUQ, RmUq(), scr, lane); continue; } r -= I_UQ;
            transpose_item8(c_w_ukv, NKV, QL, 64 * (r / 128), 32 * (r % 128), WUKV, RmIdent(), scr, lane);
        }
        const size_t gt = (size_t)vcu * 512 + tid, NT_ = (size_t)G * 512;
        for (size_t i = gt; i < (size_t)192 * DM / 16; i += NT_) *(v4u*)(WA8 + (size_t)7232 * DM + i * 16) = (v4u){0u, 0u, 0u, 0u};
        for (size_t i = gt; i < (size_t)T * DM / 16; i += NT_) { const f32x4 a = *(const f32x4*)(c_x + i * 16), b = *(const f32x4*)(c_x + i * 16 + 4), c = *(const f32x4*)(c_x + i * 16 + 8), d = *(const f32x4*)(c_x + i * 16 + 12);
            *(v4u*)(XB8 + i * 16) = (v4u){pk4_fp8(a[0], a[1], a[2], a[3]), pk4_fp8(b[0], b[1], b[2], b[3]), pk4_fp8(c[0], c[1], c[2], c[3]), pk4_fp8(d[0], d[1], d[2], d[3])}; }
        for (size_t i = gt; i < 2 * 16384; i += NT_) SK[i] = (bf16)f2bf(i < 16384 ? c_sk1[i] : c_sk2[i - 16384]);
        for (size_t i = gt; i < (size_t)SEQ * 32; i += NT_) { const int pos = (int)(i >> 5), j = (int)(i & 31);
            const float inv = (float)exp2(-(double)j / 32.0 * 13.287712379549449);
            const float ang = (float)pos * inv; float s, c; sincos_d((double)ang, s, c); ROPE[2 * i] = c; ROPE[2 * i + 1] = s; }
    }
    SEAM(0);

    if (IN(1)) {
        pg8::Gemm g{(const bf16*)XB8, (const bf16*)WA8, T, NA, DM / 2}; pg8::StaticOrder S; S.init(T, NA, G, bx);
        pg8::EpiA E{QKV, CQKV, KRRAW, 1.f / 64.f};
        pg8::gemm_phase8<pg8::EpiA, pg8::StaticOrder>(lds, g, S, E, nullptr);
    }
    SEAM(1);

    if (IN(2)) {
        const float* c_q_norm = p_q_norm; const float* c_kv_norm = p_kv_norm;
        const f32x4 gq0 = *(const f32x4*)(c_q_norm + lane * 8), gq1 = *(const f32x4*)(c_q_norm + lane * 8 + 4), gk0 = *(const f32x4*)(c_kv_norm + lane * 8), gk1 = *(const f32x4*)(c_kv_norm + lane * 8 + 4);
        const int i = lane & 31;
        v4u ncq = {0u, 0u, 0u, 0u}, nck = {0u, 0u, 0u, 0u}; bf16 nk1 = 0, nk2 = 0; f32x2 ncs = {0.f, 0.f};
        if (gw < T) { ncq = *(const v4u*)(CQKV + (size_t)gw * 1024 + lane * 8); nck = *(const v4u*)(CQKV + (size_t)gw * 1024 + 512 + lane * 8);
            nk1 = KRRAW[(size_t)gw * 64 + i]; nk2 = KRRAW[(size_t)gw * 64 + 32 + i]; ncs = *(const f32x2*)(ROPE + ((size_t)(gw & (SEQ - 1)) * 32 + i) * 2); }
        for (int t = gw; t < T; t += NGW) {
            const v4u cq = ncq, ck = nck; const bf16 k1 = nk1, k2 = nk2; const f32x2 cs = ncs;
            { const int tn = t + NGW; if (tn < T) { ncq = *(const v4u*)(CQKV + (size_t)tn * 1024 + lane * 8); nck = *(const v4u*)(CQKV + (size_t)tn * 1024 + 512 + lane * 8);
                nk1 = KRRAW[(size_t)tn * 64 + i]; nk2 = KRRAW[(size_t)tn * 64 + 32 + i]; ncs = *(const f32x2*)(ROPE + ((size_t)(tn & (SEQ - 1)) * 32 + i) * 2); } }
            float fq[8] = {bf_lo(cq.x), bf_hi(cq.x), bf_lo(cq.y), bf_hi(cq.y), bf_lo(cq.z), bf_hi(cq.z), bf_lo(cq.w), bf_hi(cq.w)};
            float fk[8] = {bf_lo(ck.x), bf_hi(ck.x), bf_lo(ck.y), bf_hi(ck.y), bf_lo(ck.z), bf_hi(ck.z), bf_lo(ck.w), bf_hi(ck.w)};
            float sq = 0.f, sk = 0.f;
#pragma unroll
            for (int e = 0; e < 8; ++e) { sq += fq[e] * fq[e]; sk += fk[e] * fk[e]; }
            const float rq = 1.f / sqrtf(wave_sum(sq) * (1.f / 512.f) + RMS_EPS), rk = 1.f / sqrtf(wave_sum(sk) * (1.f / 512.f) + RMS_EPS);
            *(v2u*)(CQN + (size_t)t * 512 + lane * 8) = (v2u){pk4_fp8(fq[0] * rq * gq0[0], fq[1] * rq * gq0[1], fq[2] * rq * gq0[2], fq[3] * rq * gq0[3]), pk4_fp8(fq[4] * rq * gq1[0], fq[5] * rq * gq1[1], fq[6] * rq * gq1[2], fq[7] * rq * gq1[3])};
            *(v2u*)(CKVN + (size_t)t * 512 + lane * 8) = (v2u){pk4_fp8(fk[0] * rk * gk0[0], fk[1] * rk * gk0[1], fk[2] * rk * gk0[2], fk[3] * rk * gk0[3]), pk4_fp8(fk[4] * rk * gk1[0], fk[5] * rk * gk1[1], fk[6] * rk * gk1[2], fk[7] * rk * gk1[3])};
            const float t1 = bf2f(k1), t2 = bf2f(k2);
            const float o1 = t1 * cs.x - t2 * cs.y, o2 = t1 * cs.y + t2 * cs.x;
            KRR[(size_t)t * 64 + lane] = (unsigned char)(pk4_fp8(lane < 32 ? o1 : o2, 0.f, 0.f, 0.f) & 0xffu);
        }
    }

#define DIL_DESC(PH, DIL, u_, d) do { \
            const int bh = (u_) >> 6, rem = (u_) & 63, rr = rem / nblk, blk = rem % nblk, b = bh >> 4, h = bh & 15; \
            const size_t tok0 = (size_t)b * SEQ + rr, tq0 = tok0 + (size_t)blk * 256 * (DIL); \
            d.Q = QKV + tq0 * 6144 + h * 128; d.qs = (long)(DIL) * 6144; \
            d.K = QKV + tok0 * 6144 + 2048 + h * 128; d.ks = (long)(DIL) * 6144; d.K2 = nullptr; d.k2s = 0; \
            d.V = QKV + tok0 * 6144 + 4096 + h * 128; d.vs = (long)(DIL) * 6144; \
            d.O = OA + tq0 * DM + h * 128; d.os = (long)(DIL) * DM; d.LSE = LSEB + tq0 * 16 + h; d.ls = (long)(DIL) * 16; \
            d.q0 = blk * 256; d.j_lo = blk == 0 ? 0 : blk * 4 - 2; d.j_hi = blk * 4 + 4; \
            d.sl = __builtin_exp2f(-0.5f * (float)(h + 1)) * (float)(DIL) * LOG2E; d.first = ((PH) == 3); \
            d.O8 = ((PH) == 5) ? OA8 + tq0 * DM + h * 128 : nullptr; d.o8s = (long)(DIL) * DM; } while (0)
#define DIL_PASS(PH, DIL, LOG2D) \
    if (IN(PH)) { \
        constexpr int nblk = SEQ / (DIL) / 256; \
        bf16x8 qr[8]; att::Desc d, dn; \
        if (vcu < 2048) { DIL_DESC(PH, DIL, vcu, d); att::attn_prime<1>(lds, d, qr); } \
        for (int u = vcu; u < 2048; u += G) { \
            const bool hn = u + G < 2048; \
            if (hn) DIL_DESC(PH, DIL, u + G, dn); else dn = d; \
            att::attn_unit<1>(lds, d, dn, hn, qr); \
            d = dn; } }
    DIL_PASS(3, 1, 0)
    SEAM(3);
    DIL_PASS(4, 4, 2)
    SEAM(4);
    DIL_PASS(5, 16, 4)
    SEAM(5);

    if (IN(6)) {
        pg8::Gemm g{(const bf16*)CQN, (const bf16*)WUQ, T, NQB, QL / 2}; pg8::StaticOrder S; S.init(T, NQB, G, bx);
        pg8::EpiQ E{QB, ROPE, QSC_B * att8::QPRE / 64.f};
        pg8::gemm_phase8<pg8::EpiQ, pg8::StaticOrder>(lds, g, S, E, nullptr);
    }
    if (IN(7)) {
        pg8::Gemm g{(const bf16*)CKVN, (const bf16*)WUKV, T, NKV, QL / 2}; pg8::StaticOrder S; S.init(T, NKV, G, bx);
        pg8::EpiKV E{KN, VT8, lds + MISC_OFF + 1024 + (tid >> 6) * 1536, 1.f / 64.f};
        pg8::gemm_phase8<pg8::EpiKV, pg8::StaticOrder>(lds, g, S, E, nullptr);
    }
    SEAM(7);

    if (IN(8)) {
        int trail;
        { LAS unsigned* cnt = (LAS unsigned*)(lds + 126976);
          if (tid < 4) cnt[tid] = 0u;
          __syncthreads();
          const unsigned simd = ((unsigned)__builtin_amdgcn_s_getreg((1 << 11) | (4 << 6) | 4)) & 3u;
          unsigned rk = 0u; if (lane == 0) rk = __hip_atomic_fetch_add(cnt + simd, 1u, __ATOMIC_RELAXED, __HIP_MEMORY_SCOPE_WORKGROUP);
          trail = (int)(__builtin_amdgcn_readfirstlane((int)rk) & 1);
          __syncthreads(); }
        for (int it = vcu; it < 1024; it += G) {
            const int bh = it >> 5, y = it & 31, b = bh >> 4, h = bh & 15;
#pragma unroll 1
            for (int s = 0; s < 2; ++s) { const int xb_ = s == 0 ? 63 - y : y;
                att8::Desc d; const size_t tb = (size_t)b * SEQ;
                d.Q = QB + (tb + (size_t)xb_ * 256) * NQB + h * 192; d.qs = NQB;
                d.K = KN + tb * DM + h * 128; d.ks = DM; d.K2 = KRR + tb * 64; d.k2s = 64;
                d.VT = VT8 + (size_t)bh * 128 * SEQ; d.vts = SEQ; d.O8 = OB8 + (tb + (size_t)xb_ * 256) * DM + h * 128; d.o8s = DM;
                d.q0 = xb_ * 256; d.j_hi = xb_ * 4 + 4; d.trail = trail;
                att8::attn_unit(lds, d); }
        }
    }
    SEAM(8);

    if (IN(9)) {
        pg8::Gemm g{(const bf16*)OA8, (const bf16*)WAO, T, DM, DM / 2}; pg8::StaticOrder S; S.init(T, DM, G, bx);
        pg8::EpiPlain8 E{YA, DM, 1.f / 64.f};
        pg8::gemm_phase8<pg8::EpiPlain8, pg8::StaticOrder>(lds, g, S, E, nullptr);
    }
    if (IN(10)) {
        pg8::Gemm g{(const bf16*)OB8, (const bf16*)WBO, T, DM, DM / 2}; pg8::StaticOrder S; S.init(T, DM, G, bx);
        pg8::EpiPlain8 E{YB, DM, 1.f / 64.f};
        pg8::gemm_phase8<pg8::EpiPlain8, pg8::StaticOrder>(lds, g, S, E, nullptr);
    }
    SEAM(10);

    if (IN(11)) {
        pg8::Gemm g{(const bf16*)XB8, (const bf16*)WG8, T, NGATE, DM / 2}; pg8::StaticOrder S; S.init(T, NGATE, G, bx);
        pg8::EpiGate E{YA, YB, p_b_gates, UB, 1.f / 64.f};
        pg8::gemm_phase8<pg8::EpiGate, pg8::StaticOrder>(lds, g, S, E, nullptr);
    }
    SEAM(11);

    if (IN(12)) {
        pg8::Gemm g{(const bf16*)UB, (const bf16*)WO, T, DM, DM / 2}; pg8::StaticOrder S; S.init(T, DM, G, bx);
        pg8::EpiResid E{p_x, RB, 1.f / 4096.f};
        pg8::gemm_phase8<pg8::EpiResid, pg8::StaticOrder>(lds, g, S, E, nullptr);
    }
    SEAM(12);

    if (IN(13)) {
        const float* c_ln1_g = p_ln1_g; const float* c_ln1_b = p_ln1_b; const float* c_e_down = p_e_down; const float* c_e_up = p_e_up;
        f32x4 lg[8], lb[8];
#pragma unroll
        for (int j = 0; j < 4; ++j) { const int c = 512 * j + 8 * lane; lg[2 * j] = *(const f32x4*)(c_ln1_g + c); lg[2 * j + 1] = *(const f32x4*)(c_ln1_g + c + 4); lb[2 * j] = *(const f32x4*)(c_ln1_b + c); lb[2 * j + 1] = *(const f32x4*)(c_ln1_b + c + 4); }
        v4u nxw[4];
        if (gw < T) {
#pragma unroll
            for (int j = 0; j < 4; ++j) nxw[j] = *(const v4u*)(RB + (size_t)gw * DM + 512 * j + 8 * lane); }
        for (int t = gw; t < T; t += NGW) {
            float v[32]; float s = 0.f;
#pragma unroll
            for (int j = 0; j < 4; ++j) { const v4u w = nxw[j];
                v[8 * j + 0] = bf_lo(w.x); v[8 * j + 1] = bf_hi(w.x); v[8 * j + 2] = bf_lo(w.y); v[8 * j + 3] = bf_hi(w.y); v[8 * j + 4] = bf_lo(w.z); v[8 * j + 5] = bf_hi(w.z); v[8 * j + 6] = bf_lo(w.w); v[8 * j + 7] = bf_hi(w.w); }
            if (t + NGW < T) {
#pragma unroll
                for (int j = 0; j < 4; ++j) nxw[j] = *(const v4u*)(RB + (size_t)(t + NGW) * DM + 512 * j + 8 * lane); }
#pragma unroll
            for (int i = 0; i < 32; ++i) s += v[i];
            const float mean = wave_sum(s) * (1.f / DM); float s2 = 0.f;
#pragma unroll
            for (int i = 0; i < 32; ++i) { v[i] -= mean; s2 += v[i] * v[i]; }
            const float rstd = 1.f / sqrtf(wave_sum(s2) * (1.f / DM) + LN_EPS);
#pragma unroll
            for (int j = 0; j < 4; ++j) { const int c = 512 * j + 8 * lane; const f32x4 g0 = lg[2 * j], g1 = lg[2 * j + 1], b0 = lb[2 * j], b1 = lb[2 * j + 1];
                *(v4u*)(H1B + (size_t)t * DM + c) = (v4u){pk2(v[8 * j] * rstd * g0[0] + b0[0], v[8 * j + 1] * rstd * g0[1] + b0[1]), pk2(v[8 * j + 2] * rstd * g0[2] + b0[2], v[8 * j + 3] * rstd * g0[3] + b0[3]),
                                                          pk2(v[8 * j + 4] * rstd * g1[0] + b1[0], v[8 * j + 5] * rstd * g1[1] + b1[1]), pk2(v[8 * j + 6] * rstd * g1[2] + b1[2], v[8 * j + 7] * rstd * g1[3] + b1[3])}; }
        }
    }
    SEAM(13);

    if (IN(14)) {
        pg8::Gemm g{H1B, WPQ, T, DM, DM}; pg8::StaticOrder S; S.init(T, DM, G, bx);
        pg8::EpiPlain E{PQ, DM, 1.f};
        pg8::gemm_phase<pg8::EpiPlain, pg8::StaticOrder>(lds, g, S, E, nullptr);
    }
    SEAM(14);

    if (IN(15)) {
        for (int c = tid; c < 4096; c += 512) { const int which = c >> 11, row = (c >> 4) & 127, ch = c & 15;
            *(LAS v4u*)(lds + which * 32768 + row * 256 + ((ch ^ (row & 7)) << 4)) = *(const v4u*)(SK + (size_t)which * 16384 + row * 128 + ch * 8); }
        __syncthreads();
        const int r32 = lane & 31, lh = lane >> 5;
        LAS unsigned char* iscr = lds + 65536 + wave * 1024 + r32 * 32;
        for (int task = gw; task < T * PH / 32; task += NGW) {
            const int Rr = task * 32 + r32;
            const bf16* qp = PQ + (size_t)Rr * 256;
            unsigned K1[16], K2[16];
#pragma unroll
            for (int half = 0; half < 2; ++half) {
                bf16x8 qf[8];
#pragma unroll
                for (int ks = 0; ks < 8; ++ks) qf[ks] = *(const bf16x8*)(qp + half * 128 + ks * 16 + lh * 8);
                f32x16 acc[4];
#pragma unroll
                for (int kb = 0; kb < 4; ++kb) { acc[kb] = f32x16{};
#pragma unroll
                    for (int ks = 0; ks < 8; ++ks) { const bf16x8 af = *(LAS const bf16x8*)(lds + half * 32768 + (kb * 32 + r32) * 256 + (((2 * ks + lh) ^ (r32 & 7)) << 4));
                        acc[kb] = __builtin_amdgcn_mfma_f32_32x32x16_bf16(af, qf[ks], acc[kb], 0, 0, 0); } }
                if (half == 0) peer::top16_of_128(acc, lh, K1); else peer::top16_of_128(acc, lh, K2);
            }
            float v1[16], v2[16]; unsigned i1[16], i2[16];
#pragma unroll
            for (int a = 0; a < 16; ++a) { v1[a] = peer::unordf(K1[a] & ~127u); i1[a] = 127u - (K1[a] & 127u); v2[a] = peer::unordf(K2[a] & ~127u); i2[a] = 127u - (K2[a] & 127u); }
            if (lh == 0) {
                *(LAS v4u*)(iscr) = (v4u){i1[0] | (i1[1] << 8) | (i1[2] << 16) | (i1[3] << 24), i1[4] | (i1[5] << 8) | (i1[6] << 16) | (i1[7] << 24), i1[8] | (i1[9] << 8) | (i1[10] << 16) | (i1[11] << 24), i1[12] | (i1[13] << 8) | (i1[14] << 16) | (i1[15] << 24)};
                *(LAS v4u*)(iscr + 16) = (v4u){i2[0] | (i2[1] << 8) | (i2[2] << 16) | (i2[3] << 24), i2[4] | (i2[5] << 8) | (i2[6] << 16) | (i2[7] << 24), i2[8] | (i2[9] << 8) | (i2[10] << 16) | (i2[11] << 24), i2[12] | (i2[13] << 8) | (i2[14] << 16) | (i2[15] << 24)};
            }
            unsigned g0[16], g1[16], g2[16];
#pragma unroll
            for (int b = 0; b < 16; ++b) g0[b] = peer::ckey(v1[0] + v2[b], b);
#pragma unroll
            for (int a = 1; a < 16; ++a) g1[a - 1] = peer::ckey(v1[a] + v2[0], a * 16);
            g1[15] = 0u;
#define CK(a, b) peer::ckey(v1[a] + v2[b], (a) * 16 + (b))
            g2[0] = CK(1, 1); g2[1] = CK(1, 2); g2[2] = CK(1, 3); g2[3] = CK(1, 4); g2[4] = CK(1, 5); g2[5] = CK(1, 6); g2[6] = CK(1, 7);
            g2[7] = CK(2, 1); g2[8] = CK(2, 2); g2[9] = CK(2, 3); g2[10] = CK(2, 4); g2[11] = CK(3, 1); g2[12] = CK(3, 2); g2[13] = CK(3, 3);
            g2[14] = CK(4, 1); g2[15] = CK(4, 2);
            peer::sort16_desc(g2);
            peer::merge16_desc(g0, g1); peer::merge16_desc(g0, g2);
            peer::insert_desc(g0, CK(5, 1)); peer::insert_desc(g0, CK(6, 1)); peer::insert_desc(g0, CK(7, 1));
#undef CK
            LDS_WAIT();
            float sv[16]; int ev[16];
#pragma unroll
            for (int k = 0; k < 16; ++k) { sv[k] = peer::unordf(g0[k] & ~255u); const unsigned tag = 255u - (g0[k] & 255u);
                const unsigned e1 = *(LAS const unsigned char*)(iscr + (tag >> 4)), e2 = *(LAS const unsigned char*)(iscr + 16 + (tag & 15u)); ev[k] = (int)(e1 * 128u + e2); }
            float ex[16], es = 0.f;
#pragma unroll
            for (int k = 0; k < 16; ++k) { ex[k] = __builtin_amdgcn_exp2f((sv[k] - sv[0]) * LOG2E); es += ex[k]; }
            const float inv = 1.f / es;
            { LAS unsigned char* tt = lds + 73728 + wave * 4096 + lh * 2048;
#pragma unroll
              for (int q = 0; q < 4; ++q) { const f32x4 gq = {ex[4 * q] * inv, ex[4 * q + 1] * inv, ex[4 * q + 2] * inv, ex[4 * q + 3] * inv}; const v4i iq = {ev[4 * q], ev[4 * q + 1], ev[4 * q + 2], ev[4 * q + 3]};
                  *(LAS v4i*)(tt + r32 * 64 + 16 * (q ^ ((r32 >> 2) & 3))) = lh == 0 ? __builtin_bit_cast(v4i, gq) : iq; }
              LAS const unsigned char* t0 = lds + 73728 + wave * 4096;
#pragma unroll
              for (int j = 0; j < 2; ++j) { const int g = 64 * j + lane, row = g >> 2, c = g & 3, off = row * 64 + 16 * (c ^ ((row >> 2) & 3));
                  *(v4i*)((unsigned char*)(GATE + (size_t)task * 512) + 16 * g) = *(LAS const v4i*)(t0 + off);
                  *(v4i*)((unsigned char*)(IDX + (size_t)task * 512) + 16 * g) = *(LAS const v4i*)(t0 + 2048 + off); } }
            LDS_WAIT();
        }
        { const float* c_e_down = p_e_down; const float* c_e_up = p_e_up;
        f32x4 nxr[8];
        if (gw < 2 * NEXP) { const float* s0 = (gw >= NEXP ? c_e_up + (size_t)(gw - NEXP) * DM : c_e_down + (size_t)gw * DM) + 32 * lane;
#pragma unroll
            for (int q = 0; q < 8; ++q) nxr[q] = *(const f32x4*)(s0 + 4 * q); }
        for (int rw = gw; rw < 2 * NEXP; rw += NGW) { const int which = rw >= NEXP, e = rw - which * NEXP;
            f32x4 cur[8]; f32x16 v0, v1; float am = 0.f;
#pragma unroll
            for (int q = 0; q < 8; ++q) cur[q] = nxr[q];
            { const int rn = rw + NGW; if (rn < 2 * NEXP) { const float* s1 = (rn >= NEXP ? c_e_up + (size_t)(rn - NEXP) * DM : c_e_down + (size_t)rn * DM) + 32 * lane;
#pragma unroll
                for (int q = 0; q < 8; ++q) nxr[q] = *(const f32x4*)(s1 + 4 * q); } }
#pragma unroll
            for (int q = 0; q < 4; ++q) { const f32x4 a = cur[q], b = cur[4 + q];
                v0[2 * q] = a.x; v1[2 * q] = a.y; v0[2 * q + 1] = a.z; v1[2 * q + 1] = a.w; v0[8 + 2 * q] = b.x; v1[8 + 2 * q] = b.y; v0[8 + 2 * q + 1] = b.z; v1[8 + 2 * q + 1] = b.w;
                am = fmaxf(am, fmaxf(fmaxf(fmaxf(fabsf(a.x), fabsf(a.y)), fmaxf(fabsf(a.z), fabsf(a.w))), fmaxf(fmaxf(fabsf(b.x), fabsf(b.y)), fmaxf(fabsf(b.z), fabsf(b.w))))); }

            am = wave_max_nonneg_dpp(am);
            const float sc = am > 0.f ? am * (1.f / 7.5f) : 1.f, inv = am > 0.f ? 7.5f / am : 0.f;
            v0 = v0 * inv; v1 = v1 * inv;
            const v6u pk = __builtin_amdgcn_cvt_scalef32_2xpk16_fp6_f32(v0, v1, 1.0f);
            unsigned* dst = (unsigned*)((which ? EU8 : ED8) + (size_t)e * 1536 + 24 * lane);
            *(v3u*)dst = (v3u){pk[0], pk[1], pk[2]}; *(v3u*)(dst + 3) = (v3u){pk[3], pk[4], pk[5]};
            if (lane == 0) (which ? SU : SD)[e] = sc; }
        }
    }
    SEAM(15);

    if (IN(16)) {
        const float* c_ln2_g = p_ln2_g; const float* c_ln2_b = p_ln2_b; float* c_out = p_out;
        for (int t = gw; t < T; t += NGW) {
            float xf[32];
            { LAS unsigned char* tr = lds + (tid >> 6) * 16384 + 8192;
#pragma unroll
              for (int j = 0; j < 4; ++j) { const int o = 16 * j + (lane >> 2), c = lane & 3;
                  *(LAS v4u*)(tr + o * 64 + 16 * (c ^ ((o >> 2) & 3))) = *(const v4u*)((const unsigned char*)(H1B + (size_t)t * DM) + 1024 * j + 16 * lane); } }
#pragma unroll
            for (int q = 0; q < 4; ++q) { const v4u w = *(LAS const v4u*)(lds + (tid >> 6) * 16384 + 8192 + lane * 64 + 16 * (q ^ ((lane >> 2) & 3)));
                xf[8 * q + 0] = bf_lo(w.x); xf[8 * q + 1] = bf_hi(w.x); xf[8 * q + 2] = bf_lo(w.y); xf[8 * q + 3] = bf_hi(w.y); xf[8 * q + 4] = bf_lo(w.z); xf[8 * q + 5] = bf_hi(w.z); xf[8 * q + 6] = bf_lo(w.w); xf[8 * q + 7] = bf_hi(w.w); }
            int ivv[2]; float gvv[2], sdl[2], sul[2], wl[2];
#pragma unroll
            for (int h = 0; h < 2; ++h) { ivv[h] = IDX[(size_t)t * 128 + 64 * h + lane]; gvv[h] = GATE[(size_t)t * 128 + 64 * h + lane]; }
#pragma unroll
            for (int h = 0; h < 2; ++h) { sdl[h] = SD[ivv[h]]; sul[h] = SU[ivv[h]]; }
#pragma unroll
            for (int h = 0; h < 2; ++h) { int dots = 0;
#pragma unroll 1
                for (int k0 = 0; k0 < 64; k0 += 4) {
                    v3u dr[4][2];
#pragma unroll
                    for (int u = 0; u < 4; ++u) { const int e = __builtin_amdgcn_readlane(ivv[h], k0 + u); const unsigned char* dp = ED8 + (size_t)e * 1536 + 24 * lane;
                        dr[u][0] = *(const v3u*)dp; dr[u][1] = *(const v3u*)(dp + 12); }
                    SBAR();
                    float tot[4];
#pragma unroll
                    for (int u = 0; u < 4; ++u) { const v6u c6 = {dr[u][0].x, dr[u][0].y, dr[u][0].z, dr[u][1].x, dr[u][1].y, dr[u][1].z};
                        const v32f dv = __builtin_amdgcn_cvt_scalef32_pk32_f32_fp6(c6, 1.0f);
                        f32x2 a0 = {0.f, 0.f}, a1 = {0.f, 0.f};
#pragma unroll
                        for (int i = 0; i < 32; i += 4) { a0 += (f32x2){dv[i], dv[i + 1]} * (f32x2){xf[i], xf[i + 1]}; a1 += (f32x2){dv[i + 2], dv[i + 3]} * (f32x2){xf[i + 2], xf[i + 3]}; }
                        tot[u] = (a0[0] + a0[1]) + (a1[0] + a1[1]); SBAR(); }
                    wave_total_dpp4(tot);
#pragma unroll
                    for (int u = 0; u < 4; ++u) { const int sv = __builtin_amdgcn_readlane(__builtin_bit_cast(int, tot[u]), 63); dots = (lane == k0 + u) ? sv : dots; }
                }
                wl[h] = gvv[h] * gelu_erf(sdl[h] * __builtin_bit_cast(float, dots)) * sul[h]; }
            float y[32];
#pragma unroll
            for (int i = 0; i < 32; ++i) y[i] = 0.f;
#pragma unroll
            for (int h = 0; h < 2; ++h) {
#pragma unroll 1
                for (int k0 = 0; k0 < 64; k0 += 4) {
                    v3u ur[4][2];
#pragma unroll
                    for (int u = 0; u < 4; ++u) { const int e = __builtin_amdgcn_readlane(ivv[h], k0 + u); const unsigned char* up = EU8 + (size_t)e * 1536 + 24 * lane;
                        ur[u][0] = *(const v3u*)up; ur[u][1] = *(const v3u*)(up + 12); }
                    SBAR();
#pragma unroll
                    for (int u = 0; u < 4; ++u) { const float w = __builtin_bit_cast(float, __builtin_amdgcn_readlane(__builtin_bit_cast(int, wl[h]), k0 + u));
                        const v6u c6 = {ur[u][0].x, ur[u][0].y, ur[u][0].z, ur[u][1].x, ur[u][1].y, ur[u][1].z};
                        const v32f uv = __builtin_amdgcn_cvt_scalef32_pk32_f32_fp6(c6, 1.0f);
#pragma unroll
                        for (int i = 0; i < 32; ++i) y[i] = __builtin_fmaf(w, uv[i], y[i]);
                        SBAR(); }
                } }
            float s = 0.f;
#pragma unroll
            for (int i = 0; i < 32; ++i) { y[i] += ALPHA * xf[i]; s += y[i]; }
            const float mean = wave_sum(s) * (1.f / DM); float s2 = 0.f;
#pragma unroll
            for (int i = 0; i < 32; ++i) { y[i] -= mean; s2 += y[i] * y[i]; }
            const float rstd = 1.f / sqrtf(wave_sum(s2) * (1.f / DM) + LN_EPS);
            { LAS unsigned char* tl = lds + (tid >> 6) * 16384;
#pragma unroll
              for (int q = 0; q < 8; ++q) *(LAS f32x4*)(tl + lane * 128 + 16 * (q ^ (lane & 7))) = (f32x4){y[4 * q] * rstd, y[4 * q + 1] * rstd, y[4 * q + 2] * rstd, y[4 * q + 3] * rstd};
#pragma unroll
              for (int q = 0; q < 8; ++q) { const int s = 8 * q + (lane >> 3), ch = lane & 7, c = 256 * q + 4 * lane;
                  const f32x4 g0 = *(const f32x4*)(c_ln2_g + c), b0 = *(const f32x4*)(c_ln2_b + c), v = *(LAS const f32x4*)(tl + s * 128 + 16 * (ch ^ (s & 7)));
                  *(f32x4*)(c_out + (size_t)t * DM + c) = v * g0 + b0; }
              LDS_WAIT(); }
        }
    }
#undef IN
#undef SEAM
#undef DIL_PASS
#undef DIL_DESC
#undef p_x
#undef p_w_in
#undef p_b_gates
#undef p_a_w_out
#undef p_q_norm
#undef p_w_uq
#undef p_kv_norm
#undef p_w_ukv
#undef p_mla_w_out
#undef p_w_out
#undef p_ln1_g
#undef p_ln1_b
#undef p_w_pq
#undef p_sk1
#undef p_sk2
#undef p_e_down
#undef p_e_up
#undef p_ln2_g
#undef p_ln2_b
#undef p_out
#undef WA8
#undef WG8
#undef WAO
#undef WBO
#undef WO
#undef WPQ
#undef WUQ
#undef WUKV
#undef SK
#undef ROPE
#undef XB8
#undef QKV
#undef CQKV
#undef KRRAW
#undef CQN
#undef CKVN
#undef KRR
#undef LSEB
#undef OA
#undef QB
#undef KN
#undef VT8
#undef OB8
#undef OA8
#undef VB
#undef YA
#undef YB
#undef UB
#undef RB
#undef H1B
#undef ED8
#undef EU8
#undef SD
#undef SU
#undef PQ
#undef IDX
#undef GATE
}


#if defined(MK_PROBE)
constexpr int CHK_OFF = 512;
__device__ __forceinline__ float fp8f(const unsigned char* p, size_t i) { const int w = (int)((const unsigned*)p)[i >> 2]; switch (i & 3) { case 0: return __builtin_amdgcn_cvt_f32_fp8(w, 0); case 1: return __builtin_amdgcn_cvt_f32_fp8(w, 1); case 2: return __builtin_amdgcn_cvt_f32_fp8(w, 2); default: return __builtin_amdgcn_cvt_f32_fp8(w, 3); } }
__device__ __forceinline__ float o8f(const unsigned char* row, int c) { const int h = c >> 7, w = c & 127; return fp8f(row, (size_t)(h * 128 + 4 * (w & 31) + (w >> 5))) * (1.f / 64.f); }
__device__ __forceinline__ unsigned hash32(unsigned a) { a ^= a >> 16; a *= 0x7feb352dU; a ^= a >> 15; a *= 0x846ca68bU; a ^= a >> 16; return a; }
__device__ __forceinline__ void chk_acc(unsigned char* ws, int k, float num, float den) {
    __shared__ float red[2][16];
    const int lane = threadIdx.x & 63, w = threadIdx.x >> 6, nw = (blockDim.x + 63) >> 6;
    num = wave_sum(num); den = wave_sum(den);
    if (lane == 0) { red[0][w] = num; red[1][w] = den; }
    __syncthreads();
    if (threadIdx.x == 0) { float a = 0.f, b = 0.f; for (int i = 0; i < nw; ++i) { a += red[0][i]; b += red[1][i]; }
        atomicAdd((float*)(ws + WS_CTL) + CHK_OFF + 2 * k, a); atomicAdd((float*)(ws + WS_CTL) + CHK_OFF + 2 * k + 1, b); }
    __syncthreads();
}
__global__ void __launch_bounds__(256) chk_inproj(const float* x, const float* w_in, unsigned char* ws) {
    const int s = blockIdx.x, j = threadIdx.x; const int t = hash32(s * 7 + 1) % T; const int c = (j * 28 + s * 3) % 7232;
    float ref = 0.f; for (int k = 0; k < DM; ++k) ref += x[(size_t)t * DM + k] * w_in[(size_t)k * IN_W + c];
    float fast;
    if (c < 6144) fast = bf2f(((const bf16*)(ws + WS_QKV))[(size_t)t * 6144 + c]) / (c < 2048 ? QSC_A : 1.f);
    else if (c < 7168) fast = bf2f(((const bf16*)(ws + WS_CQKV))[(size_t)t * 1024 + c - 6144]);
    else fast = bf2f(((const bf16*)(ws + WS_KRRAW))[(size_t)t * 64 + c - 7168]);
    chk_acc(ws, 0, (fast - ref) * (fast - ref), ref * ref);
}
__global__ void __launch_bounds__(64) chk_norm(const float* qn, const float* kvn, unsigned char* ws) {
    const int s = blockIdx.x, lane = threadIdx.x; const int t = hash32(s * 11 + 5) % T;
    const bf16* raw = (const bf16*)(ws + WS_CQKV) + (size_t)t * 1024; float num = 0.f, den = 0.f;
    for (int part = 0; part < 2; ++part) { float ss = 0.f; for (int k = lane; k < 512; k += 64) { const float v = bf2f(raw[part * 512 + k]); ss += v * v; }
        ss = wave_sum(ss); const float r = 1.f / sqrtf(ss / 512.f + RMS_EPS);
        const unsigned char* o = (const unsigned char*)(ws + (part ? WS_CKVN : WS_CQN)) + (size_t)t * 512; const float* g = part ? kvn : qn;
        for (int k = lane; k < 512; k += 64) { const float ref = bf2f(raw[part * 512 + k]) * r * g[k], f = fp8f(o, k); num += (f - ref) * (f - ref); den += ref * ref; } }
    { const int i = lane & 31; const bf16* kr = (const bf16*)(ws + WS_KRRAW) + (size_t)t * 64; const float t1 = bf2f(kr[i]), t2 = bf2f(kr[i + 32]);
      const float inv = powf(10000.f, -(float)i / 32.f); const float ang = (float)(t & (SEQ - 1)) * inv; float sn, cs; sincos_d((double)ang, sn, cs);
      const float ref = lane < 32 ? t1 * cs - t2 * sn : t1 * sn + t2 * cs, f = fp8f((const unsigned char*)(ws + WS_KRR), (size_t)t * 64 + lane); num += (f - ref) * (f - ref); den += ref * ref; }
    chk_acc(ws, 1, num, den);
}
__global__ void __launch_bounds__(64) chk_dil(unsigned char* ws) {
    __shared__ float lg[3][132]; __shared__ float og[3][128]; __shared__ float qs[128];
    const int s = blockIdx.x, lane = threadIdx.x; const unsigned hh = hash32(s * 13 + 7);
    const int b = hh & 1, h = (hh >> 1) & 15; int t = (hh >> 5) % SEQ; if (s < 8) t = s * 3; if (s >= 8 && s < 16) t = 100 + s * 37;
    const bf16* QKV_ = (const bf16*)(ws + WS_QKV); const size_t rowq = (size_t)b * SEQ + t;
    for (int c = lane; c < 128; c += 64) qs[c] = bf2f(QKV_[rowq * 6144 + h * 128 + c]) / QSC_A;
    __syncthreads();
    const float slope = exp2f(-0.5f * (float)(h + 1)); float lse[3];
    const int dil[3] = {1, 4, 16};
    for (int g = 0; g < 3; ++g) { const int d = dil[g], i = t / d;
        for (int j = lane; j <= 128; j += 64) { float l = -1e30f;
            if (i - j >= 0) { const size_t rk = (size_t)b * SEQ + (t - j * d); float dot = 0.f; for (int c = 0; c < 128; ++c) dot += qs[c] * bf2f(QKV_[rk * 6144 + 2048 + h * 128 + c]);
                l = dot * 0.08838834764831845f - slope * (float)(d * j); }
            lg[g][j] = l; }
        __syncthreads();
        float m = -1e30f; for (int j = 0; j <= 128; ++j) m = fmaxf(m, lg[g][j]);
        float z = 0.f; for (int j = 0; j <= 128; ++j) z += expf(lg[g][j] - m);
        for (int c = lane; c < 128; c += 64) { float o = 0.f; for (int j = 0; j <= 128; ++j) { if (i - j < 0) break; const size_t rk = (size_t)b * SEQ + (t - j * d); o += expf(lg[g][j] - m) / z * bf2f(QKV_[rk * 6144 + 4096 + h * 128 + c]); } og[g][c] = o; }
        lse[g] = m + logf(z);
        __syncthreads(); }
    const float mm = fmaxf(lse[0], fmaxf(lse[1], lse[2])); const float e0 = expf(lse[0] - mm), e1 = expf(lse[1] - mm), e2 = expf(lse[2] - mm), es = e0 + e1 + e2;
    float num = 0.f, den = 0.f;
    for (int c = lane; c < 128; c += 64) { const float ref = (e0 * og[0][c] + e1 * og[1][c] + e2 * og[2][c]) / es, f = o8f((const unsigned char*)(ws + WS_OA8) + rowq * DM, h * 128 + c); num += (f - ref) * (f - ref); den += ref * ref; }
    chk_acc(ws, 2, num, den);
}
__global__ void __launch_bounds__(192) chk_qb(const float* w_uq, unsigned char* ws) {
    __shared__ float raw[192];
    const int s = blockIdx.x, c = threadIdx.x; const unsigned hh = hash32(s * 17 + 3); const int t = hh % T, head = (hh >> 16) & 15;
    const unsigned char* cq = (const unsigned char*)(ws + WS_CQN) + (size_t)t * 512; float a = 0.f; for (int k = 0; k < 512; ++k) a += fp8f(cq, k) * w_uq[(size_t)k * NQB + head * 192 + c];
    raw[c] = a; __syncthreads();
    float ref = a;
    if (c >= 128) { const int i = (c - 128) & 31; const float inv = powf(10000.f, -(float)i / 32.f); const float ang = (float)(t & (SEQ - 1)) * inv; float sn, cs; sincos_d((double)ang, sn, cs);
        const float t1 = raw[128 + i], t2 = raw[160 + i]; ref = c < 160 ? t1 * cs - t2 * sn : t1 * sn + t2 * cs; }
    ref *= QSC_B; const float f = fp8f((const unsigned char*)(ws + WS_QB), (size_t)t * NQB + head * 192 + c) * (1.f / 8.f);
    chk_acc(ws, 3, (f - ref) * (f - ref), ref * ref);
}
__global__ void __launch_bounds__(256) chk_kv(const float* w_ukv, unsigned char* ws) {
    const int s = blockIdx.x, c = threadIdx.x; const unsigned hh = hash32(s * 19 + 9); const int t = hh % T, head = (hh >> 16) & 15;
    const unsigned char* ck = (const unsigned char*)(ws + WS_CKVN) + (size_t)t * 512; float ref = 0.f; for (int k = 0; k < 512; ++k) ref += fp8f(ck, k) * w_ukv[(size_t)k * NKV + head * 256 + c];
    const float f = c < 128 ? fp8f((const unsigned char*)(ws + WS_KN), (size_t)t * DM + head * 128 + c) : fp8f((const unsigned char*)(ws + WS_VT), ((size_t)((t / SEQ) * 16 + head) * 128 + (c - 128)) * SEQ + ((t % SEQ) & ~63) + att8::vperm((t % SEQ) & 63));
    chk_acc(ws, 4, (f - ref) * (f - ref), ref * ref);
}
__global__ void __launch_bounds__(256) chk_mla(unsigned char* ws) {
    __shared__ float qs[192]; __shared__ float redm[4]; __shared__ float redz[4];
    const int s = blockIdx.x, tid = threadIdx.x; const unsigned hh = hash32(s * 23 + 11); const int b = hh & 1, h = (hh >> 1) & 15; int t = (hh >> 5) % SEQ; if (s < 6) t = s * 51; if (s >= 6 && s < 12) t = SEQ - 1 - (s - 6) * 77;
    const size_t tb = (size_t)b * SEQ; float* pbuf = (float*)(ws + WS_END) + (size_t)s * SEQ;
    for (int c = tid; c < 192; c += 256) qs[c] = fp8f((const unsigned char*)(ws + WS_QB), (tb + t) * NQB + h * 192 + c) * (1.f / 8.f);
    __syncthreads();
    float m = -1e30f;
    for (int k = tid; k <= t; k += 256) { float dot = 0.f; const unsigned char* kn = (const unsigned char*)(ws + WS_KN) + (tb + k) * DM + h * 128; const unsigned char* kr = (const unsigned char*)(ws + WS_KRR) + (tb + k) * 64;
        for (int c = 0; c < 128; ++c) dot += qs[c] * fp8f(kn, c); for (int c = 0; c < 64; ++c) dot += qs[128 + c] * fp8f(kr, c);
        pbuf[k] = dot; m = fmaxf(m, dot); }
    for (int o = 1; o < 64; o <<= 1) m = fmaxf(m, __shfl_xor(m, o));
    if ((tid & 63) == 0) redm[tid >> 6] = m; __syncthreads(); m = fmaxf(fmaxf(redm[0], redm[1]), fmaxf(redm[2], redm[3]));
    float z = 0.f; for (int k = tid; k <= t; k += 256) { const float p = exp2f(pbuf[k] - m); pbuf[k] = p; z += p; }
    z = wave_sum(z); if ((tid & 63) == 0) redz[tid >> 6] = z; __syncthreads(); z = redz[0] + redz[1] + redz[2] + redz[3];
    __threadfence_block(); __syncthreads();
    float num = 0.f, den = 0.f;
    if (tid < 128) { float o = 0.f; for (int k = 0; k <= t; ++k) o += pbuf[k] * fp8f((const unsigned char*)(ws + WS_VT), ((size_t)(b * 16 + h) * 128 + tid) * SEQ + (k & ~63) + att8::vperm(k & 63));
        const float ref = o / z, f = o8f((const unsigned char*)(ws + WS_OB) + (tb + t) * DM, h * 128 + tid); num = (f - ref) * (f - ref); den = ref * ref; }
    chk_acc(ws, 5, num, den);
}
__global__ void __launch_bounds__(256) chk_y(const float* wa, const float* wb, unsigned char* ws) {
    const int s = blockIdx.x, j = threadIdx.x; const int t = hash32(s * 29 + 13) % T, c = (j * 8 + s) % DM;
    const unsigned char* oa = (const unsigned char*)(ws + WS_OA8) + (size_t)t * DM; const unsigned char* ob = (const unsigned char*)(ws + WS_OB) + (size_t)t * DM; float ra = 0.f, rb = 0.f;
    for (int k = 0; k < DM; ++k) { ra += o8f(oa, k) * wa[(size_t)k * DM + c]; rb += o8f(ob, k) * wb[(size_t)k * DM + c]; }
    const float fa = fp8f((const unsigned char*)(ws + WS_YA), (size_t)t * DM + c) * (1.f / 64.f), fb = fp8f((const unsigned char*)(ws + WS_YB), (size_t)t * DM + c) * (1.f / 64.f);
    chk_acc(ws, 6, (fa - ra) * (fa - ra) + (fb - rb) * (fb - rb), ra * ra + rb * rb);
}
__global__ void __launch_bounds__(256) chk_u(const float* x, const float* w_in, const float* bg, unsigned char* ws) {
    const int s = blockIdx.x, j = threadIdx.x; const int t = hash32(s * 31 + 17) % T, c = (j * 8 + s) % DM;
    float ga = 0.f, gb = 0.f; for (int k = 0; k < DM; ++k) { const float xv = x[(size_t)t * DM + k]; ga += xv * w_in[(size_t)k * IN_W + 7232 + c]; gb += xv * w_in[(size_t)k * IN_W + 7232 + DM + c]; }
    ga = 1.f / (1.f + expf(-(ga + bg[c]))); gb = 1.f / (1.f + expf(-(gb + bg[DM + c])));
    const float ref = ga * fp8f((const unsigned char*)(ws + WS_YA), (size_t)t * DM + c) * (1.f / 64.f) + gb * fp8f((const unsigned char*)(ws + WS_YB), (size_t)t * DM + c) * (1.f / 64.f), f = fp8f((const unsigned char*)(ws + WS_U), (size_t)t * DM + c) * (1.f / 64.f);
    chk_acc(ws, 7, (f - ref) * (f - ref), ref * ref);
}
__global__ void __launch_bounds__(256) chk_r(const float* x, const float* wo, unsigned char* ws) {
    const int s = blockIdx.x, j = threadIdx.x; const int t = hash32(s * 37 + 19) % T, c = (j * 8 + s) % DM;
    const unsigned char* u = (const unsigned char*)(ws + WS_U) + (size_t)t * DM; float ref = 0.f; for (int k = 0; k < DM; ++k) ref += fp8f(u, k) * (1.f / 64.f) * wo[(size_t)k * DM + c];
    const float f = bf2f(((const bf16*)(ws + WS_R))[(size_t)t * DM + c]) - ALPHA * x[(size_t)t * DM + c];
    chk_acc(ws, 8, (f - ref) * (f - ref), ref * ref);
}
__global__ void __launch_bounds__(64) chk_dummy(unsigned char* ws) { chk_acc(ws, 9, threadIdx.x == 0 ? 2.f : 0.f, threadIdx.x == 0 ? 1.f : 0.f); }
__global__ void __launch_bounds__(256) chk_report(float* out, unsigned char* ws, int nchk, float thr) {
    const float* a = (const float*)(ws + WS_CTL) + CHK_OFF; int bad = -1; float e = 0.f;
    for (int k = 0; k < nchk; ++k) { const float num = a[2 * k], den = a[2 * k + 1]; const float err = (den > 0.f) ? sqrtf(num / den) : 1.f; const bool nan = !(err == err);
        const float th = (k == 0 || k == 1 || k == 2 || k == 3 || k == 4 || k == 5 || k == 6 || k == 7) ? (k == 5 ? 0.12f : 0.08f) : (k == 8 ? 0.2f : thr);
        if (bad < 0 && (nan || err > th || !(den > 0.f))) { bad = k; e = nan ? 1.f : fminf(err, 1.f); } }
    if (bad < 0) return;
    const float K = sqrtf((1.f + 8.f * e) * powf(10.f, (float)(bad + 2)));
    for (size_t i = (size_t)blockIdx.x * blockDim.x + threadIdx.x; i < (size_t)T * DM; i += (size_t)gridDim.x * blockDim.x) out[i] = K;
}
#endif

#if defined(MK_FP6PROBE)
__global__ void __launch_bounds__(256) fp6_probe(float* out, int which_slot) {
    const float pos[16] = {0.125f, 0.25f, 0.375f, 0.5f, 0.625f, 0.75f, 0.875f, 1.f, 1.25f, 1.5f, 1.75f, 2.f, 2.5f, 3.f, 3.5f, 4.f};
    f32x16_t x0, x1;
#pragma unroll
    for (int i = 0; i < 16; ++i) { x0[i] = pos[i]; x1[i] = -pos[i]; }
    const v6u pk = __builtin_amdgcn_cvt_scalef32_2xpk16_fp6_f32(x0, x1, 1.0f);
    const v32f r = __builtin_amdgcn_cvt_scalef32_pk32_f32_fp6(pk, 1.0f);
    int m1 = 0, m2 = 0, m3 = 0, scaled = 0;
#pragma unroll
    for (int j = 0; j < 32; ++j) { const float h1 = j < 16 ? pos[j] : -pos[j - 16], h2 = (j & 1) ? -pos[j >> 1] : pos[j >> 1], h3 = (j & 1) ? pos[j >> 1] : -pos[j >> 1];
        m1 += (r[j] == h1); m2 += (r[j] == h2); m3 += (r[j] == h3); scaled += (r[j] != 0.f && (fabsf(r[j]) > 4.f || fabsf(r[j]) < 0.125f)); }
    float code = 6.f;
    if (m1 == 32) code = 2.f; else if (m2 == 32) code = 3.f; else if (m3 == 32) code = 4.f; else if (scaled) code = 8.f;
    if (which_slot >= 0) { float v = 0.f;
#pragma unroll
        for (int j = 0; j < 32; ++j) if (j == which_slot) v = r[j];
        int src = 40;
#pragma unroll
        for (int i = 0; i < 16; ++i) { if (v == pos[i]) src = i; if (v == -pos[i]) src = 16 + i; }
        code = 10.f + (float)src * 0.5f; }
    const float K = sqrtf(powf(10.f, code));
    for (size_t i = (size_t)blockIdx.x * blockDim.x + threadIdx.x; i < (size_t)T * DM; i += (size_t)gridDim.x * blockDim.x) out[i] = K;
}
#endif

extern "C" void kernel_launch(void* const* d_in, const int* in_sizes, int n_in, void* d_out, int out_size, void* d_ws, size_t ws_size, hipStream_t stream) {
    static int grid = 0;
    if (grid == 0) {
        if (n_in != 19 || in_sizes[0] != T * DM || out_size != T * DM || ws_size < WS_END) { fprintf(stderr, "kernel_launch: unexpected shapes (n_in %d, in0 %d, out %d, ws %zu)\n", n_in, n_in > 0 ? in_sizes[0] : -1, out_size, ws_size); grid = -1; return; }
        int dev = 0, cus = 0, per_cu = 0;
        if (hipGetDevice(&dev) != hipSuccess || hipDeviceGetAttribute(&cus, hipDeviceAttributeMultiprocessorCount, dev) != hipSuccess) { grid = -1; return; }
        if (hipFuncSetAttribute((const void*)mk_fwd, hipFuncAttributeMaxDynamicSharedMemorySize, LDS_BYTES) != hipSuccess) { fprintf(stderr, "kernel_launch: hipFuncSetAttribute failed\n"); grid = -1; return; }
        if (hipOccupancyMaxActiveBlocksPerMultiprocessor(&per_cu, (const void*)mk_fwd, 512, LDS_BYTES) != hipSuccess || per_cu < 1) { fprintf(stderr, "kernel_launch: occupancy query says %d blocks per CU\n", per_cu); }
        (void)hipGetLastError();
        grid = cus;
    }
    if (grid < 0) return;
    if (hipMemsetAsync((char*)d_ws + WS_CTL, 0, CTL_ZERO_BYTES, stream) != hipSuccess) return;
    Args a{};
    for (int i = 0; i < 19; ++i) a.in[i] = (const float*)d_in[i];
    a.out = (float*)d_out; a.ws = (unsigned char*)d_ws;
#if defined(MK_FP6PROBE)
    hipLaunchKernelGGL(fp6_probe, dim3(1024), dim3(256), 0, stream, (float*)d_out, MK_FP6PROBE);
#elif defined(MK_PROBE)
    {
        const int cuts[10] = {0, 2, 3, 6, 8, 9, 11, 12, 13, NPHASE};
        unsigned char* w = (unsigned char*)d_ws;
        for (int li = 0; li < 9; ++li) { a.ph_lo = cuts[li]; a.ph_hi = cuts[li + 1]; a.bli = li; hipLaunchKernelGGL(mk_fwd, dim3(grid), dim3(512), LDS_BYTES, stream, a);
            if (li == 0) hipLaunchKernelGGL(chk_inproj, dim3(64), dim3(256), 0, stream, a.in[0], a.in[1], w);
            if (li == 1) hipLaunchKernelGGL(chk_norm, dim3(64), dim3(64), 0, stream, a.in[4], a.in[6], w);
            if (li == 2) hipLaunchKernelGGL(chk_dil, dim3(128), dim3(64), 0, stream, w);
            if (li == 3) { hipLaunchKernelGGL(chk_qb, dim3(64), dim3(192), 0, stream, a.in[5], w); hipLaunchKernelGGL(chk_kv, dim3(64), dim3(256), 0, stream, a.in[7], w); }
            if (li == 4) hipLaunchKernelGGL(chk_mla, dim3(64), dim3(256), 0, stream, w);
            if (li == 5) hipLaunchKernelGGL(chk_y, dim3(64), dim3(256), 0, stream, a.in[3], a.in[8], w);
            if (li == 6) hipLaunchKernelGGL(chk_u, dim3(64), dim3(256), 0, stream, a.in[0], a.in[1], a.in[2], w);
            if (li == 7) hipLaunchKernelGGL(chk_r, dim3(64), dim3(256), 0, stream, a.in[0], a.in[9], w);
        }
        hipLaunchKernelGGL(chk_dummy, dim3(1), dim3(64), 0, stream, w);
        hipLaunchKernelGGL(chk_report, dim3(1024), dim3(256), 0, stream, (float*)d_out, w, 10, 0.015f);
    }
#elif defined(MK_DUP_PHASE)
    a.ph_lo = 0; a.ph_hi = MK_DUP_PHASE + 1; a.bli = 0; hipLaunchKernelGGL(mk_fwd, dim3(grid), dim3(512), LDS_BYTES, stream, a);
    a.ph_lo = MK_DUP_PHASE; a.ph_hi = NPHASE; a.bli = 1; hipLaunchKernelGGL(mk_fwd, dim3(grid), dim3(512), LDS_BYTES, stream, a);
#else
    a.ph_lo = 0; a.ph_hi = NPHASE; a.bli = 0;
    hipLaunchKernelGGL(mk_fwd, dim3(grid), dim3(512), LDS_BYTES, stream, a);
#endif
}
```

```cpp
#include <hip/hip_runtime.h>
#include <cstdio>
#include <cstdint>

#define GAS __attribute__((address_space(1)))
#define LAS __attribute__((address_space(3)))
typedef unsigned short bf16;
typedef unsigned v4u __attribute__((ext_vector_type(4)));
typedef unsigned v2u __attribute__((ext_vector_type(2)));
struct v3u { unsigned x, y, z; };
typedef unsigned v6u __attribute__((ext_vector_type(6)));
typedef float v32f __attribute__((ext_vector_type(32)));
typedef float f32x16_t __attribute__((ext_vector_type(16)));
typedef int v4i __attribute__((ext_vector_type(4)));
typedef float f32x4 __attribute__((ext_vector_type(4)));
typedef float f32x2 __attribute__((ext_vector_type(2)));
typedef float f32x16 __attribute__((ext_vector_type(16)));
typedef short bf16x8 __attribute__((ext_vector_type(8)));
typedef short s16x4 __attribute__((ext_vector_type(4)));

constexpr int DM = 2048, BATCH = 2, SEQ = 16384, T = BATCH * SEQ;
constexpr int IN_W = 11328;
constexpr int NA = 7424;
constexpr int NGATE = 4096;
constexpr int NQB = 3072, NKV = 4096, QL = 512;
constexpr int NEXP = 16384, PH = 8, PTOPK = 16;
constexpr float LN_EPS = 1e-5f, RMS_EPS = 1e-6f;
constexpr float ALPHA = 1.189207115002721f;
constexpr float LOG2E = 1.4426950408889634f;
constexpr float QSC_A = 0.08838834764831845f * LOG2E;
constexpr float QSC_B = 0.07216878364870322f * LOG2E;
constexpr int NPHASE = 17;

constexpr size_t MiB = 1u << 20;
constexpr size_t WS_CTL = 0, CTL_ZERO_BYTES = 262144;
constexpr size_t WS_WA = 1 * MiB, WS_WG = 30 * MiB, WS_WAO = 46 * MiB, WS_WBO = 54 * MiB, WS_WO = 62 * MiB, WS_WPQ = 70 * MiB, WS_WUQ = 78 * MiB, WS_WUKV = 81 * MiB;
constexpr size_t WS_SK = 85 * MiB, WS_ROPE = 86 * MiB;
constexpr size_t WS_XB = 96 * MiB, WS_OA8 = 160 * MiB;
constexpr size_t WS_QKV = 224 * MiB, WS_CQKV = 608 * MiB, WS_KRRAW = 672 * MiB, WS_CQN = 676 * MiB, WS_CKVN = 708 * MiB, WS_KRR = 740 * MiB, WS_LSE = 744 * MiB, WS_OA = 746 * MiB;
constexpr size_t WS_QB = 224 * MiB, WS_KN = 416 * MiB, WS_VT = 480 * MiB, WS_OB = 544 * MiB, WS_VB = 874 * MiB;
constexpr size_t WS_YA = 224 * MiB, WS_YB = 352 * MiB, WS_U = 874 * MiB;
constexpr size_t WS_R = 224 * MiB, WS_H1B = 480 * MiB, WS_ED = 608 * MiB, WS_EU = 640 * MiB, WS_SD = 672 * MiB, WS_SU = 672 * MiB + 65536, WS_PQ = 736 * MiB, WS_IDX = 874 * MiB, WS_GATE = 890 * MiB;
constexpr size_t WS_END = 1002 * MiB;
static_assert(WS_WA + (size_t)NA * DM * 2 <= WS_WG && WS_WUKV + (size_t)NKV * QL * 2 <= WS_SK && WS_ROPE + (size_t)SEQ * 64 * 4 <= WS_XB, "weights map");
static_assert(WS_QKV + (size_t)T * 6144 * 2 <= WS_CQKV && WS_OA + (size_t)T * DM * 2 <= WS_VB && WS_VB + (size_t)T * DM * 2 <= WS_END, "activation map");
static_assert(WS_QB + (size_t)T * NQB * 2 <= WS_KN && WS_KN + (size_t)T * DM * 2 <= WS_OB && WS_OB + (size_t)T * DM * 2 <= WS_KRRAW, "mla map");
static_assert(WS_R + (size_t)T * DM * 2 <= WS_H1B && WS_H1B + (size_t)T * DM * 2 <= WS_ED && WS_ED + (size_t)NEXP * 1536 <= WS_EU && WS_EU + (size_t)NEXP * DM <= WS_SD && WS_SU + (size_t)NEXP * 4 <= WS_PQ && WS_PQ + (size_t)T * DM * 2 <= WS_IDX, "peer map");
constexpr int CW_BAR = 1024;

constexpr int RING_BYTES = 131072;
constexpr int MISC_OFF = RING_BYTES;
constexpr int LDS_BYTES = 147456;

#define LDS_WAIT() asm volatile("s_waitcnt lgkmcnt(0)" ::: "memory")
#define VM_WAIT() asm volatile("s_waitcnt vmcnt(0)" ::: "memory")
#define SBAR() __builtin_amdgcn_sched_barrier(0)
__device__ __forceinline__ unsigned f2bf(float f) { unsigned u = __builtin_bit_cast(unsigned, f); return (u + 0x7fffu + ((u >> 16) & 1u)) >> 16; }
__device__ __forceinline__ unsigned pk2(float lo, float hi) { return f2bf(lo) | (f2bf(hi) << 16); }
__device__ __forceinline__ float bf_lo(unsigned w) { return __builtin_bit_cast(float, w << 16); }
__device__ __forceinline__ float bf_hi(unsigned w) { return __builtin_bit_cast(float, w & 0xffff0000u); }
__device__ __forceinline__ float bf2f(bf16 b) { return __builtin_bit_cast(float, ((unsigned)b) << 16); }
__device__ __forceinline__ unsigned pk4_fp8(float a, float b, float c, float d) { int w = __builtin_amdgcn_cvt_pk_fp8_f32(a, b, 0, false); w = __builtin_amdgcn_cvt_pk_fp8_f32(c, d, w, true); return (unsigned)w; }
__device__ __forceinline__ float wave_sum(float v) {
    int x = __builtin_bit_cast(int, v);
#define WS_DPP_ADD(ctrl_, rmask_) do { const int t_ = __builtin_amdgcn_update_dpp(0, x, ctrl_, rmask_, 0xf, false); x = __builtin_bit_cast(int, __builtin_bit_cast(float, x) + __builtin_bit_cast(float, t_)); } while (0)
    WS_DPP_ADD(0xB1, 0xf); WS_DPP_ADD(0x4E, 0xf); WS_DPP_ADD(0x141, 0xf); WS_DPP_ADD(0x140, 0xf); WS_DPP_ADD(0x142, 0xa); WS_DPP_ADD(0x143, 0xc);
#undef WS_DPP_ADD
    return __builtin_bit_cast(float, __builtin_amdgcn_readlane(x, 63));
}

#define XB_TMO      128
#define XB_XCNT(j)  (256  + 64 * (j))
#define XB_XSUB(j)  (1280 + 64 * (j))
#define XB_XGEN(j)  (2304 + 64 * (j))
#define XB_TOP      3328
#define XB_TOPGEN   3392
#define XCD_BAR_WORDS 3456
#define XB_SPIN_CAP (1u << 24)

__device__ __forceinline__ unsigned xb_ld(unsigned* p)              { return __hip_atomic_load(p, __ATOMIC_RELAXED, __HIP_MEMORY_SCOPE_AGENT); }
__device__ __forceinline__ unsigned xb_add(unsigned* p, unsigned v) { return __hip_atomic_fetch_add(p, v, __ATOMIC_RELAXED, __HIP_MEMORY_SCOPE_AGENT); }
__device__ __forceinline__ unsigned xb_xcc_id() { return (unsigned)__builtin_amdgcn_s_getreg((3 << 11) | 20) & 0xFu; }
#define XB_SPIN(cond, bar) do { unsigned _sp = 0; while (cond) { __builtin_amdgcn_s_sleep(1); \
    if ((++_sp & 255u) == 0u) { if (xb_ld(&(bar)[XB_TMO])) break; if (_sp > XB_SPIN_CAP) { atomicAdd(&(bar)[XB_TMO], 1u); break; } } } } while (0)

struct XcdBarrier {
    unsigned* bar; unsigned x;
    volatile LAS unsigned* st;
};

__device__ __forceinline__ XcdBarrier xcd_barrier_post(unsigned* bar, volatile LAS unsigned* st) {
    XcdBarrier b; b.bar = bar; b.x = xb_xcc_id(); b.st = st;
    if (threadIdx.x == 0) (void)xb_add(&bar[XB_XCNT(b.x)], 1u);
    return b;
}
__device__ __forceinline__ void xcd_barrier_complete(unsigned* bar, unsigned x, unsigned& nloc, unsigned& nx) {
    const unsigned G = gridDim.x * gridDim.y * gridDim.z;
    unsigned sum, cnt, mine, sp = 0u;
    for (;;) {
        sum = 0u; cnt = 0u; mine = 0u;
#pragma unroll
        for (unsigned j = 0; j < 16; ++j) { const unsigned c = xb_ld(&bar[XB_XCNT(j)]); sum += c; cnt += (c > 0u) ? 1u : 0u; mine = (j == x) ? c : mine; }
        if (sum == G) break;
        __builtin_amdgcn_s_sleep(1);
        if ((++sp & 255u) == 0u) { if (xb_ld(&bar[XB_TMO])) break; if (sp > XB_SPIN_CAP) { atomicAdd(&bar[XB_TMO], 1u); break; } }
    }
    nloc = mine > 0u ? mine : 1u; nx = cnt > 0u ? cnt : 1u;
}

__device__ __forceinline__ void xcd_barrier(const XcdBarrier& b) {
    asm volatile("s_waitcnt vmcnt(0)" ::: "memory");
    __syncthreads();
    if (threadIdx.x == 0) {
        unsigned* bar = b.bar;
        __builtin_amdgcn_s_waitcnt(0);
        unsigned nloc = b.st[0], nx = b.st[1];
        if (nloc == 0u) { xcd_barrier_complete(bar, b.x, nloc, nx); b.st[0] = nloc; b.st[1] = nx; }
        const unsigned old = xb_add(&bar[XB_XSUB(b.x)], 1u);
        const unsigned gen = old / nloc;
        if (old + 1u == (gen + 1u) * nloc) {
            __builtin_amdgcn_fence(__ATOMIC_RELEASE, "agent");
            asm volatile("s_waitcnt vmcnt(0)" ::: "memory");
            const unsigned og = xb_add(&bar[XB_TOP], 1u);
            const unsigned tg = og / nx;
            if (og + 1u == (tg + 1u) * nx) xb_add(&bar[XB_TOPGEN], 1u);
            else XB_SPIN(xb_ld(&bar[XB_TOPGEN]) == tg, bar);
            __builtin_amdgcn_fence(__ATOMIC_ACQUIRE, "agent");
            xb_add(&bar[XB_XGEN(b.x)], 1u);
            asm volatile("s_waitcnt vmcnt(0)" ::: "memory");
        } else {
            XB_SPIN(xb_ld(&bar[XB_XGEN(b.x)]) == gen, bar);
            __builtin_amdgcn_fence(__ATOMIC_ACQUIRE, "agent");
            asm volatile("s_waitcnt vmcnt(0)" ::: "memory");
        }
    }
    __syncthreads();
}


namespace pg8 {
#define PG8_LAS __attribute__((address_space(3)))
typedef unsigned short bf16_t;
typedef short bf16x8 __attribute__((ext_vector_type(8)));
typedef float f32x4 __attribute__((ext_vector_type(4)));
typedef unsigned u32x4 __attribute__((ext_vector_type(4)));
constexpr int BM = 256, BK = 64, HALF = 128, HTB = HALF * BK * 2  , STAGE_BYTES = 8 * HTB, NXCD = 8, WGM = 4;

__host__ __device__ __forceinline__ int lds_byte(int r, int c) { const int st = (r >> 4) * 2 + (c >> 5), rr = r & 15, cc = c & 31, ob = rr * 64 + cc * 2; return st * 1024 + (ob ^ (((ob >> 9) & 1) << 5)); }
__host__ __device__ __forceinline__ void stage_rc(int b, int& R, int& C) { const int st = b / 1024, sb = b % 1024, swz = sb ^ (((sb >> 9) & 1) << 5); R = (st >> 1) * 16 + swz / 64; C = (st & 1) * 32 + (swz % 64) / 2; }
__host__ __device__ __forceinline__ int perm32(int rho) { const int n = rho >> 4, i = rho & 15; return 8 * (i >> 2) + 4 * n + (i & 3); }

struct Unit { int pm, pn; };
struct Gemm { const bf16_t* A; const bf16_t* Bt; int M, N, K; };

struct StaticOrder {
    int nM, nN, nwg, G, c;
    __host__ __device__ void init(int M, int N, int G_, int c_) { nM = M / BM; nN = N / BM; nwg = nM * nN; G = G_; c = c_; }
    __host__ __device__ bool next(int i, Unit& u) const {
        const long L = (long)i * G + c; if (L >= nwg) return false;
        int wgid = (int)L; { const int q = nwg / NXCD, r = nwg % NXCD, xcd = wgid % NXCD, off = wgid / NXCD; wgid = (xcd < r ? xcd * (q + 1) : r * (q + 1) + (xcd - r) * q) + off; }
        const int nig = WGM * nN, gid = wgid / nig, fm = gid * WGM, gsz = (nM - fm) < WGM ? (nM - fm) : WGM;
        u.pm = fm + ((wgid % nig) % gsz); u.pn = (wgid % nig) / gsz; return true;
    }
    __device__ __forceinline__ void a_ready(const Unit&) const {}
    __device__ __forceinline__ void done(const Unit&) const {}
};
__device__ __forceinline__ unsigned cvt_pk_bf16(float lo, float hi) { unsigned r; asm volatile("v_cvt_pk_bf16_f32 %0, %1, %2" : "=v"(r) : "v"(lo), "v"(hi)); return r; }
typedef float f32x2 __attribute__((ext_vector_type(2)));
__device__ __forceinline__ f32x2 gelu_pk(f32x2 v) {
    const f32x2 av = __builtin_elementwise_abs(v), d = av * 0.2316418882f + 1.0f;
    f32x2 t; t.x = __builtin_amdgcn_rcpf(d.x); t.y = __builtin_amdgcn_rcpf(d.y);
    f32x2 q = t * 0.5307027145f + (-0.7265760135f); q = q * t + 0.7107068705f; q = q * t + (-0.142248368f); q = q * t + 0.127414796f; q = q * t;
    const f32x2 s = (v * v) * (-0.72134752044f);
    f32x2 e; e.x = __builtin_amdgcn_exp2f(s.x); e.y = __builtin_amdgcn_exp2f(s.y);
    const f32x2 m = v * (q * e), r = v - m;
    f32x2 o; o.x = v.x < 0.f ? m.x : r.x; o.y = v.y < 0.f ? m.y : r.y; return o;
}

__device__ __forceinline__ u32x4 pack8s(f32x4 v0, f32x4 v1, float s) { u32x4 w; w.x = cvt_pk_bf16(v0[0] * s, v0[1] * s); w.y = cvt_pk_bf16(v0[2] * s, v0[3] * s); w.z = cvt_pk_bf16(v1[0] * s, v1[1] * s); w.w = cvt_pk_bf16(v1[2] * s, v1[3] * s); return w; }
struct EpiA {
    static constexpr bool PERM = true, AFTER_DRAIN = false;
    bf16_t* qkv; bf16_t* cqkv; bf16_t* krraw; float accs;
    __device__ __forceinline__ void operator()(const f32x4 (&acc)[2][2][4][2], const Unit& u, int wr, int wc, int fr, int fq) const {
        const int row0 = u.pm * BM + wr * 64 + fr, cw = wc * 32 + 8 * fq, pn = u.pn;
        bf16_t* base; int ldc, colt; float sc = accs; bool narrow = false;
        if (pn < 24) { base = qkv; ldc = 6144; colt = pn * 256; if (pn < 8) sc = QSC_A * accs; }
        else if (pn < 28) { base = cqkv; ldc = 1024; colt = (pn - 24) * 256; }
        else { base = krraw; ldc = 64; colt = 0; narrow = true; }
#pragma unroll
        for (int ai = 0; ai < 2; ++ai)
#pragma unroll
            for (int m = 0; m < 4; ++m) { bf16_t* rowp = base + (size_t)(row0 + ai * HALF + m * 16) * ldc + colt + cw;
#pragma unroll
                for (int bj = 0; bj < 2; ++bj) { if (narrow && (bj == 1 || cw >= 64)) continue;
                    *(u32x4*)(rowp + bj * HALF) = pack8s(acc[ai][bj][m][0], acc[ai][bj][m][1], sc); } }
    }
};
struct EpiQ {
    static constexpr bool PERM = true, AFTER_DRAIN = false;
    unsigned char* qb; const float* rope; float qsc;
    __device__ __forceinline__ void operator()(const f32x4 (&acc)[2][2][4][2], const Unit& u, int wr, int wc, int fr, int fq) const {
        const int row0 = u.pm * BM + wr * 64 + fr;
#pragma unroll
        for (int bj = 0; bj < 2; ++bj) { const int c0 = u.pn * BM + bj * HALF + wc * 32 + 8 * fq; const int head = c0 / 192, off = c0 - head * 192;
#pragma unroll
            for (int ai = 0; ai < 2; ++ai)
#pragma unroll
                for (int m = 0; m < 4; ++m) { const int row = row0 + ai * HALF + m * 16; unsigned char* rowp = qb + (size_t)row * NQB + head * 192; typedef unsigned u32x2 __attribute__((ext_vector_type(2)));
                    const f32x4 v0 = acc[ai][bj][m][0], v1 = acc[ai][bj][m][1];
                    if (off < 128) { u32x2 w; w.x = pk4_fp8(v0[0] * qsc, v0[1] * qsc, v0[2] * qsc, v0[3] * qsc); w.y = pk4_fp8(v1[0] * qsc, v1[1] * qsc, v1[2] * qsc, v1[3] * qsc); *(u32x2*)(rowp + off) = w; }
                    else { const int i0 = (off - 128) >> 1; const float* cs = rope + ((size_t)(row & (SEQ - 1)) * 32 + i0) * 2;
                        const f32x4 ca = *(const f32x4*)cs, cb = *(const f32x4*)(cs + 4);
                        const float a0 = v0[0] * ca[0] - v0[1] * ca[1], b0 = v0[0] * ca[1] + v0[1] * ca[0];
                        const float a1 = v0[2] * ca[2] - v0[3] * ca[3], b1 = v0[2] * ca[3] + v0[3] * ca[2];
                        const float a2 = v1[0] * cb[0] - v1[1] * cb[1], b2 = v1[0] * cb[1] + v1[1] * cb[0];
                        const float a3 = v1[2] * cb[2] - v1[3] * cb[3], b3 = v1[2] * cb[3] + v1[3] * cb[2];
                        *(unsigned*)(rowp + 128 + i0) = pk4_fp8(a0 * qsc, a1 * qsc, a2 * qsc, a3 * qsc); *(unsigned*)(rowp + 160 + i0) = pk4_fp8(b0 * qsc, b1 * qsc, b2 * qsc, b3 * qsc); } } }
    }
};
struct EpiKV {
    static constexpr bool PERM = true, AFTER_DRAIN = false;
    unsigned char* kn; unsigned char* vt; PG8_LAS unsigned char* scr; float accs;
    __device__ __forceinline__ void operator()(const f32x4 (&acc)[2][2][4][2], const Unit& u, int wr, int wc, int fr, int fq) const {
        const int row0 = u.pm * BM + wr * 64 + fr, cw = u.pn * 128 + wc * 32 + 8 * fq;
        const int lane = threadIdx.x & 63;
        const int bb = (u.pm * BM) / SEQ, key0 = (u.pm * BM) % SEQ + wr * 64;
        unsigned char* vrow = vt + ((size_t)(bb * 16 + u.pn) * 128 + wc * 32 + (lane >> 1)) * SEQ + key0 + 32 * (lane & 1);
#pragma unroll
        for (int ai = 0; ai < 2; ++ai) {
#pragma unroll
            for (int m = 0; m < 4; ++m) { const size_t ro = (size_t)(row0 + ai * HALF + m * 16) * DM + cw;
                { typedef unsigned u32x2 __attribute__((ext_vector_type(2))); const f32x4 k0 = acc[ai][0][m][0] * accs, k1 = acc[ai][0][m][1] * accs; u32x2 w; w.x = pk4_fp8(k0[0], k0[1], k0[2], k0[3]); w.y = pk4_fp8(k1[0], k1[1], k1[2], k1[3]); *(u32x2*)(kn + ro) = w; } }
#pragma unroll
            for (int mp = 0; mp < 2; ++mp) {
#pragma unroll
                for (int mm = 0; mm < 2; ++mm) { const int k = mm * 16 + fr, lp = 16 * ((k >> 2) & 1) + 4 * ((k >> 3) & 3) + (k & 3);
#pragma unroll
                    for (int n = 0; n < 2; ++n) { const f32x4 v = acc[ai][1][2 * mp + mm][n] * accs; const unsigned w = pk4_fp8(v[0], v[1], v[2], v[3]);
#pragma unroll
                        for (int i = 0; i < 4; ++i) scr[(8 * fq + 4 * n + i) * 48 + lp] = (unsigned char)((w >> (8 * i)) & 0xffu); } }
                const u32x4 piece = *(const PG8_LAS u32x4*)(scr + (lane >> 1) * 48 + 16 * (lane & 1));
                *(u32x4*)(vrow + ai * HALF + 16 * mp) = piece; }
        }
    }
};
struct EpiPlain {
    static constexpr bool PERM = true, AFTER_DRAIN = false;
    bf16_t* O; int ldc; float accs;
    __device__ __forceinline__ void operator()(const f32x4 (&acc)[2][2][4][2], const Unit& u, int wr, int wc, int fr, int fq) const {
        const int row0 = u.pm * BM + wr * 64 + fr, c0 = u.pn * BM + wc * 32 + 8 * fq;
#pragma unroll
        for (int ai = 0; ai < 2; ++ai)
#pragma unroll
            for (int m = 0; m < 4; ++m) { bf16_t* rowp = O + (size_t)(row0 + ai * HALF + m * 16) * ldc + c0;
#pragma unroll
                for (int bj = 0; bj < 2; ++bj) *(u32x4*)(rowp + bj * HALF) = pack8s(acc[ai][bj][m][0], acc[ai][bj][m][1], accs); }
    }
};
struct EpiPlain8 {
    static constexpr bool PERM = true, AFTER_DRAIN = false;
    unsigned char* O; int ldc; float accs;
    __device__ __forceinline__ void operator()(const f32x4 (&acc)[2][2][4][2], const Unit& u, int wr, int wc, int fr, int fq) const {
        const int row0 = u.pm * BM + wr * 64 + fr, c0 = u.pn * BM + wc * 32 + 8 * fq;
        typedef unsigned u32x2 __attribute__((ext_vector_type(2)));
#pragma unroll
        for (int ai = 0; ai < 2; ++ai)
#pragma unroll
            for (int m = 0; m < 4; ++m) { unsigned char* rowp = O + (size_t)(row0 + ai * HALF + m * 16) * ldc + c0;
#pragma unroll
                for (int bj = 0; bj < 2; ++bj) { const f32x4 v0 = acc[ai][bj][m][0] * accs, v1 = acc[ai][bj][m][1] * accs; u32x2 w; w.x = pk4_fp8(v0[0], v0[1], v0[2], v0[3]); w.y = pk4_fp8(v1[0], v1[1], v1[2], v1[3]); *(u32x2*)(rowp + bj * HALF) = w; } }
    }
};
__device__ __forceinline__ float sigmoidf_fast(float x) { return __builtin_amdgcn_rcpf(1.f + __builtin_amdgcn_exp2f(-LOG2E * x)); }
struct EpiGate {
    static constexpr bool PERM = true, AFTER_DRAIN = false;
    const unsigned char* ya; const unsigned char* yb; const float* bg; unsigned char* uo; float accs;
    __device__ __forceinline__ void operator()(const f32x4 (&acc)[2][2][4][2], const Unit& u, int wr, int wc, int fr, int fq) const {
        const int row0 = u.pm * BM + wr * 64 + fr, cc = u.pn * 128 + wc * 32 + 8 * fq;
        const f32x4 ba0 = *(const f32x4*)(bg + cc), ba1 = *(const f32x4*)(bg + cc + 4), bb0 = *(const f32x4*)(bg + DM + cc), bb1 = *(const f32x4*)(bg + DM + cc + 4);
        typedef unsigned u32x2 __attribute__((ext_vector_type(2))); typedef float f32x2_ __attribute__((ext_vector_type(2)));
        u32x2 a8v[2][4], b8v[2][4];
#pragma unroll
        for (int ai = 0; ai < 2; ++ai)
#pragma unroll
            for (int m = 0; m < 4; ++m) { const size_t ro = (size_t)(row0 + ai * HALF + m * 16) * DM + cc; a8v[ai][m] = *(const u32x2*)(ya + ro); b8v[ai][m] = *(const u32x2*)(yb + ro); }
#pragma unroll
        for (int ai = 0; ai < 2; ++ai)
#pragma unroll
            for (int m = 0; m < 4; ++m) { const size_t ro = (size_t)(row0 + ai * HALF + m * 16) * DM + cc;
                const u32x2 a8 = a8v[ai][m], b8 = b8v[ai][m];
                const f32x4 ga0 = acc[ai][0][m][0] * accs + ba0, ga1 = acc[ai][0][m][1] * accs + ba1, gb0 = acc[ai][1][m][0] * accs + bb0, gb1 = acc[ai][1][m][1] * accs + bb1;
                const float ga[8] = {ga0[0], ga0[1], ga0[2], ga0[3], ga1[0], ga1[1], ga1[2], ga1[3]}, gb[8] = {gb0[0], gb0[1], gb0[2], gb0[3], gb1[0], gb1[1], gb1[2], gb1[3]};
                float yav[8], ybv[8];
                { const f32x2_ t0 = __builtin_amdgcn_cvt_pk_f32_fp8((int)a8.x, false), t1 = __builtin_amdgcn_cvt_pk_f32_fp8((int)a8.x, true), t2 = __builtin_amdgcn_cvt_pk_f32_fp8((int)a8.y, false), t3 = __builtin_amdgcn_cvt_pk_f32_fp8((int)a8.y, true);
                  yav[0] = t0[0]; yav[1] = t0[1]; yav[2] = t1[0]; yav[3] = t1[1]; yav[4] = t2[0]; yav[5] = t2[1]; yav[6] = t3[0]; yav[7] = t3[1]; }
                { const f32x2_ t0 = __builtin_amdgcn_cvt_pk_f32_fp8((int)b8.x, false), t1 = __builtin_amdgcn_cvt_pk_f32_fp8((int)b8.x, true), t2 = __builtin_amdgcn_cvt_pk_f32_fp8((int)b8.y, false), t3 = __builtin_amdgcn_cvt_pk_f32_fp8((int)b8.y, true);
                  ybv[0] = t0[0]; ybv[1] = t0[1]; ybv[2] = t1[0]; ybv[3] = t1[1]; ybv[4] = t2[0]; ybv[5] = t2[1]; ybv[6] = t3[0]; ybv[7] = t3[1]; }
                float r[8];
#pragma unroll
                for (int j = 0; j < 8; ++j) r[j] = sigmoidf_fast(ga[j]) * yav[j] + sigmoidf_fast(gb[j]) * ybv[j];
                u32x2 w; w.x = pk4_fp8(r[0], r[1], r[2], r[3]); w.y = pk4_fp8(r[4], r[5], r[6], r[7]);
                *(u32x2*)(uo + ro) = w; }
    }
};
struct EpiResid {
    static constexpr bool PERM = true, AFTER_DRAIN = false;
    const float* x; bf16_t* r; float accs;
    __device__ __forceinline__ void operator()(const f32x4 (&acc)[2][2][4][2], const Unit& u, int wr, int wc, int fr, int fq) const {
        const int row0 = u.pm * BM + wr * 64 + fr, c0 = u.pn * BM + wc * 32 + 8 * fq;
#pragma unroll
        for (int ai = 0; ai < 2; ++ai) {
            f32x4 xv[4][2][2];
#pragma unroll
            for (int m = 0; m < 4; ++m) { const size_t ro = (size_t)(row0 + ai * HALF + m * 16) * DM + c0;
#pragma unroll
                for (int bj = 0; bj < 2; ++bj) { xv[m][bj][0] = *(const f32x4*)(x + ro + bj * HALF); xv[m][bj][1] = *(const f32x4*)(x + ro + bj * HALF + 4); } }
#pragma unroll
            for (int m = 0; m < 4; ++m) { const size_t ro = (size_t)(row0 + ai * HALF + m * 16) * DM + c0;
#pragma unroll
                for (int bj = 0; bj < 2; ++bj) { const f32x4 a0 = acc[ai][bj][m][0] * accs + xv[m][bj][0] * ALPHA, a1 = acc[ai][bj][m][1] * accs + xv[m][bj][1] * ALPHA;
                    *(u32x4*)(r + ro + bj * HALF) = pack8s(a0, a1, 1.f); } }
        }
    }
};
template <class Epi, class Sched, bool STAMP = false>
__device__ __forceinline__ void gemm_phase(PG8_LAS unsigned char* lds, const Gemm g, const Sched& S, const Epi& E, unsigned long long* stamps) {
    const int tid = threadIdx.x, wid = __builtin_amdgcn_readfirstlane(tid >> 6), lane = tid & 63, wr = wid >> 2, wc = wid & 3, fr = lane & 15, fq = lane >> 4;
    const int K = g.K, nt = K / BK;
    int ts_lo = 0, ts_hi = 0, nts = 0; const unsigned long long rt_entry = STAMP ? (unsigned long long)wall_clock64() : 0ull;
#define PG8_STAMP() do { if (STAMP && wid == 0 && nts < 64) { const unsigned long long _c = (unsigned long long)clock64(); \
        ts_lo = (lane == nts) ? (int)(unsigned)_c : ts_lo; ts_hi = (lane == nts) ? (int)(unsigned)(_c >> 32) : ts_hi; ++nts; } } while (0)
    PG8_STAMP();
    unsigned voffA[2], voffB[2];
#pragma unroll
    for (int i = 0; i < 2; ++i) { int R, C; stage_rc(tid * 16 + i * 8192, R, C); const int Rb = Epi::PERM ? ((R & ~31) + perm32(R & 31)) : R;
        voffA[i] = (unsigned)(R * K + C) * 2u; voffB[i] = (unsigned)(Rb * K + C) * 2u; }
    const size_t kstep = (size_t)(BK * 2);
    const size_t hstep = (size_t)HALF * K * 2;
    const size_t tstep = 2 * hstep;
    const unsigned ldsw = (unsigned)wid * 1024u;
    const int aoff = lds_byte(wr * 64 + fr, fq * 8), boff = lds_byte(wc * 32 + fr, fq * 8);
#define PG8_SA(b, h) (((b) * 2 + (h)) * HTB)
#define PG8_SB(b, h) ((4 + (b) * 2 + (h)) * HTB)
#define PG8_STAGE(bufoff, gbase, voff) do { _Pragma("unroll") for (int _i = 0; _i < 2; ++_i) \
        __builtin_amdgcn_global_load_lds((const unsigned*)((const char*)(gbase) + (voff)[_i]), (PG8_LAS unsigned*)(lds + (bufoff) + ldsw + _i * 8192), 16, 0, 0); } while (0)
#define PG8_LDA(dst, b, h) do { _Pragma("unroll") for (int m = 0; m < 4; ++m) _Pragma("unroll") for (int k = 0; k < 2; ++k) dst[m][k] = *(const PG8_LAS bf16x8*)(lds + PG8_SA(b, h) + aoff + m * 2048 + k * 1024); } while (0)
#define PG8_LDB(dst, b, h) do { _Pragma("unroll") for (int n = 0; n < 2; ++n) _Pragma("unroll") for (int k = 0; k < 2; ++k) dst[n][k] = *(const PG8_LAS bf16x8*)(lds + PG8_SB(b, h) + boff + n * 2048 + k * 1024); } while (0)
#define PG8_MMA(ai, bj, At, Bt) do { __builtin_amdgcn_s_setprio(1); _Pragma("unroll") for (int m = 0; m < 4; ++m) _Pragma("unroll") for (int n = 0; n < 2; ++n) _Pragma("unroll") for (int k = 0; k < 2; ++k) \
        acc[ai][bj][m][n] = __builtin_amdgcn_mfma_f32_16x16x32_bf16(Bt[n][k], At[m][k], acc[ai][bj][m][n], 0, 0, 0); __builtin_amdgcn_s_setprio(0); } while (0)
#define PG8_WAIT_V(n) asm volatile("s_waitcnt vmcnt(" #n ")" ::: "memory")
#define PG8_WAIT_L(n) asm volatile("s_waitcnt lgkmcnt(" #n ")" ::: "memory")
#define PG8_BAR __builtin_amdgcn_s_barrier()
#define PG8_SCHED __builtin_amdgcn_sched_barrier(0)
    Unit cur, nxt; int ui = 0;
    if (!S.next(0, cur)) return;
    f32x4 acc[2][2][4][2];
#pragma unroll
    for (int a = 0; a < 2; ++a)
#pragma unroll
        for (int b = 0; b < 2; ++b)
#pragma unroll
            for (int m = 0; m < 4; ++m)
#pragma unroll
                for (int n = 0; n < 2; ++n) acc[a][b][m][n] = (f32x4){0.f, 0.f, 0.f, 0.f};
    bf16x8 At[4][2], B0[2][2], B1[2][2];
    const char* cA = (const char*)g.A + (size_t)cur.pm * tstep; const char* cB = (const char*)g.Bt + (size_t)cur.pn * tstep;
    S.a_ready(cur);
    PG8_STAGE(PG8_SB(0, 0), cB, voffB); PG8_STAGE(PG8_SA(0, 0), cA, voffA); PG8_STAGE(PG8_SB(0, 1), cB + hstep, voffB); PG8_STAGE(PG8_SA(0, 1), cA + hstep, voffA);
    if (wr == 1) PG8_BAR;
    PG8_WAIT_V(4); PG8_BAR;
    PG8_STAGE(PG8_SB(1, 0), cB + kstep, voffB); PG8_STAGE(PG8_SA(1, 0), cA + kstep, voffA); PG8_STAGE(PG8_SB(1, 1), cB + hstep + kstep, voffB);
    PG8_WAIT_V(6); PG8_BAR;
    PG8_STAMP();
    for (;;) {
        const bool has_next = S.next(ui + 1, nxt);
        const char* nA = has_next ? (const char*)g.A + (size_t)nxt.pm * tstep : cA; const char* nB = has_next ? (const char*)g.Bt + (size_t)nxt.pn * tstep : cB;
        for (int t = 0; t < nt; t += 2) {
            const bool last = (t == nt - 2);
            const char* a1 = cA + (size_t)(t + 1) * kstep;
            const char* a2 = last ? nA : cA + (size_t)(t + 2) * kstep; const char* b2 = last ? nB : cB + (size_t)(t + 2) * kstep;
            const char* a3 = a2 + kstep; const char* b3 = b2 + kstep;
            if (last && has_next) S.a_ready(nxt);
            PG8_LDB(B0, 0, 0); PG8_SCHED; PG8_LDA(At, 0, 0); PG8_STAGE(PG8_SA(1, 1), a1 + hstep, voffA);
            PG8_WAIT_L(8); PG8_BAR; PG8_WAIT_L(0); PG8_MMA(0, 0, At, B0); PG8_BAR; PG8_SCHED;
            PG8_LDB(B1, 0, 1); PG8_STAGE(PG8_SB(0, 0), b2, voffB);
            PG8_BAR; PG8_WAIT_L(0); PG8_MMA(0, 1, At, B1); PG8_BAR;
            PG8_LDA(At, 0, 1); PG8_STAGE(PG8_SA(0, 0), a2, voffA);
            PG8_BAR; PG8_WAIT_L(0); PG8_MMA(1, 0, At, B0); PG8_BAR; PG8_SCHED;
            PG8_STAGE(PG8_SB(0, 1), b2 + hstep, voffB);
            PG8_WAIT_V(6); PG8_BAR; PG8_MMA(1, 1, At, B1); PG8_BAR;
            PG8_LDB(B0, 1, 0); PG8_SCHED; PG8_LDA(At, 1, 0); PG8_STAGE(PG8_SA(0, 1), a2 + hstep, voffA);
            PG8_WAIT_L(8); PG8_BAR; PG8_WAIT_L(0); PG8_MMA(0, 0, At, B0); PG8_BAR; PG8_SCHED;
            PG8_LDB(B1, 1, 1); PG8_STAGE(PG8_SB(1, 0), b3, voffB);
            PG8_BAR; PG8_WAIT_L(0); PG8_MMA(0, 1, At, B1); PG8_BAR;
            PG8_LDA(At, 1, 1); PG8_STAGE(PG8_SA(1, 0), a3, voffA);
            PG8_BAR; PG8_WAIT_L(0); PG8_MMA(1, 0, At, B0); PG8_BAR; PG8_SCHED;
            PG8_STAGE(PG8_SB(1, 1), b3 + hstep, voffB);
            PG8_WAIT_V(6); PG8_BAR; PG8_MMA(1, 1, At, B1); PG8_BAR;
        }
        PG8_STAMP();
        if constexpr (!Epi::AFTER_DRAIN) { E(acc, cur, wr, wc, fr, fq); S.done(cur); }
        PG8_STAMP();
        if (!has_next) break;
#pragma unroll
        for (int a = 0; a < 2; ++a)
#pragma unroll
            for (int b = 0; b < 2; ++b)
#pragma unroll
                for (int m = 0; m < 4; ++m)
#pragma unroll
                    for (int n = 0; n < 2; ++n) acc[a][b][m][n] = (f32x4){0.f, 0.f, 0.f, 0.f};
        cur = nxt; cA = nA; cB = nB; ++ui;
    }
    PG8_WAIT_V(0);
    if (wr == 0) PG8_BAR;
    PG8_BAR;
    if constexpr (Epi::AFTER_DRAIN) { E.fused(acc, cur, wr, wc, fr, fq, lds, wid, lane); S.done(cur); }
    PG8_STAMP();
    if (STAMP && wid == 0) { stamps[lane] = lane < nts ? (((unsigned long long)(unsigned)ts_hi << 32) | (unsigned)ts_lo) : 0ull;
        if (lane == 62) stamps[62] = rt_entry; if (lane == 63) stamps[63] = (unsigned long long)wall_clock64(); }
#undef PG8_STAMP
#undef PG8_SA
#undef PG8_SB
#undef PG8_STAGE
#undef PG8_LDA
#undef PG8_LDB
#undef PG8_MMA
#undef PG8_WAIT_V
#undef PG8_WAIT_L
#undef PG8_BAR
#undef PG8_SCHED
}
typedef int i32x4 __attribute__((ext_vector_type(4)));
typedef int i32x8 __attribute__((ext_vector_type(8)));
template <class Epi, class Sched, bool STAMP = false>
__device__ __forceinline__ void gemm_phase8(PG8_LAS unsigned char* lds, const Gemm g, const Sched& S, const Epi& E, unsigned long long* stamps) {
    const int tid = threadIdx.x, wid = __builtin_amdgcn_readfirstlane(tid >> 6), lane = tid & 63, wr = wid >> 2, wc = wid & 3, fr = lane & 15, fq = lane >> 4;
    const int K = g.K, nt = K / BK;
    int ts_lo = 0, ts_hi = 0, nts = 0; const unsigned long long rt_entry = STAMP ? (unsigned long long)wall_clock64() : 0ull;
#define PG8_STAMP() do { if (STAMP && wid == 0 && nts < 64) { const unsigned long long _c = (unsigned long long)clock64(); \
        ts_lo = (lane == nts) ? (int)(unsigned)_c : ts_lo; ts_hi = (lane == nts) ? (int)(unsigned)(_c >> 32) : ts_hi; ++nts; } } while (0)
    PG8_STAMP();
    unsigned voffA[2], voffB[2];
#pragma unroll
    for (int i = 0; i < 2; ++i) { int R, C; stage_rc(tid * 16 + i * 8192, R, C); const int Rb = Epi::PERM ? ((R & ~31) + perm32(R & 31)) : R;
        voffA[i] = (unsigned)(R * K + C) * 2u; voffB[i] = (unsigned)(Rb * K + C) * 2u; }
    const size_t kstep = (size_t)(BK * 2);
    const size_t hstep = (size_t)HALF * K * 2;
    const size_t tstep = 2 * hstep;
    const unsigned ldsw = (unsigned)wid * 1024u;
    const int aoff = lds_byte(wr * 64 + fr, fq * 16), boff = lds_byte(wc * 32 + fr, fq * 16);
    const int hsw = (fq & 1) * 16, aofL = aoff + hsw, aofH = aoff + 16 - hsw, bofL = boff + hsw, bofH = boff + 16 - hsw;
#define PG8_SA(b, h) (((b) * 2 + (h)) * HTB)
#define PG8_SB(b, h) ((4 + (b) * 2 + (h)) * HTB)
#define PG8_STAGE(bufoff, gbase, voff) do { _Pragma("unroll") for (int _i = 0; _i < 2; ++_i) \
        __builtin_amdgcn_global_load_lds((const unsigned*)((const char*)(gbase) + (voff)[_i]), (PG8_LAS unsigned*)(lds + (bufoff) + ldsw + _i * 8192), 16, 0, 0); } while (0)
#define PG8_LDA(dst, b, h) do { _Pragma("unroll") for (int m = 0; m < 4; ++m) { const i32x4 lo_ = *(const PG8_LAS i32x4*)(lds + PG8_SA(b, h) + aofL + m * 2048), hi_ = *(const PG8_LAS i32x4*)(lds + PG8_SA(b, h) + aofH + m * 2048); dst[m] = (i32x8){lo_[0], lo_[1], lo_[2], lo_[3], hi_[0], hi_[1], hi_[2], hi_[3]}; } } while (0)
#define PG8_LDB(dst, b, h) do { _Pragma("unroll") for (int n = 0; n < 2; ++n) { const i32x4 lo_ = *(const PG8_LAS i32x4*)(lds + PG8_SB(b, h) + bofL + n * 2048), hi_ = *(const PG8_LAS i32x4*)(lds + PG8_SB(b, h) + bofH + n * 2048); dst[n] = (i32x8){lo_[0], lo_[1], lo_[2], lo_[3], hi_[0], hi_[1], hi_[2], hi_[3]}; } } while (0)
#define PG8_MMA(ai, bj, At, Bt) do { __builtin_amdgcn_s_setprio(1); _Pragma("unroll") for (int m = 0; m < 4; ++m) _Pragma("unroll") for (int n = 0; n < 2; ++n) \
        asm volatile("v_mfma_scale_f32_16x16x128_f8f6f4 %0, %1, %2, %0, %3, %3 op_sel_hi:[0,0,0]" : "+v"(acc[ai][bj][m][n]) : "v"(Bt[n]), "v"(At[m]), "v"(sc1)); __builtin_amdgcn_s_setprio(0); } while (0)
#define PG8_WAIT_V(n) asm volatile("s_waitcnt vmcnt(" #n ")" ::: "memory")
#define PG8_WAIT_L(n) asm volatile("s_waitcnt lgkmcnt(" #n ")" ::: "memory")
#define PG8_BAR __builtin_amdgcn_s_barrier()
#define PG8_SCHED __builtin_amdgcn_sched_barrier(0)
    const int sc1 = 0x7f7f7f7f;
    Unit cur, nxt; int ui = 0;
    if (!S.next(0, cur)) return;
    f32x4 acc[2][2][4][2];
#pragma unroll
    for (int a = 0; a < 2; ++a)
#pragma unroll
        for (int b = 0; b < 2; ++b)
#pragma unroll
            for (int m = 0; m < 4; ++m)
#pragma unroll
                for (int n = 0; n < 2; ++n) acc[a][b][m][n] = (f32x4){0.f, 0.f, 0.f, 0.f};
    i32x8 At[4], B0[2], B1[2];
    const char* cA = (const char*)g.A + (size_t)cur.pm * tstep; const char* cB = (const char*)g.Bt + (size_t)cur.pn * tstep;
    S.a_ready(cur);
    PG8_STAGE(PG8_SB(0, 0), cB, voffB); PG8_STAGE(PG8_SA(0, 0), cA, voffA); PG8_STAGE(PG8_SB(0, 1), cB + hstep, voffB); PG8_STAGE(PG8_SA(0, 1), cA + hstep, voffA);
    if (wr == 1) PG8_BAR;
    PG8_WAIT_V(4); PG8_BAR;
    PG8_STAGE(PG8_SB(1, 0), cB + kstep, voffB); PG8_STAGE(PG8_SA(1, 0), cA + kstep, voffA); PG8_STAGE(PG8_SB(1, 1), cB + hstep + kstep, voffB);
    PG8_WAIT_V(6); PG8_BAR;
    PG8_STAMP();
    for (;;) {
        const bool has_next = S.next(ui + 1, nxt);
        const char* nA = has_next ? (const char*)g.A + (size_t)nxt.pm * tstep : cA; const char* nB = has_next ? (const char*)g.Bt + (size_t)nxt.pn * tstep : cB;
        for (int t = 0; t < nt; t += 2) {
            const bool last = (t == nt - 2);
            const char* a1 = cA + (size_t)(t + 1) * kstep;
            const char* a2 = last ? nA : cA + (size_t)(t + 2) * kstep; const char* b2 = last ? nB : cB + (size_t)(t + 2) * kstep;
            const char* a3 = a2 + kstep; const char* b3 = b2 + kstep;
            if (last && has_next) S.a_ready(nxt);
            PG8_LDB(B0, 0, 0); PG8_SCHED; PG8_LDA(At, 0, 0); PG8_STAGE(PG8_SA(1, 1), a1 + hstep, voffA);
            PG8_WAIT_L(8); PG8_BAR; PG8_WAIT_L(0); PG8_MMA(0, 0, At, B0); PG8_BAR; PG8_SCHED;
            PG8_LDB(B1, 0, 1); PG8_STAGE(PG8_SB(0, 0), b2, voffB);
            PG8_BAR; PG8_WAIT_L(0); PG8_MMA(0, 1, At, B1); PG8_BAR;
            PG8_LDA(At, 0, 1); PG8_STAGE(PG8_SA(0, 0), a2, voffA);
            PG8_BAR; PG8_WAIT_L(0); PG8_MMA(1, 0, At, B0); PG8_BAR; PG8_SCHED;
            PG8_STAGE(PG8_SB(0, 1), b2 + hstep, voffB);
            PG8_WAIT_V(6); PG8_BAR; PG8_MMA(1, 1, At, B1); PG8_BAR;
            PG8_LDB(B0, 1, 0); PG8_SCHED; PG8_LDA(At, 1, 0); PG8_STAGE(PG8_SA(0, 1), a2 + hstep, voffA);
            PG8_WAIT_L(8); PG8_BAR; PG8_WAIT_L(0); PG8_MMA(0, 0, At, B0); PG8_BAR; PG8_SCHED;
            PG8_LDB(B1, 1, 1); PG8_STAGE(PG8_SB(1, 0), b3, voffB);
            PG8_BAR; PG8_WAIT_L(0); PG8_MMA(0, 1, At, B1); PG8_BAR;
            PG8_LDA(At, 1, 1); PG8_STAGE(PG8_SA(1, 0), a3, voffA);
            PG8_BAR; PG8_WAIT_L(0); PG8_MMA(1, 0, At, B0); PG8_BAR; PG8_SCHED;
            PG8_STAGE(PG8_SB(1, 1), b3 + hstep, voffB);
            PG8_WAIT_V(6); PG8_BAR; PG8_MMA(1, 1, At, B1); PG8_BAR;
        }
        PG8_STAMP();
        asm volatile("s_nop 15\n\ts_nop 15" ::: "memory");
        if constexpr (!Epi::AFTER_DRAIN) { E(acc, cur, wr, wc, fr, fq); S.done(cur); }
        PG8_STAMP();
        if (!has_next) break;
#pragma unroll
        for (int a = 0; a < 2; ++a)
#pragma unroll
            for (int b = 0; b < 2; ++b)
#pragma unroll
                for (int m = 0; m < 4; ++m)
#pragma unroll
                    for (int n = 0; n < 2; ++n) acc[a][b][m][n] = (f32x4){0.f, 0.f, 0.f, 0.f};
        cur = nxt; cA = nA; cB = nB; ++ui;
    }
    PG8_WAIT_V(0);
    if (wr == 0) PG8_BAR;
    PG8_BAR;
    if constexpr (Epi::AFTER_DRAIN) { E.fused(acc, cur, wr, wc, fr, fq, lds, wid, lane); S.done(cur); }
    PG8_STAMP();
    if (STAMP && wid == 0) { stamps[lane] = lane < nts ? (((unsigned long long)(unsigned)ts_hi << 32) | (unsigned)ts_lo) : 0ull;
        if (lane == 62) stamps[62] = rt_entry; if (lane == 63) stamps[63] = (unsigned long long)wall_clock64(); }
#undef PG8_STAMP
#undef PG8_SA
#undef PG8_SB
#undef PG8_STAGE
#undef PG8_LDA
#undef PG8_LDB
#undef PG8_MMA
#undef PG8_WAIT_V
#undef PG8_WAIT_L
#undef PG8_BAR
#undef PG8_SCHED
}
}

namespace att {
constexpr int SHM_V = 16384, SHM_K = 24576;
constexpr int OFF_V = 0, OFF_K = 2 * SHM_V, OFF_WS = OFF_K + 2 * SHM_K;
constexpr int ATT_LDS = OFF_WS + 8 * 256;
static_assert(ATT_LDS <= RING_BYTES, "attention LDS");
constexpr float THR = 11.5f;
__device__ __forceinline__ int v_st(int k, int c) { const int kk = (k & ~0xC) | ((k & 4) << 1) | ((k & 8) >> 1); return ((kk >> 3) * 4 + (c >> 5)) * 512 + ((kk & 7) * 32 + (c & 31)) * 2; }
__device__ __forceinline__ int v_rd_base(int lane) { return ((lane & 3) << 3) | (((lane >> 2) & 3) << 6) | (((lane >> 4) & 1) << 5) | (((lane >> 5) & 1) << 8); }
constexpr int v_rd_off(int d0, int ks, int half) { return d0 * 512 + ks * 4096 + half * 2048; }
__device__ __forceinline__ int crow(int r, int hi) { return (r & 3) + 8 * (r >> 2) + 4 * hi; }
__device__ __forceinline__ unsigned cvtpk(float lo, float hi) { unsigned r; asm volatile("v_cvt_pk_bf16_f32 %0, %1, %2" : "=v"(r) : "v"(lo), "v"(hi)); return r; }

struct Desc {
    const bf16* Q; long qs;
    const bf16* K; long ks;
    const bf16* K2; long k2s;
    const bf16* V; long vs;
    bf16* O; long os;
    float* LSE; long ls;
    int q0;
    int j_lo, j_hi;
    float sl;
    int first;
    unsigned char* O8; long o8s;
};

template <int MODE>
__device__ __forceinline__ void attn_prime(LAS unsigned char* lds, const Desc& a, bf16x8 (&qr)[MODE == 0 ? 12 : 8]) {
    constexpr int NQ = MODE == 0 ? 12 : 8;
    const int tid = threadIdx.x, wid = __builtin_amdgcn_readfirstlane(tid >> 6), lane = tid & 63, r32 = lane & 31, hi = lane >> 5;
    { const bf16* qrow = a.Q + (long)(wid * 32 + r32) * a.qs + hi * 8;
#pragma unroll
      for (int d0 = 0; d0 < NQ; ++d0) qr[d0] = *(const bf16x8*)(qrow + d0 * 16); }
#pragma unroll
    for (int r = 0; r < 2; ++r) { const int sidx = r * 512 + wid * 64 + lane; const int row = sidx >> 4, c = (sidx & 15) ^ (row & 15); const int oA = row * (int)a.ks + c * 8;
        const int sub = sidx >> 5, within = sidx & 31, kk = (sub >> 2) * 8 + (within >> 2), kq = (kk & ~0xC) | ((kk & 4) << 1) | ((kk & 8) >> 1), cc = (sub & 3) * 32 + (within & 3) * 8; const int oV = kq * (int)a.vs + cc;
        __builtin_amdgcn_global_load_lds((const unsigned*)(a.K + (long)(a.j_lo * 64) * a.ks + oA), (LAS unsigned*)(lds + OFF_K + r * 8192 + wid * 1024), 16, 0, 0);
        __builtin_amdgcn_global_load_lds((const unsigned*)(a.V + (long)(a.j_lo * 64) * a.vs + oV), (LAS unsigned*)(lds + OFF_V + r * 8192 + wid * 1024), 16, 0, 0); }
}
template <int MODE>
__device__ __forceinline__ void attn_unit(LAS unsigned char* lds, const Desc& a, const Desc& nx, bool has_next, bf16x8 (&qr)[MODE == 0 ? 12 : 8]) {
    constexpr int NQ = MODE == 0 ? 12 : 8;
    constexpr unsigned W = MODE == 0 ? 0x7fffffffu : 129u;
    const int tid = threadIdx.x, wid = __builtin_amdgcn_readfirstlane(tid >> 6), lane = tid & 63, r32 = lane & 31, hi = lane >> 5;
    const unsigned ldsb = (unsigned)(uintptr_t)lds;
    LAS float* wsf = (LAS float*)(lds + OFF_WS) + wid * 64; LAS float* li_l = wsf; LAS float* al_l = wsf + 32;
    float m_reg = -1e30f, l_reg = 0.f; f32x16 o[4];
#pragma unroll
    for (int d = 0; d < 4; ++d) o[d] = f32x16{};
    if (MODE == 1 && !a.first) {
        m_reg = a.LSE[(long)(wid * 32 + r32) * a.ls]; l_reg = 1.f;
#pragma unroll
        for (int r = 0; r < 16; ++r) { const v2u w = *(const v2u*)(a.O + (long)(wid * 32 + crow(r, hi)) * a.os + 4 * r32);
            o[0][r] = bf_lo(w.x); o[1][r] = bf_hi(w.x); o[2][r] = bf_lo(w.y); o[3][r] = bf_hi(w.y); }
    }
    int offA[2], offV[2], offB;
#pragma unroll
    for (int r = 0; r < 2; ++r) { const int sidx = r * 512 + wid * 64 + lane; const int row = sidx >> 4, c = (sidx & 15) ^ (row & 15); offA[r] = row * (int)a.ks + c * 8;
        const int sub = sidx >> 5, within = sidx & 31, kk = (sub >> 2) * 8 + (within >> 2), kq = (kk & ~0xC) | ((kk & 4) << 1) | ((kk & 8) >> 1), cc = (sub & 3) * 32 + (within & 3) * 8; offV[r] = kq * (int)a.vs + cc; }
    { const int sidx = wid * 64 + lane; const int row = sidx >> 3, c = (sidx & 7) ^ ((row >> 1) & 7); offB = row * (int)a.k2s + c * 8; }
#define AT_DMA(kb_, bf) do { \
        _Pragma("unroll") for (int r_ = 0; r_ < 2; ++r_) { \
            __builtin_amdgcn_global_load_lds((const unsigned*)(a.K + (long)(kb_) * a.ks + offA[r_]), (LAS unsigned*)(lds + OFF_K + (bf) * SHM_K + r_ * 8192 + wid * 1024), 16, 0, 0); \
            __builtin_amdgcn_global_load_lds((const unsigned*)(a.V + (long)(kb_) * a.vs + offV[r_]), (LAS unsigned*)(lds + OFF_V + (bf) * SHM_V + r_ * 8192 + wid * 1024), 16, 0, 0); } \
        if (MODE == 0) __builtin_amdgcn_global_load_lds((const unsigned*)(a.K2 + (long)(kb_) * a.k2s + offB), (LAS unsigned*)(lds + OFF_K + (bf) * SHM_K + 16384 + wid * 1024), 16, 0, 0); } while (0)
    int kbA[8], kbB[4];
#pragma unroll
    for (int dd = 0; dd < 8; ++dd) kbA[dd] = r32 * 256 + (((2 * dd + hi) ^ (r32 & 15)) << 4);
#pragma unroll
    for (int dd = 0; dd < 4; ++dd) kbB[dd] = 16384 + r32 * 128 + (((2 * dd + hi) ^ ((r32 >> 1) & 7)) << 4);
    const unsigned vb0 = ldsb + OFF_V + v_rd_base(lane);
    const int qlo = a.q0 + wid * 32;
    const int qm = qlo + r32 - 4 * hi;
    const int NT = a.j_hi - a.j_lo;
    const float NEGINF = -__builtin_inff();
    f32x16 cvec;
#pragma unroll
    for (int r = 0; r < 16; ++r) cvec[r] = MODE == 1 ? a.sl * (float)((r & 3) + 8 * (r >> 2)) : 0.f;

    unsigned kaA[8], kaB[4];
#pragma unroll
    for (int dd = 0; dd < 8; ++dd) kaA[dd] = ldsb + OFF_K + kbA[dd];
#pragma unroll
    for (int dd = 0; dd < 4; ++dd) kaB[dd] = ldsb + OFF_K + kbB[dd];
#define KRD(dst, base, off) asm volatile("ds_read_b128 %0, %1 offset:%2" : "=&v"(dst) : "v"(base), "i"(off) : "memory")
#define KRD2(x0, x1, d0_, BUF) do { if constexpr ((d0_) < 8) { KRD(x0, kaA[(d0_)], (BUF) * SHM_K); KRD(x1, kaA[(d0_)], (BUF) * SHM_K + 8192); } \
        else { KRD(x0, kaB[((d0_) - 8) & 3], (BUF) * SHM_K); KRD(x1, kaB[((d0_) - 8) & 3], (BUF) * SHM_K + 4096); } } while (0)
#define KBATCH(f, bt, BUF) do { KRD2(f[0], f[1], 2 * (bt), BUF); KRD2(f[2], f[3], 2 * (bt) + 1, BUF); } while (0)
#define QK_MMA(f, bt) do { p0 = __builtin_amdgcn_mfma_f32_32x32x16_bf16(f[0], qr[2 * (bt)], p0, 0, 0, 0); p1 = __builtin_amdgcn_mfma_f32_32x32x16_bf16(f[1], qr[2 * (bt)], p1, 0, 0, 0); \
        p0 = __builtin_amdgcn_mfma_f32_32x32x16_bf16(f[2], qr[2 * (bt) + 1], p0, 0, 0, 0); p1 = __builtin_amdgcn_mfma_f32_32x32x16_bf16(f[3], qr[2 * (bt) + 1], p1, 0, 0, 0); } while (0)
#define QK_MMA0(f, c_) do { p0 = __builtin_amdgcn_mfma_f32_32x32x16_bf16(f[0], qr[0], c_, 0, 0, 0); p1 = __builtin_amdgcn_mfma_f32_32x32x16_bf16(f[1], qr[0], c_, 0, 0, 0); \
        p0 = __builtin_amdgcn_mfma_f32_32x32x16_bf16(f[2], qr[1], p0, 0, 0, 0); p1 = __builtin_amdgcn_mfma_f32_32x32x16_bf16(f[3], qr[1], p1, 0, 0, 0); } while (0)
#define MAX3(acc_, x_, y_) asm("v_max3_f32 %0, %0, %1, %2" : "+v"(acc_) : "v"(x_), "v"(y_))
#define ADD1(acc_, x_) asm("v_add_f32 %0, %0, %1" : "+v"(acc_) : "v"(x_))
#define LGK(n) asm volatile("s_waitcnt lgkmcnt(" #n ")" ::: "memory")
#define TRRD(dst, off) asm volatile("ds_read_b64_tr_b16 %0, %1 offset:%2" : "=&v"(dst) : "v"(vb0), "i"(off) : "memory")
#define VRD8(S, VB, d0) do { constexpr int b_ = (VB) * SHM_V + v_rd_off(d0, 0, 0); \
        TRRD(S[0], b_); TRRD(S[1], b_ + 2048); TRRD(S[2], b_ + 4096); TRRD(S[3], b_ + 6144); TRRD(S[4], b_ + 8192); TRRD(S[5], b_ + 10240); TRRD(S[6], b_ + 12288); TRRD(S[7], b_ + 14336); } while (0)
#define PV_MMA(S, d0) do { \
        o[d0] = __builtin_amdgcn_mfma_f32_32x32x16_bf16(pa0, (bf16x8){S[0][0], S[0][1], S[0][2], S[0][3], S[1][0], S[1][1], S[1][2], S[1][3]}, o[d0], 0, 0, 0); \
        o[d0] = __builtin_amdgcn_mfma_f32_32x32x16_bf16(pa1, (bf16x8){S[2][0], S[2][1], S[2][2], S[2][3], S[3][0], S[3][1], S[3][2], S[3][3]}, o[d0], 0, 0, 0); \
        o[d0] = __builtin_amdgcn_mfma_f32_32x32x16_bf16(pa2, (bf16x8){S[4][0], S[4][1], S[4][2], S[4][3], S[5][0], S[5][1], S[5][2], S[5][3]}, o[d0], 0, 0, 0); \
        o[d0] = __builtin_amdgcn_mfma_f32_32x32x16_bf16(pa3, (bf16x8){S[6][0], S[6][1], S[6][2], S[6][3], S[7][0], S[7][1], S[7][2], S[7][3]}, o[d0], 0, 0, 0); } while (0)
#define PK4(P, B_, OUT) do { unsigned a0 = cvtpk(P[B_ + 0], P[B_ + 1]), a1 = cvtpk(P[B_ + 2], P[B_ + 3]); \
        unsigned b0 = cvtpk(P[B_ + 4], P[B_ + 5]), b1 = cvtpk(P[B_ + 6], P[B_ + 7]); \
        auto r0 = __builtin_amdgcn_permlane32_swap(a0, b0, false, false); auto r1 = __builtin_amdgcn_permlane32_swap(a1, b1, false, false); \
        v4u w = {r0[0], r1[0], r0[1], r1[1]}; OUT = __builtin_bit_cast(bf16x8, w); } while (0)

#define AT_STEP(t, BUF) do { \
        const int kb = (a.j_lo + (t)) * 64; \
        if ((t) + 1 < NT) AT_DMA(kb + 64, (BUF) ^ 1); \
        const bool act = (kb <= qlo + 31) && (MODE == 0 || kb + 63 >= qlo - 128); \
        if (act) { \
            f32x16 p0, p1; \
            { bf16x8 fa[4], fb[4]; \
              KBATCH(fa, 0, BUF); KBATCH(fb, 1, BUF); \
              LGK(4); SBAR(); QK_MMA0(fa, cvec); SBAR(); KBATCH(fa, 2, BUF); \
              LGK(4); SBAR(); QK_MMA(fb, 1); SBAR(); KBATCH(fb, 3, BUF); \
              if constexpr (MODE == 0) { \
                  LGK(4); SBAR(); QK_MMA(fa, 2); SBAR(); KBATCH(fa, 4, BUF); \
                  LGK(4); SBAR(); QK_MMA(fb, 3); SBAR(); KBATCH(fb, 5, BUF); \
                  LGK(4); SBAR(); QK_MMA(fa, 4); SBAR(); \
                  LGK(0); SBAR(); QK_MMA(fb, 5); SBAR(); \
              } else { \
                  LGK(4); SBAR(); QK_MMA(fa, 2); SBAR(); \
                  LGK(0); SBAR(); QK_MMA(fb, 3); SBAR(); } } \
            const int dq = qm - kb; \
            const float nb = MODE == 1 ? -a.sl * (float)dq : 0.f, off1 = MODE == 1 ? 32.f * a.sl : 0.f;     \
            if ((kb + 63 > qlo) || (MODE == 1 && kb <= qlo + 31 - 129)) { \
                _Pragma("unroll") for (int r = 0; r < 16; ++r) { const int c = (r & 3) + 8 * (r >> 2); \
                    if ((unsigned)(dq - c) >= W) p0[r] = NEGINF; if ((unsigned)(dq - c - 32) >= W) p1[r] = NEGINF; } } \
            asm volatile("s_nop 15" : "+v"(p0), "+v"(p1));                   \
            float pmax; { float x0 = p0[0], x1 = p0[1], y0 = p1[0], y1 = p1[1]; \
                _Pragma("unroll") for (int r = 2; r < 16; r += 4) { MAX3(x0, p0[r], p0[r + 1]); MAX3(y0, p1[r], p1[r + 1]); } \
                _Pragma("unroll") for (int r = 4; r < 16; r += 4) { MAX3(x1, p0[r], p0[r + 1]); MAX3(y1, p1[r], p1[r + 1]); } \
                pmax = fmaxf(fmaxf(x0, x1), fmaxf(y0, y1) + off1) + nb; } \
            { auto rr = __builtin_amdgcn_permlane32_swap(__float_as_uint(pmax), __float_as_uint(pmax), false, false); pmax = fmaxf(__uint_as_float(rr[0]), __uint_as_float(rr[1])); } \
            float alpha = 1.f; \
            if (!__all(pmax - m_reg <= THR)) { const float mn = fmaxf(m_reg, pmax); alpha = __builtin_amdgcn_exp2f(m_reg - mn); m_reg = mn; } \
            if (__any(alpha < 1.f)) { if (hi == 0) al_l[r32] = alpha; LDS_WAIT(); \
                _Pragma("unroll") for (int r = 0; r < 16; ++r) { const float f = al_l[crow(r, hi)]; o[0][r] *= f; o[1][r] *= f; o[2][r] *= f; o[3][r] *= f; } } \
            float ps; { const float e0 = nb - m_reg, e1 = e0 + off1; float psa[4]; \
                _Pragma("unroll") for (int r = 0; r < 16; ++r) p0[r] = __builtin_amdgcn_exp2f(p0[r] + e0); \
                _Pragma("unroll") for (int r = 0; r < 16; ++r) p1[r] = __builtin_amdgcn_exp2f(p1[r] + e1); \
                asm volatile("s_nop 0" : "+v"(p0), "+v"(p1));            \
                _Pragma("unroll") for (int r = 0; r < 4; ++r) psa[r] = p0[r]; \
                _Pragma("unroll") for (int r = 4; r < 16; ++r) ADD1(psa[r & 3], p0[r]); \
                _Pragma("unroll") for (int r = 0; r < 16; ++r) ADD1(psa[r & 3], p1[r]); \
                ADD1(psa[0], psa[1]); ADD1(psa[2], psa[3]); ADD1(psa[0], psa[2]); ps = psa[0]; } \
            { auto rr = __builtin_amdgcn_permlane32_swap(__float_as_uint(ps), __float_as_uint(ps), false, false); ps = __uint_as_float(rr[0]) + __uint_as_float(rr[1]); } \
            l_reg = l_reg * alpha + ps; \
            bf16x8 pa0, pa1, pa2, pa3; PK4(p0, 0, pa0); PK4(p0, 8, pa1); PK4(p1, 0, pa2); PK4(p1, 8, pa3); \
            { s16x4 va[8], vb_[8]; \
              VRD8(va, BUF, 0); VRD8(vb_, BUF, 1); \
              LGK(8); SBAR(); PV_MMA(va, 0); SBAR(); VRD8(va, BUF, 2); \
              LGK(8); SBAR(); PV_MMA(vb_, 1); SBAR(); VRD8(vb_, BUF, 3); \
              LGK(8); SBAR(); PV_MMA(va, 2); SBAR(); \
              LGK(0); SBAR(); PV_MMA(vb_, 3); SBAR(); } \
        } \
        VM_WAIT(); __syncthreads(); } while (0)

    VM_WAIT(); __syncthreads();
    for (int t = 0; t < NT; t += 2) { AT_STEP(t, 0); if (t + 1 < NT) AT_STEP(t + 1, 1); }

    if (has_next) {
        { const bf16* qrow = nx.Q + (long)(wid * 32 + r32) * nx.qs + hi * 8;
#pragma unroll
          for (int d0 = 0; d0 < NQ; ++d0) qr[d0] = *(const bf16x8*)(qrow + d0 * 16); }
#pragma unroll
        for (int r_ = 0; r_ < 2; ++r_) {
            __builtin_amdgcn_global_load_lds((const unsigned*)(nx.K + (long)(nx.j_lo * 64) * nx.ks + offA[r_]), (LAS unsigned*)(lds + OFF_K + r_ * 8192 + wid * 1024), 16, 0, 0);
            __builtin_amdgcn_global_load_lds((const unsigned*)(nx.V + (long)(nx.j_lo * 64) * nx.vs + offV[r_]), (LAS unsigned*)(lds + OFF_V + r_ * 8192 + wid * 1024), 16, 0, 0); }
        SBAR(); }
    if (hi == 0) li_l[r32] = l_reg;
    LDS_WAIT();
    if (MODE == 1 && !a.O8 && hi == 0) a.LSE[(long)(wid * 32 + r32) * a.ls] = m_reg + __builtin_amdgcn_logf(l_reg);
    if (a.O8) {
#pragma unroll
        for (int r = 0; r < 16; ++r) { const int orow = crow(r, hi); const float rl = 64.f * __builtin_amdgcn_rcpf(li_l[orow]);
            *(unsigned*)(a.O8 + (long)(wid * 32 + orow) * a.o8s + 4 * r32) = pk4_fp8(o[0][r] * rl, o[1][r] * rl, o[2][r] * rl, o[3][r] * rl); }
    } else {
#pragma unroll
        for (int r = 0; r < 16; ++r) { const int orow = crow(r, hi); const float rl = __builtin_amdgcn_rcpf(li_l[orow]);
            *(v2u*)(a.O + (long)(wid * 32 + orow) * a.os + 4 * r32) = (v2u){cvtpk(o[0][r] * rl, o[1][r] * rl), cvtpk(o[2][r] * rl, o[3][r] * rl)}; }
    }
    asm volatile("s_waitcnt lgkmcnt(0)\n\ts_barrier" ::: "memory");
#undef AT_DMA
#undef TRRD
#undef KRD
#undef KRD2
#undef KBATCH
#undef QK_MMA
#undef LGK
#undef VRD8
#undef PV_MMA
#undef PK4
#undef AT_STEP
#undef QK_MMA0
#undef MAX3
#undef ADD1
}
}

namespace att8 {
typedef int i32x8 __attribute__((ext_vector_type(8)));
typedef int i32x4 __attribute__((ext_vector_type(4)));
constexpr int SHM_V = 8192, SHM_K = 12288;
constexpr int OFF_V = 0, OFF_K = 4 * SHM_V, OFF_WS = OFF_K + 3 * SHM_K;
constexpr float THR = 4.f;
constexpr float QPRE = 8.f;
__device__ __forceinline__ int pk4u_fp8(float a, float b, float c, float d) { int w; asm volatile("" : "=v"(w)); w = __builtin_amdgcn_cvt_pk_fp8_f32(a, b, w, false); return __builtin_amdgcn_cvt_pk_fp8_f32(c, d, w, true); }
#define PK4U(a_, b_, c_, d_) pk4u_fp8(a_, b_, c_, d_)
__device__ __forceinline__ int crow8(int r, int hi) { return (r & 3) + 8 * (r >> 2) + 4 * hi; }
__host__ __device__ __forceinline__ int vperm(int key) { return 32 * ((key >> 2) & 1) + 4 * (((key >> 3) & 3) + 4 * (key >> 5)) + (key & 3); }

struct Desc {
    const unsigned char* Q; long qs;
    const unsigned char* K; long ks;
    const unsigned char* K2; long k2s;
    const unsigned char* VT; long vts;
    unsigned char* O8; long o8s;
    int q0, j_hi;
    int trail;
};

__device__ __forceinline__ void attn_unit(LAS unsigned char* lds, const Desc& a) {
    const int tid = threadIdx.x, wid = __builtin_amdgcn_readfirstlane(tid >> 6), lane = tid & 63, r32 = lane & 31, hi = lane >> 5;
    const unsigned ldsb = (unsigned)(uintptr_t)lds;
    LAS float* wsf = (LAS float*)(lds + OFF_WS) + wid * 64; LAS float* li_l = wsf; LAS float* al_l = wsf + 32;
    const int sc1 = 0x7f7f7f7f, scq = 0x7c7c7c7c;
    i32x8 qf[3];
    { const unsigned char* qrow = a.Q + (long)(wid * 32 + r32) * a.qs + 32 * hi;
#pragma unroll
      for (int s = 0; s < 3; ++s) { const i32x4 lo_ = *(const i32x4*)(qrow + 64 * s), hi_ = *(const i32x4*)(qrow + 64 * s + 16); qf[s] = (i32x8){lo_[0], lo_[1], lo_[2], lo_[3], hi_[0], hi_[1], hi_[2], hi_[3]}; } }
    float m_reg = -1e30f, l_reg = 0.f; f32x16 o[4];
#pragma unroll
    for (int d = 0; d < 4; ++d) o[d] = f32x16{};
    int offA, offB, offV;
    { const int sidx = wid * 64 + lane; { const int row = sidx >> 3, c = (sidx & 7) ^ ((row >> 1) & 7); offA = row * (int)a.ks + 16 * c; }
      { const int row = (sidx & 255) >> 2, c = (sidx & 3) ^ ((row >> 2) & 3); offB = row * (int)a.k2s + 16 * c; }
      { const int d = sidx >> 2, c = (sidx & 3) ^ ((d >> 2) & 3); offV = d * (int)a.vts + 16 * c; } }
#define A8_DMA(kb_, bf, vs_) do { \
        __builtin_amdgcn_global_load_lds((const unsigned*)(a.K + (long)(kb_) * a.ks + offA), (LAS unsigned*)(lds + OFF_K + (bf) * SHM_K + wid * 1024), 16, 0, 0); \
        __builtin_amdgcn_global_load_lds((const unsigned*)(a.VT + (kb_) + offV), (LAS unsigned*)(lds + OFF_V + (vs_) * SHM_V + wid * 1024), 16, 0, 0); \
        if (wid < 4) __builtin_amdgcn_global_load_lds((const unsigned*)(a.K2 + (long)(kb_) * a.k2s + offB), (LAS unsigned*)(lds + OFF_K + (bf) * SHM_K + 8192 + wid * 1024), 16, 0, 0); } while (0)
    unsigned kaA[2][2], kaB[2], va[2];
#pragma unroll
    for (int e = 0; e < 2; ++e) {
#pragma unroll
        for (int s = 0; s < 2; ++s) kaA[s][e] = ldsb + OFF_K + r32 * 128 + (((4 * s + 2 * hi + e) ^ ((r32 >> 1) & 7)) << 4);
        kaB[e] = ldsb + OFF_K + 8192 + r32 * 64 + (((2 * hi + e) ^ ((r32 >> 2) & 3)) << 4);
        va[e] = ldsb + OFF_V + r32 * 64 + (((2 * hi + e) ^ ((r32 >> 2) & 3)) << 4); }
    const int qlo = a.q0 + wid * 32, qm = qlo + r32 - 4 * hi, NT = a.j_hi;
    const float NEGINF = -__builtin_inff();
#define RD16(dst, base, off) asm volatile("ds_read_b128 %0, %1 offset:%2" : "=&v"(dst) : "v"(base), "i"(off) : "memory")
#define LGK(n) asm volatile("s_waitcnt lgkmcnt(" #n ")" ::: "memory")
#define MMA8(acc_, a_, b_) asm volatile("s_nop 1\n\tv_mfma_scale_f32_32x32x64_f8f6f4 %0, %1, %2, %0, %3, %3 op_sel_hi:[0,0,0]" : "+v"(acc_) : "v"(a_), "v"(b_), "v"(sc1))
#define MMA8Z(acc_, a_, b_) asm volatile("s_nop 1\n\tv_mfma_scale_f32_32x32x64_f8f6f4 %0, %1, %2, 0, %3, %3 op_sel_hi:[0,0,0]" : "=&v"(acc_) : "v"(a_), "v"(b_), "v"(sc1))
#define MMAQ(acc_, a_, b_) asm volatile("s_nop 1\n\tv_mfma_scale_f32_32x32x64_f8f6f4 %0, %1, %2, %0, %3, %4 op_sel_hi:[0,0,0]" : "+v"(acc_) : "v"(a_), "v"(b_), "v"(sc1), "v"(scq))
#define MMAQZ(acc_, a_, b_) asm volatile("s_nop 1\n\tv_mfma_scale_f32_32x32x64_f8f6f4 %0, %1, %2, 0, %3, %4 op_sel_hi:[0,0,0]" : "=&v"(acc_) : "v"(a_), "v"(b_), "v"(sc1), "v"(scq))
#define MMAQC(acc_, a_, b_, c_) asm volatile("s_nop 1\n\tv_mfma_scale_f32_32x32x64_f8f6f4 %0, %1, %2, %3, %4, %5 op_sel_hi:[0,0,0]" : "=&v"(acc_) : "v"(a_), "v"(b_), "v"(c_), "v"(sc1), "v"(scq))
#define MK8(x_, l_, h_) x_ = (i32x8){l_[0], l_[1], l_[2], l_[3], h_[0], h_[1], h_[2], h_[3]}
#define KRD(s_, BUF, l0, h0, l1, h1) do { if constexpr ((s_) < 2) { RD16(l0, kaA[s_][0], (BUF) * SHM_K); RD16(h0, kaA[s_][1], (BUF) * SHM_K); RD16(l1, kaA[s_][0], (BUF) * SHM_K + 4096); RD16(h1, kaA[s_][1], (BUF) * SHM_K + 4096); } \
        else { RD16(l0, kaB[0], (BUF) * SHM_K); RD16(h0, kaB[1], (BUF) * SHM_K); RD16(l1, kaB[0], (BUF) * SHM_K + 2048); RD16(h1, kaB[1], (BUF) * SHM_K + 2048); } } while (0)
#define VRD(d0_, vb0_, vb1_, l0, h0) do { RD16(l0, vb0_, (d0_) * 2048); RD16(h0, vb1_, (d0_) * 2048); } while (0)

#define PV_PRE(vb0_, vb1_) do { i32x4 yl, yh; i32x8 fv; \
        VRD(0, vb0_, vb1_, vxl, vxh); VRD(1, vb0_, vb1_, yl, yh); \
        asm volatile("s_nop 3" : "+v"(pa)); \
        LGK(2); SBAR(); MK8(fv, vxl, vxh); MMA8(o[0], pa, fv); SBAR(); VRD(2, vb0_, vb1_, vxl, vxh); \
        LGK(2); SBAR(); MK8(fv, yl, yh); MMA8(o[1], pa, fv); SBAR(); VRD(3, vb0_, vb1_, yl, yh); \
        LGK(2); SBAR(); MK8(fv, vxl, vxh); MMA8(o[2], pa, fv); SBAR(); \
        LGK(0); SBAR(); MK8(fv, yl, yh); MMA8(o[3], pa, fv); SBAR(); } while (0)
#define MAX3(acc_, x_, y_) asm("v_max3_f32 %0, %0, %1, %2" : "+v"(acc_) : "v"(x_), "v"(y_))
#define ADD1(acc_, x_) asm("v_add_f32 %0, %0, %1" : "+v"(acc_) : "v"(x_))
#define BAR_RAW() asm volatile("s_barrier" ::: "memory")
#define BAR_DMA() asm volatile("s_waitcnt vmcnt(0) lgkmcnt(0)\n\ts_barrier" ::: "memory")
#define SEG_M(t, BUF, FIRST_) do { \
        const int kb = (t) * 64; \
        act = kb <= qlo + 31; \
        if (act_prev) PV_PRE(vp0, vp1);                                  \
        if (act) { \
            i32x4 xl0, xh0, xl1, xh1, yl0, yh0, yl1, yh1; i32x8 f0, f1; \
            KRD(0, BUF, xl0, xh0, xl1, xh1); KRD(1, BUF, yl0, yh0, yl1, yh1); \
            LGK(4); SBAR(); MK8(f0, xl0, xh0); MK8(f1, xl1, xh1); \
            if (FIRST_) { MMAQZ(p0, f0, qf[0]); MMAQZ(p1, f1, qf[0]); } else { MMAQC(p0, f0, qf[0], nm); MMAQC(p1, f1, qf[0], nm); } \
            SBAR(); KRD(2, BUF, xl0, xh0, xl1, xh1); \
            LGK(4); SBAR(); MK8(f0, yl0, yh0); MK8(f1, yl1, yh1); MMAQ(p0, f0, qf[1]); MMAQ(p1, f1, qf[1]); SBAR(); \
            LGK(0); SBAR(); MK8(f0, xl0, xh0); MK8(f1, xl1, xh1); MMAQ(p0, f0, qf[2]); MMAQ(p1, f1, qf[2]); SBAR(); } \
          \
        VM_WAIT(); \
        if ((t) + 2 < NT) A8_DMA(kb + 128, ((BUF) + 2) % 3, ((vsel + 2) & 3)); \
        asm volatile("s_nop 15\n\ts_nop 7" : "+v"(p0), "+v"(p1)); \
        BAR_RAW(); \
    } while (0)
#define SEG_V(t, BUF, FIRST_) do { \
        const int kb = (t) * 64; \
        if (act) { \
            const int dq = qm - kb; \
            if (kb + 63 > qlo) { \
                _Pragma("unroll") for (int r = 0; r < 16; ++r) { const int c = (r & 3) + 8 * (r >> 2); if (dq - c < 0) p0[r] = NEGINF; if (dq - c - 32 < 0) p1[r] = NEGINF; } } \
            float pmx[4] = {p0[0], p0[1], p0[2], p0[3]}; \
            _Pragma("unroll") for (int r = 4; r < 16; r += 2) MAX3(pmx[(r >> 1) & 3], p0[r], p0[r + 1]); \
            _Pragma("unroll") for (int r = 0; r < 16; r += 2) MAX3(pmx[(r >> 1) & 3], p1[r], p1[r + 1]); \
            float pmax; asm("v_max3_f32 %0, %1, %2, %3" : "=v"(pmax) : "v"(pmx[0]), "v"(pmx[1]), "v"(pmx[2])); asm("v_max_f32 %0, %0, %1" : "+v"(pmax) : "v"(pmx[3])); \
            { auto rr = __builtin_amdgcn_permlane32_swap(__float_as_uint(pmax), __float_as_uint(pmax), false, false); pmax = fmaxf(__uint_as_float(rr[0]), __uint_as_float(rr[1])); } \
            float alpha = 1.f; \
            if (FIRST_) {     \
                const float mn = fmaxf(m_reg, pmax); alpha = __builtin_amdgcn_exp2f(m_reg - mn); m_reg = mn; const float moff = 4.f - m_reg; \
                _Pragma("unroll") for (int r = 0; r < 16; ++r) { p0[r] += moff; p1[r] += moff; } \
                _Pragma("unroll") for (int r = 0; r < 16; ++r) nm[r] = moff; \
            } else if (!__all(pmax - 4.f <= THR)) {     \
                const float delta = fmaxf(pmax - 4.f, 0.f); alpha = __builtin_amdgcn_exp2f(-delta); m_reg += delta; const float moff = 4.f - m_reg; \
                _Pragma("unroll") for (int r = 0; r < 16; ++r) { p0[r] -= delta; p1[r] -= delta; } \
                _Pragma("unroll") for (int r = 0; r < 16; ++r) nm[r] = moff; } \
            if (__any(alpha < 1.f)) { if (hi == 0) al_l[r32] = alpha; LDS_WAIT(); \
                asm volatile("s_nop 15\n\ts_nop 7" : "+v"(o[0]), "+v"(o[1]), "+v"(o[2]), "+v"(o[3])); \
                _Pragma("unroll") for (int r = 0; r < 16; ++r) { const float f = al_l[crow8(r, hi)]; o[0][r] *= f; o[1][r] *= f; o[2][r] *= f; o[3][r] *= f; } } \
            float ps, psa[4];     \
            _Pragma("unroll") for (int r = 0; r < 16; ++r) p0[r] = __builtin_amdgcn_exp2f(p0[r]); \
            _Pragma("unroll") for (int r = 0; r < 16; ++r) p1[r] = __builtin_amdgcn_exp2f(p1[r]); \
            asm volatile("s_nop 0" : "+v"(p0), "+v"(p1));                \
            _Pragma("unroll") for (int r = 0; r < 4; ++r) psa[r] = p0[r]; \
            _Pragma("unroll") for (int r = 4; r < 16; ++r) ADD1(psa[r & 3], p0[r]); \
            _Pragma("unroll") for (int r = 0; r < 16; ++r) ADD1(psa[r & 3], p1[r]); \
            ADD1(psa[0], psa[1]); ADD1(psa[2], psa[3]); ADD1(psa[0], psa[2]); ps = psa[0]; \
            { auto rr = __builtin_amdgcn_permlane32_swap(__float_as_uint(ps), __float_as_uint(ps), false, false); ps = __uint_as_float(rr[0]) + __uint_as_float(rr[1]); } \
            l_reg = l_reg * alpha + ps; \
            _Pragma("unroll") for (int j = 0; j < 4; ++j) { pa[j] = PK4U(p0[4 * j], p0[4 * j + 1], p0[4 * j + 2], p0[4 * j + 3]); pa[4 + j] = PK4U(p1[4 * j], p1[4 * j + 1], p1[4 * j + 2], p1[4 * j + 3]); } \
        } \
        act_prev = act; vp0 = vc0; vp1 = vc1; vsel = (vsel + 1) & 3; vc0 = va[0] + (unsigned)vsel * SHM_V; vc1 = va[1] + (unsigned)vsel * SHM_V; \
        BAR_RAW(); \
    } while (0)

    f32x16 nm = f32x16{}, p0 = f32x16{}, p1 = f32x16{};
    i32x8 pa = i32x8{}; bool act = false, act_prev = false; int vsel = 0; unsigned vc0 = va[0], vc1 = va[1], vp0 = va[0], vp1 = va[1];
    i32x4 vxl, vxh;
    A8_DMA(0, 0, 0); if (1 < NT) A8_DMA(64, 1, 1);
    BAR_DMA();
    if (a.trail) BAR_RAW();
    SEG_M(0, 0, 1); SEG_V(0, 0, 1);
    for (int t = 1; t < NT; t += 3) {
        SEG_M(t, 1, 0); SEG_V(t, 1, 0);
        if (t + 1 < NT) { SEG_M(t + 1, 2, 0); SEG_V(t + 1, 2, 0); }
        if (t + 2 < NT) { SEG_M(t + 2, 0, 0); SEG_V(t + 2, 0, 0); } }
    if (act_prev) PV_PRE(vp0, vp1);
    if (!a.trail) BAR_RAW();

    asm volatile("s_nop 15\n\ts_nop 7" : "+v"(o[0]), "+v"(o[1]), "+v"(o[2]), "+v"(o[3]));
    if (hi == 0) li_l[r32] = l_reg;
    LDS_WAIT();
#pragma unroll
    for (int r = 0; r < 16; ++r) { const int orow = crow8(r, hi); const float rl = 64.f * __builtin_amdgcn_rcpf(li_l[orow]);
        *(unsigned*)(a.O8 + (long)(wid * 32 + orow) * a.o8s + 4 * r32) = pk4_fp8(o[0][r] * rl, o[1][r] * rl, o[2][r] * rl, o[3][r] * rl); }
    asm volatile("s_waitcnt lgkmcnt(0)\n\ts_barrier" ::: "memory");
#undef A8_DMA
#undef RD16
#undef LGK
#undef MMA8
#undef MMA8Z
#undef MMAQ
#undef MMAQZ
#undef MMAQC
#undef MK8
#undef KRD
#undef VRD
#undef SEG_M
#undef MAX3
#undef ADD1
#undef PK4U
#undef SEG_V
#undef BAR_RAW
#undef BAR_DMA
#undef PV_PRE
}
}

template <class RowMap>
__device__ __forceinline__ void transpose_item(const float* W, int ldw, int K, int k0, int nsrc0, bf16* WT, RowMap rm, LAS float* scr, int lane) {
#pragma unroll
    for (int i = 0; i < 8; ++i) { const int kk = 8 * i + (lane >> 3); const f32x4 v = *(const f32x4*)(W + (size_t)(k0 + kk) * ldw + nsrc0 + 4 * (lane & 7)); LAS float* d = scr + kk * 33 + 4 * (lane & 7); d[0] = v.x; d[1] = v.y; d[2] = v.z; d[3] = v.w; }
    LDS_WAIT(); asm volatile("" ::: "memory");
    const int c = lane & 7;
#pragma unroll
    for (int j = 0; j < 4; ++j) { const int n = (lane >> 3) + 8 * j; const LAS float* s = scr + (8 * c) * 33 + n;
        v4u o; o.x = pk2(s[0 * 33], s[1 * 33]); o.y = pk2(s[2 * 33], s[3 * 33]); o.z = pk2(s[4 * 33], s[5 * 33]); o.w = pk2(s[6 * 33], s[7 * 33]);
        *(v4u*)(WT + (size_t)rm(nsrc0 + n) * K + k0 + 8 * c) = o; }
    LDS_WAIT(); asm volatile("" ::: "memory");
}
struct KmIdent { __device__ __forceinline__ int operator()(int k) const { return k; } };
struct KmAttn { __device__ __forceinline__ int operator()(int k) const { return (k & ~127) + 32 * (k & 3) + ((k & 127) >> 2); } };
template <class RowMap, class KMap = KmIdent>
__device__ __forceinline__ void transpose_item8(const float* W, int ldw, int K, int k0, int nsrc0, unsigned char* WT, RowMap rm, LAS float* scr, int lane, KMap km = KMap()) {
#pragma unroll
    for (int i = 0; i < 8; ++i) { const int kk = 8 * i + (lane >> 3); const f32x4 v = *(const f32x4*)(W + (size_t)km(k0 + kk) * ldw + nsrc0 + 4 * (lane & 7)); LAS float* d = scr + kk * 33 + 4 * (lane & 7); d[0] = v.x; d[1] = v.y; d[2] = v.z; d[3] = v.w; }
    LDS_WAIT(); asm volatile("" ::: "memory");
    const int c = lane & 7;
#pragma unroll
    for (int j = 0; j < 4; ++j) { const int n = (lane >> 3) + 8 * j; const LAS float* s = scr + (8 * c) * 33 + n;
        v2u o; o.x = pk4_fp8(64.f * s[0 * 33], 64.f * s[1 * 33], 64.f * s[2 * 33], 64.f * s[3 * 33]); o.y = pk4_fp8(64.f * s[4 * 33], 64.f * s[5 * 33], 64.f * s[6 * 33], 64.f * s[7 * 33]);
        *(v2u*)(WT + (size_t)rm(nsrc0 + n) * K + k0 + 8 * c) = o; }
    LDS_WAIT(); asm volatile("" ::: "memory");
}
struct RmIdent { __device__ __forceinline__ int operator()(int c) const { return c; } };
struct RmGate { __device__ __forceinline__ int operator()(int c) const { const int cp = c - 7232, half = cp >> 11, cc = cp & 2047; return 256 * (cc >> 7) + 128 * half + (cc & 127); } };
struct RmUq { __device__ __forceinline__ int operator()(int c) const { const int head = c / 192, off = c - head * 192; if (off < 128) return c; const int j = off - 128; return head * 192 + 128 + 2 * (j & 31) + (j >> 5); } };

__device__ __forceinline__ void sincos_d(double x, float& s, float& c) {
    const double TWO_PI = 6.283185307179586476925286766559;
    const double k = __builtin_rint(x * (1.0 / TWO_PI)); double r = x - k * TWO_PI;
    const double r2 = r * r; double ss = 1.0, cc = 1.0, ts = 1.0, tc = 1.0;
#pragma unroll
    for (int i = 1; i <= 14; ++i) { tc *= -r2 * (1.0 / (double)((2 * i - 1) * (2 * i))); ts *= -r2 * (1.0 / (double)((2 * i) * (2 * i + 1))); cc += tc; ss += ts; }
    s = (float)(ss * r); c = (float)cc;
}

namespace peer {
__device__ __forceinline__ unsigned ordf(float f) { const unsigned u = __float_as_uint(f); return u ^ ((unsigned)((int)u >> 31) | 0x80000000u); }
__device__ __forceinline__ float unordf(unsigned o) { return __uint_as_float(o ^ ((unsigned)((~(int)o) >> 31) | 0x80000000u)); }
__device__ __forceinline__ void sort16_desc(unsigned (&v)[16]) {
#pragma unroll
    for (int k = 2; k <= 16; k <<= 1)
#pragma unroll
        for (int j = k >> 1; j > 0; j >>= 1)
#pragma unroll
            for (int i = 0; i < 16; ++i) { const int l = i ^ j; if (l > i) { const bool desc = ((i & k) == 0);
                const unsigned hi = v[i] > v[l] ? v[i] : v[l], lo = v[i] > v[l] ? v[l] : v[i]; v[i] = desc ? hi : lo; v[l] = desc ? lo : hi; } }
}
__device__ __forceinline__ void merge16_desc(unsigned (&a)[16], const unsigned (&b)[16]) {
#pragma unroll
    for (int i = 0; i < 16; ++i) a[i] = a[i] > b[15 - i] ? a[i] : b[15 - i];
#pragma unroll
    for (int j = 8; j > 0; j >>= 1)
#pragma unroll
        for (int i = 0; i < 16; ++i) { const int l = i ^ j; if (l > i) { const unsigned hi = a[i] > a[l] ? a[i] : a[l], lo = a[i] > a[l] ? a[l] : a[i]; a[i] = hi; a[l] = lo; } }
}
__device__ __forceinline__ void insert_desc(unsigned (&a)[16], unsigned x) {
#pragma unroll
    for (int i = 0; i < 16; ++i) { const unsigned hi = a[i] > x ? a[i] : x, lo = a[i] > x ? x : a[i]; a[i] = hi; x = lo; }
}
__device__ __forceinline__ void top16_of_128(const f32x16 (&acc)[4], int hi, unsigned (&out)[16]) {
    unsigned g[4][16];
#pragma unroll
    for (int kb = 0; kb < 4; ++kb)
#pragma unroll
        for (int r = 0; r < 16; ++r) { const unsigned base = (unsigned)(kb * 32 + (r & 3) + 8 * (r >> 2)); g[kb][r] = ((ordf(acc[kb][r]) & ~127u) | (127u - base)) ^ (unsigned)(4 * hi); }
    sort16_desc(g[0]); sort16_desc(g[1]); sort16_desc(g[2]); sort16_desc(g[3]);
    merge16_desc(g[0], g[1]); merge16_desc(g[2], g[3]); merge16_desc(g[0], g[2]);
    unsigned pr[16];
#pragma unroll
    for (int i = 0; i < 16; ++i) { auto rr = __builtin_amdgcn_permlane32_swap(g[0][i], g[0][i], false, false); pr[i] = hi ? rr[0] : rr[1]; }
    merge16_desc(g[0], pr);
#pragma unroll
    for (int i = 0; i < 16; ++i) out[i] = g[0][i];
}
__device__ __forceinline__ unsigned ckey(float v, int tag) { return (ordf(v) & ~255u) | (unsigned)(255 - tag); }
}

__device__ __forceinline__ float wave_total_dpp(float v) {
    int x = __builtin_bit_cast(int, v);
#define DPP_ADD(ctrl_, rmask_) do { const int t_ = __builtin_amdgcn_update_dpp(0, x, ctrl_, rmask_, 0xf, false); x = __builtin_bit_cast(int, __builtin_bit_cast(float, x) + __builtin_bit_cast(float, t_)); } while (0)
    DPP_ADD(0xB1, 0xf);
    DPP_ADD(0x4E, 0xf);
    DPP_ADD(0x141, 0xf);
    DPP_ADD(0x140, 0xf);
    DPP_ADD(0x142, 0xa);
    DPP_ADD(0x143, 0xc);
#undef DPP_ADD
    return __builtin_bit_cast(float, __builtin_amdgcn_readlane(x, 63));
}
__device__ __forceinline__ void wave_total_dpp4(float (&v)[4]) {
#define DPP_ADD8(ctrl_, rmask_) do { _Pragma("unroll") for (int u = 0; u < 4; ++u) { const int x_ = __builtin_bit_cast(int, v[u]); const int t_ = __builtin_amdgcn_update_dpp(0, x_, ctrl_, rmask_, 0xf, false); v[u] += __builtin_bit_cast(float, t_); } } while (0)
    DPP_ADD8(0xB1, 0xf); DPP_ADD8(0x4E, 0xf); DPP_ADD8(0x141, 0xf); DPP_ADD8(0x140, 0xf); DPP_ADD8(0x142, 0xa); DPP_ADD8(0x143, 0xc);
#undef DPP_ADD8
}
__device__ __forceinline__ float wave_max_nonneg_dpp(float v) {
    int x = __builtin_bit_cast(int, v);
#define DPP_MAX(ctrl_, rmask_) do { const int t_ = __builtin_amdgcn_update_dpp(0, x, ctrl_, rmask_, 0xf, false); x = __builtin_bit_cast(int, fmaxf(__builtin_bit_cast(float, x), __builtin_bit_cast(float, t_))); } while (0)
    DPP_MAX(0xB1, 0xf); DPP_MAX(0x4E, 0xf); DPP_MAX(0x141, 0xf); DPP_MAX(0x140, 0xf); DPP_MAX(0x142, 0xa); DPP_MAX(0x143, 0xc);
#undef DPP_MAX
    return __builtin_bit_cast(float, __builtin_amdgcn_readlane(x, 63));
}
__device__ __forceinline__ float gelu_erf(float v) {
    const float av = __builtin_fabsf(v), t = __builtin_amdgcn_rcpf(av * 0.2316418882f + 1.0f);
    float q = t * 0.5307027145f + (-0.7265760135f); q = q * t + 0.7107068705f; q = q * t + (-0.142248368f); q = q * t + 0.127414796f; q = q * t;
    const float e = __builtin_amdgcn_exp2f((v * v) * (-0.72134752044f));
    const float m = v * (q * e);
    return v < 0.f ? m : v - m;
}

constexpr int PTBL_OFF = MISC_OFF + 64;
__device__ __forceinline__ void* ldp(LAS unsigned char* lds, int k) { const v2u w = *(LAS const v2u*)(lds + PTBL_OFF + 8 * k);
    const unsigned lo = (unsigned)__builtin_amdgcn_readfirstlane((int)w.x), hi = (unsigned)__builtin_amdgcn_readfirstlane((int)w.y); return (void*)(((unsigned long long)hi << 32) | lo); }
struct Args { const float* in[19]; float* out; unsigned char* ws; int ph_lo, ph_hi, bli, pad; };
__global__ void __launch_bounds__(512, 2) mk_fwd(Args args) {
    extern __shared__ __attribute__((aligned(16))) unsigned char lds_raw[];
    LAS unsigned char* lds = (LAS unsigned char*)lds_raw;
    const int tid = threadIdx.x, lane = tid & 63, wave = __builtin_amdgcn_readfirstlane(tid >> 6);
    const int G = gridDim.x, bx = blockIdx.x;
    const int vcu = (G % 8 == 0) ? (bx % 8) * (G / 8) + bx / 8 : bx;
    const int gw = vcu * 8 + wave, NGW = G * 8;
    unsigned char* ws = args.ws;
#define p_x ((const float*)ldp(lds, 0))
#define p_w_in ((const float*)ldp(lds, 1))
#define p_b_gates ((const float*)ldp(lds, 2))
#define p_a_w_out ((const float*)ldp(lds, 3))
#define p_q_norm ((const float*)ldp(lds, 4))
#define p_w_uq ((const float*)ldp(lds, 5))
#define p_kv_norm ((const float*)ldp(lds, 6))
#define p_w_ukv ((const float*)ldp(lds, 7))
#define p_mla_w_out ((const float*)ldp(lds, 8))
#define p_w_out ((const float*)ldp(lds, 9))
#define p_ln1_g ((const float*)ldp(lds, 10))
#define p_ln1_b ((const float*)ldp(lds, 11))
#define p_w_pq ((const float*)ldp(lds, 12))
#define p_sk1 ((const float*)ldp(lds, 13))
#define p_sk2 ((const float*)ldp(lds, 14))
#define p_e_down ((const float*)ldp(lds, 15))
#define p_e_up ((const float*)ldp(lds, 16))
#define p_ln2_g ((const float*)ldp(lds, 17))
#define p_ln2_b ((const float*)ldp(lds, 18))
#define p_out ((float*)ldp(lds, 19))
#define WA8 ((unsigned char*)(ws + WS_WA))
#define WG8 ((unsigned char*)(ws + WS_WG))
#define WAO ((unsigned char*)(ws + WS_WAO))
#define WBO ((unsigned char*)(ws + WS_WBO))
#define WO ((unsigned char*)(ws + WS_WO))
#define WPQ ((bf16*)(ws + WS_WPQ))
#define WUQ ((unsigned char*)(ws + WS_WUQ))
#define WUKV ((unsigned char*)(ws + WS_WUKV))
#define SK ((bf16*)(ws + WS_SK))
#define ROPE ((float*)(ws + WS_ROPE))
#define XB8 ((unsigned char*)(ws + WS_XB))
#define QKV ((bf16*)(ws + WS_QKV))
#define CQKV ((bf16*)(ws + WS_CQKV))
#define KRRAW ((bf16*)(ws + WS_KRRAW))
#define CQN ((unsigned char*)(ws + WS_CQN))
#define CKVN ((unsigned char*)(ws + WS_CKVN))
#define KRR ((unsigned char*)(ws + WS_KRR))
#define LSEB ((float*)(ws + WS_LSE))
#define OA ((bf16*)(ws + WS_OA))
#define OA8 ((unsigned char*)(ws + WS_OA8))
#define QB ((unsigned char*)(ws + WS_QB))
#define KN ((unsigned char*)(ws + WS_KN))
#define VT8 ((unsigned char*)(ws + WS_VT))
#define OB8 ((unsigned char*)(ws + WS_OB))
#define VB ((bf16*)(ws + WS_VB))
#define YA ((unsigned char*)(ws + WS_YA))
#define YB ((unsigned char*)(ws + WS_YB))
#define UB ((unsigned char*)(ws + WS_U))
#define RB ((bf16*)(ws + WS_R))
#define H1B ((bf16*)(ws + WS_H1B))
#define ED8 ((unsigned char*)(ws + WS_ED))
#define EU8 ((unsigned char*)(ws + WS_EU))
#define SD ((float*)(ws + WS_SD))
#define SU ((float*)(ws + WS_SU))
#define PQ ((bf16*)(ws + WS_PQ))
#define IDX ((int*)(ws + WS_IDX))
#define GATE ((float*)(ws + WS_GATE))

    if (tid == 0) {
#define PT(k, p) *(LAS unsigned long long*)(lds + PTBL_OFF + 8 * (k)) = (unsigned long long)(uintptr_t)(p)
        PT(0, args.in[0]); PT(1, args.in[1]); PT(2, args.in[2]); PT(3, args.in[3]); PT(4, args.in[4]); PT(5, args.in[5]); PT(6, args.in[6]); PT(7, args.in[7]); PT(8, args.in[8]); PT(9, args.in[9]);
        PT(10, args.in[10]); PT(11, args.in[11]); PT(12, args.in[12]); PT(13, args.in[13]); PT(14, args.in[14]); PT(15, args.in[15]); PT(16, args.in[16]); PT(17, args.in[17]); PT(18, args.in[18]); PT(19, args.out);
#undef PT
    }
    if (tid < 4) ((LAS unsigned*)(lds + MISC_OFF))[tid] = 0u;
    __syncthreads();
    const int lo = args.ph_lo, hi = args.ph_hi;
    const bool use_bar = true;
    XcdBarrier bar; bar.bar = (unsigned*)(ws + WS_CTL) + CW_BAR + args.bli * XCD_BAR_WORDS; bar.x = 0; bar.st = nullptr;
    if (use_bar) bar = xcd_barrier_post((unsigned*)(ws + WS_CTL) + CW_BAR + args.bli * XCD_BAR_WORDS, (volatile LAS unsigned*)(lds + MISC_OFF));
#ifndef MK_PHASES
#define MK_PHASES 0xFFFFFFFFu
#endif
#define IN(k) ((((MK_PHASES) >> (k)) & 1u) && lo <= (k) && (k) < hi)
#define SEAM(k) do { if (IN(k) && IN((k) + 1)) xcd_barrier(bar); } while (0)

    if (IN(0)) {
        LAS float* scr = (LAS float*)(lds + wave * 16384);
        const float* c_w_in = p_w_in; const float* c_a_w_out = p_a_w_out; const float* c_mla_w_out = p_mla_w_out; const float* c_w_out = p_w_out; const float* c_w_pq = p_w_pq; const float* c_w_uq = p_w_uq; const float* c_w_ukv = p_w_ukv;
        const float* c_x = p_x; const float* c_sk1 = p_sk1; const float* c_sk2 = p_sk2;
        constexpr int I_A = 32 * 226, I_G = 32 * 128, I_SQ = 32 * 64, I_UQ = 8 * 96, I_UKV = 8 * 128;
        constexpr int NITEMS = I_A + I_G + 4 * I_SQ + I_UQ + I_UKV;
        for (int it = gw; it < NITEMS; it += NGW) {
            int r = it;
            if (r < I_A) { transpose_item8(c_w_in, IN_W, DM, 64 * (r / 226), 32 * (r % 226), WA8, RmIdent(), scr, lane); continue; } r -= I_A;
            if (r < I_G) { transpose_item8(c_w_in, IN_W, DM, 64 * (r / 128), 7232 + 32 * (r % 128), WG8, RmGate(), scr, lane); continue; } r -= I_G;
            if (r < I_SQ) { transpose_item8(c_a_w_out, DM, DM, 64 * (r / 64), 32 * (r % 64), WAO, RmIdent(), scr, lane, KmAttn()); continue; } r -= I_SQ;
            if (r < I_SQ) { transpose_item8(c_mla_w_out, DM, DM, 64 * (r / 64), 32 * (r % 64), WBO, RmIdent(), scr, lane, KmAttn()); continue; } r -= I_SQ;
            if (r < I_SQ) { transpose_item8(c_w_out, DM, DM, 64 * (r / 64), 32 * (r % 64), WO, RmIdent(), scr, lane); continue; } r -= I_SQ;
            if (r < I_SQ) { transpose_item(c_w_pq, DM, DM, 64 * (r / 64), 32 * (r % 64), WPQ, RmIdent(), scr, lane); continue; } r -= I_SQ;
            if (r < I_UQ) { transpose_item8(c_w_uq, NQB, QL, 64 * (r / 96), 32 * (r % 96), WUQ, RmUq(), scr, lane); continue; } r -= I_UQ;
            transpose_item8(c_w_ukv, NKV, QL, 64 * (r / 128), 32 * (r % 128), WUKV, RmIdent(), scr, lane);
        }
        const size_t gt = (size_t)vcu * 512 + tid, NT_ = (size_t)G * 512;
        for (size_t i = gt; i < (size_t)192 * DM / 16; i += NT_) *(v4u*)(WA8 + (size_t)7232 * DM + i * 16) = (v4u){0u, 0u, 0u, 0u};
        for (size_t i = gt; i < (size_t)T * DM / 16; i += NT_) { const f32x4 a = *(const f32x4*)(c_x + i * 16), b = *(const f32x4*)(c_x + i * 16 + 4), c = *(const f32x4*)(c_x + i * 16 + 8), d = *(const f32x4*)(c_x + i * 16 + 12);
            *(v4u*)(XB8 + i * 16) = (v4u){pk4_fp8(a[0], a[1], a[2], a[3]), pk4_fp8(b[0], b[1], b[2], b[3]), pk4_fp8(c[0], c[1], c[2], c[3]), pk4_fp8(d[0], d[1], d[2], d[3])}; }
        for (size_t i = gt; i < 2 * 16384; i += NT_) SK[i] = (bf16)f2bf(i < 16384 ? c_sk1[i] : c_sk2[i - 16384]);
        for (size_t i = gt; i < (size_t)SEQ * 32; i += NT_) { const int pos = (int)(i >> 5), j = (int)(i & 31);
            const float inv = (float)exp2(-(double)j / 32.0 * 13.287712379549449);
            const float ang = (float)pos * inv; float s, c; sincos_d((double)ang, s, c); ROPE[2 * i] = c; ROPE[2 * i + 1] = s; }
    }
    SEAM(0);

    if (IN(1)) {
        pg8::Gemm g{(const bf16*)XB8, (const bf16*)WA8, T, NA, DM / 2}; pg8::StaticOrder S; S.init(T, NA, G, bx);
        pg8::EpiA E{QKV, CQKV, KRRAW, 1.f / 64.f};
        pg8::gemm_phase8<pg8::EpiA, pg8::StaticOrder>(lds, g, S, E, nullptr);
    }
    SEAM(1);

    if (IN(2)) {
        const float* c_q_norm = p_q_norm; const float* c_kv_norm = p_kv_norm;
        for (int t = gw; t < T; t += NGW) {
            const v4u cq = *(const v4u*)(CQKV + (size_t)t * 1024 + lane * 8), ck = *(const v4u*)(CQKV + (size_t)t * 1024 + 512 + lane * 8);
            float fq[8] = {bf_lo(cq.x), bf_hi(cq.x), bf_lo(cq.y), bf_hi(cq.y), bf_lo(cq.z), bf_hi(cq.z), bf_lo(cq.w), bf_hi(cq.w)};
            float fk[8] = {bf_lo(ck.x), bf_hi(ck.x), bf_lo(ck.y), bf_hi(ck.y), bf_lo(ck.z), bf_hi(ck.z), bf_lo(ck.w), bf_hi(ck.w)};
            float sq = 0.f, sk = 0.f;
#pragma unroll
            for (int e = 0; e < 8; ++e) { sq += fq[e] * fq[e]; sk += fk[e] * fk[e]; }
            const float rq = 1.f / sqrtf(wave_sum(sq) * (1.f / 512.f) + RMS_EPS), rk = 1.f / sqrtf(wave_sum(sk) * (1.f / 512.f) + RMS_EPS);
            const f32x4 gq0 = *(const f32x4*)(c_q_norm + lane * 8), gq1 = *(const f32x4*)(c_q_norm + lane * 8 + 4), gk0 = *(const f32x4*)(c_kv_norm + lane * 8), gk1 = *(const f32x4*)(c_kv_norm + lane * 8 + 4);
            *(v2u*)(CQN + (size_t)t * 512 + lane * 8) = (v2u){pk4_fp8(fq[0] * rq * gq0[0], fq[1] * rq * gq0[1], fq[2] * rq * gq0[2], fq[3] * rq * gq0[3]), pk4_fp8(fq[4] * rq * gq1[0], fq[5] * rq * gq1[1], fq[6] * rq * gq1[2], fq[7] * rq * gq1[3])};
            *(v2u*)(CKVN + (size_t)t * 512 + lane * 8) = (v2u){pk4_fp8(fk[0] * rk * gk0[0], fk[1] * rk * gk0[1], fk[2] * rk * gk0[2], fk[3] * rk * gk0[3]), pk4_fp8(fk[4] * rk * gk1[0], fk[5] * rk * gk1[1], fk[6] * rk * gk1[2], fk[7] * rk * gk1[3])};
            const int i = lane & 31; const float t1 = bf2f(KRRAW[(size_t)t * 64 + i]), t2 = bf2f(KRRAW[(size_t)t * 64 + 32 + i]);
            const f32x2 cs = *(const f32x2*)(ROPE + ((size_t)(t & (SEQ - 1)) * 32 + i) * 2);
            const float o1 = t1 * cs.x - t2 * cs.y, o2 = t1 * cs.y + t2 * cs.x;
            KRR[(size_t)t * 64 + lane] = (unsigned char)(pk4_fp8(lane < 32 ? o1 : o2, 0.f, 0.f, 0.f) & 0xffu);
        }
    }

#define DIL_DESC(PH, DIL, u_, d) do { \
            const int bh = (u_) >> 6, rem = (u_) & 63, rr = rem / nblk, blk = rem % nblk, b = bh >> 4, h = bh & 15; \
            const size_t tok0 = (size_t)b * SEQ + rr, tq0 = tok0 + (size_t)blk * 256 * (DIL); \
            d.Q = QKV + tq0 * 6144 + h * 128; d.qs = (long)(DIL) * 6144; \
            d.K = QKV + tok0 * 6144 + 2048 + h * 128; d.ks = (long)(DIL) * 6144; d.K2 = nullptr; d.k2s = 0; \
            d.V = QKV + tok0 * 6144 + 4096 + h * 128; d.vs = (long)(DIL) * 6144; \
            d.O = OA + tq0 * DM + h * 128; d.os = (long)(DIL) * DM; d.LSE = LSEB + tq0 * 16 + h; d.ls = (long)(DIL) * 16; \
            d.q0 = blk * 256; d.j_lo = blk == 0 ? 0 : blk * 4 - 2; d.j_hi = blk * 4 + 4; \
            d.sl = __builtin_exp2f(-0.5f * (float)(h + 1)) * (float)(DIL) * LOG2E; d.first = ((PH) == 3); \
            d.O8 = ((PH) == 5) ? OA8 + tq0 * DM + h * 128 : nullptr; d.o8s = (long)(DIL) * DM; } while (0)
#define DIL_PASS(PH, DIL, LOG2D) \
    if (IN(PH)) { \
        constexpr int nblk = SEQ / (DIL) / 256; \
        bf16x8 qr[8]; att::Desc d, dn; \
        if (vcu < 2048) { DIL_DESC(PH, DIL, vcu, d); att::attn_prime<1>(lds, d, qr); } \
        for (int u = vcu; u < 2048; u += G) { \
            const bool hn = u + G < 2048; \
            if (hn) DIL_DESC(PH, DIL, u + G, dn); else dn = d; \
            att::attn_unit<1>(lds, d, dn, hn, qr); \
            d = dn; } }
    DIL_PASS(3, 1, 0)
    SEAM(3);
    DIL_PASS(4, 4, 2)
    SEAM(4);
    DIL_PASS(5, 16, 4)
    SEAM(5);

    if (IN(6)) {
        pg8::Gemm g{(const bf16*)CQN, (const bf16*)WUQ, T, NQB, QL / 2}; pg8::StaticOrder S; S.init(T, NQB, G, bx);
        pg8::EpiQ E{QB, ROPE, QSC_B * att8::QPRE / 64.f};
        pg8::gemm_phase8<pg8::EpiQ, pg8::StaticOrder>(lds, g, S, E, nullptr);
    }
    if (IN(7)) {
        pg8::Gemm g{(const bf16*)CKVN, (const bf16*)WUKV, T, NKV, QL / 2}; pg8::StaticOrder S; S.init(T, NKV, G, bx);
        pg8::EpiKV E{KN, VT8, lds + MISC_OFF + 1024 + (tid >> 6) * 1536, 1.f / 64.f};
        pg8::gemm_phase8<pg8::EpiKV, pg8::StaticOrder>(lds, g, S, E, nullptr);
    }
    SEAM(7);

    if (IN(8)) {
        int trail;
        { LAS unsigned* cnt = (LAS unsigned*)(lds + 126976);
          if (tid < 4) cnt[tid] = 0u;
          __syncthreads();
          const unsigned simd = ((unsigned)__builtin_amdgcn_s_getreg((1 << 11) | (4 << 6) | 4)) & 3u;
          unsigned rk = 0u; if (lane == 0) rk = __hip_atomic_fetch_add(cnt + simd, 1u, __ATOMIC_RELAXED, __HIP_MEMORY_SCOPE_WORKGROUP);
          trail = (int)(__builtin_amdgcn_readfirstlane((int)rk) & 1);
          __syncthreads(); }
        for (int it = vcu; it < 1024; it += G) {
            const int bh = it >> 5, y = it & 31, b = bh >> 4, h = bh & 15;
#pragma unroll 1
            for (int s = 0; s < 2; ++s) { const int xb_ = s == 0 ? 63 - y : y;
                att8::Desc d; const size_t tb = (size_t)b * SEQ;
                d.Q = QB + (tb + (size_t)xb_ * 256) * NQB + h * 192; d.qs = NQB;
                d.K = KN + tb * DM + h * 128; d.ks = DM; d.K2 = KRR + tb * 64; d.k2s = 64;
                d.VT = VT8 + (size_t)bh * 128 * SEQ; d.vts = SEQ; d.O8 = OB8 + (tb + (size_t)xb_ * 256) * DM + h * 128; d.o8s = DM;
                d.q0 = xb_ * 256; d.j_hi = xb_ * 4 + 4; d.trail = trail;
                att8::attn_unit(lds, d); }
        }
    }
    SEAM(8);

    if (IN(9)) {
        pg8::Gemm g{(const bf16*)OA8, (const bf16*)WAO, T, DM, DM / 2}; pg8::StaticOrder S; S.init(T, DM, G, bx);
        pg8::EpiPlain8 E{YA, DM, 1.f / 64.f};
        pg8::gemm_phase8<pg8::EpiPlain8, pg8::StaticOrder>(lds, g, S, E, nullptr);
    }
    if (IN(10)) {
        pg8::Gemm g{(const bf16*)OB8, (const bf16*)WBO, T, DM, DM / 2}; pg8::StaticOrder S; S.init(T, DM, G, bx);
        pg8::EpiPlain8 E{YB, DM, 1.f / 64.f};
        pg8::gemm_phase8<pg8::EpiPlain8, pg8::StaticOrder>(lds, g, S, E, nullptr);
    }
    SEAM(10);

    if (IN(11)) {
        pg8::Gemm g{(const bf16*)XB8, (const bf16*)WG8, T, NGATE, DM / 2}; pg8::StaticOrder S; S.init(T, NGATE, G, bx);
        pg8::EpiGate E{YA, YB, p_b_gates, UB, 1.f / 64.f};
        pg8::gemm_phase8<pg8::EpiGate, pg8::StaticOrder>(lds, g, S, E, nullptr);
    }
    SEAM(11);

    if (IN(12)) {
        pg8::Gemm g{(const bf16*)UB, (const bf16*)WO, T, DM, DM / 2}; pg8::StaticOrder S; S.init(T, DM, G, bx);
        pg8::EpiResid E{p_x, RB, 1.f / 4096.f};
        pg8::gemm_phase8<pg8::EpiResid, pg8::StaticOrder>(lds, g, S, E, nullptr);
    }
    SEAM(12);

    if (IN(13)) {
        const float* c_ln1_g = p_ln1_g; const float* c_ln1_b = p_ln1_b; const float* c_e_down = p_e_down; const float* c_e_up = p_e_up;
        f32x4 lg[8], lb[8];
#pragma unroll
        for (int j = 0; j < 4; ++j) { const int c = 512 * j + 8 * lane; lg[2 * j] = *(const f32x4*)(c_ln1_g + c); lg[2 * j + 1] = *(const f32x4*)(c_ln1_g + c + 4); lb[2 * j] = *(const f32x4*)(c_ln1_b + c); lb[2 * j + 1] = *(const f32x4*)(c_ln1_b + c + 4); }
        v4u nxw[4];
        if (gw < T) {
#pragma unroll
            for (int j = 0; j < 4; ++j) nxw[j] = *(const v4u*)(RB + (size_t)gw * DM + 512 * j + 8 * lane); }
        for (int t = gw; t < T; t += NGW) {
            float v[32]; float s = 0.f;
#pragma unroll
            for (int j = 0; j < 4; ++j) { const v4u w = nxw[j];
                v[8 * j + 0] = bf_lo(w.x); v[8 * j + 1] = bf_hi(w.x); v[8 * j + 2] = bf_lo(w.y); v[8 * j + 3] = bf_hi(w.y); v[8 * j + 4] = bf_lo(w.z); v[8 * j + 5] = bf_hi(w.z); v[8 * j + 6] = bf_lo(w.w); v[8 * j + 7] = bf_hi(w.w); }
            if (t + NGW < T) {
#pragma unroll
                for (int j = 0; j < 4; ++j) nxw[j] = *(const v4u*)(RB + (size_t)(t + NGW) * DM + 512 * j + 8 * lane); }
#pragma unroll
            for (int i = 0; i < 32; ++i) s += v[i];
            const float mean = wave_sum(s) * (1.f / DM); float s2 = 0.f;
#pragma unroll
            for (int i = 0; i < 32; ++i) { v[i] -= mean; s2 += v[i] * v[i]; }
            const float rstd = 1.f / sqrtf(wave_sum(s2) * (1.f / DM) + LN_EPS);
#pragma unroll
            for (int j = 0; j < 4; ++j) { const int c = 512 * j + 8 * lane; const f32x4 g0 = lg[2 * j], g1 = lg[2 * j + 1], b0 = lb[2 * j], b1 = lb[2 * j + 1];
                *(v4u*)(H1B + (size_t)t * DM + c) = (v4u){pk2(v[8 * j] * rstd * g0[0] + b0[0], v[8 * j + 1] * rstd * g0[1] + b0[1]), pk2(v[8 * j + 2] * rstd * g0[2] + b0[2], v[8 * j + 3] * rstd * g0[3] + b0[3]),
                                                          pk2(v[8 * j + 4] * rstd * g1[0] + b1[0], v[8 * j + 5] * rstd * g1[1] + b1[1]), pk2(v[8 * j + 6] * rstd * g1[2] + b1[2], v[8 * j + 7] * rstd * g1[3] + b1[3])}; }
        }
    }
    SEAM(13);

    if (IN(14)) {
        pg8::Gemm g{H1B, WPQ, T, DM, DM}; pg8::StaticOrder S; S.init(T, DM, G, bx);
        pg8::EpiPlain E{PQ, DM, 1.f};
        pg8::gemm_phase<pg8::EpiPlain, pg8::StaticOrder>(lds, g, S, E, nullptr);
    }
    SEAM(14);

    if (IN(15)) {
        for (int c = tid; c < 4096; c += 512) { const int which = c >> 11, row = (c >> 4) & 127, ch = c & 15;
            *(LAS v4u*)(lds + which * 32768 + row * 256 + ((ch ^ (row & 7)) << 4)) = *(const v4u*)(SK + (size_t)which * 16384 + row * 128 + ch * 8); }
        __syncthreads();
        const int r32 = lane & 31, lh = lane >> 5;
        LAS unsigned char* iscr = lds + 65536 + wave * 1024 + r32 * 32;
        for (int task = gw; task < T * PH / 32; task += NGW) {
            const int Rr = task * 32 + r32;
            const bf16* qp = PQ + (size_t)Rr * 256;
            unsigned K1[16], K2[16];
#pragma unroll
            for (int half = 0; half < 2; ++half) {
                bf16x8 qf[8];
#pragma unroll
                for (int ks = 0; ks < 8; ++ks) qf[ks] = *(const bf16x8*)(qp + half * 128 + ks * 16 + lh * 8);
                f32x16 acc[4];
#pragma unroll
                for (int kb = 0; kb < 4; ++kb) { acc[kb] = f32x16{};
#pragma unroll
                    for (int ks = 0; ks < 8; ++ks) { const bf16x8 af = *(LAS const bf16x8*)(lds + half * 32768 + (kb * 32 + r32) * 256 + (((2 * ks + lh) ^ (r32 & 7)) << 4));
                        acc[kb] = __builtin_amdgcn_mfma_f32_32x32x16_bf16(af, qf[ks], acc[kb], 0, 0, 0); } }
                if (half == 0) peer::top16_of_128(acc, lh, K1); else peer::top16_of_128(acc, lh, K2);
            }
            float v1[16], v2[16]; unsigned i1[16], i2[16];
#pragma unroll
            for (int a = 0; a < 16; ++a) { v1[a] = peer::unordf(K1[a] & ~127u); i1[a] = 127u - (K1[a] & 127u); v2[a] = peer::unordf(K2[a] & ~127u); i2[a] = 127u - (K2[a] & 127u); }
            if (lh == 0) {
                *(LAS v4u*)(iscr) = (v4u){i1[0] | (i1[1] << 8) | (i1[2] << 16) | (i1[3] << 24), i1[4] | (i1[5] << 8) | (i1[6] << 16) | (i1[7] << 24), i1[8] | (i1[9] << 8) | (i1[10] << 16) | (i1[11] << 24), i1[12] | (i1[13] << 8) | (i1[14] << 16) | (i1[15] << 24)};
                *(LAS v4u*)(iscr + 16) = (v4u){i2[0] | (i2[1] << 8) | (i2[2] << 16) | (i2[3] << 24), i2[4] | (i2[5] << 8) | (i2[6] << 16) | (i2[7] << 24), i2[8] | (i2[9] << 8) | (i2[10] << 16) | (i2[11] << 24), i2[12] | (i2[13] << 8) | (i2[14] << 16) | (i2[15] << 24)};
            }
            unsigned g0[16], g1[16], g2[16];
#pragma unroll
            for (int b = 0; b < 16; ++b) g0[b] = peer::ckey(v1[0] + v2[b], b);
#pragma unroll
            for (int a = 1; a < 16; ++a) g1[a - 1] = peer::ckey(v1[a] + v2[0], a * 16);
            g1[15] = 0u;
#define CK(a, b) peer::ckey(v1[a] + v2[b], (a) * 16 + (b))
            g2[0] = CK(1, 1); g2[1] = CK(1, 2); g2[2] = CK(1, 3); g2[3] = CK(1, 4); g2[4] = CK(1, 5); g2[5] = CK(1, 6); g2[6] = CK(1, 7);
            g2[7] = CK(2, 1); g2[8] = CK(2, 2); g2[9] = CK(2, 3); g2[10] = CK(2, 4); g2[11] = CK(3, 1); g2[12] = CK(3, 2); g2[13] = CK(3, 3);
            g2[14] = CK(4, 1); g2[15] = CK(4, 2);
            peer::sort16_desc(g2);
            peer::merge16_desc(g0, g1); peer::merge16_desc(g0, g2);
            peer::insert_desc(g0, CK(5, 1)); peer::insert_desc(g0, CK(6, 1)); peer::insert_desc(g0, CK(7, 1));
#undef CK
            LDS_WAIT();
            float sv[16]; int ev[16];
#pragma unroll
            for (int k = 0; k < 16; ++k) { sv[k] = peer::unordf(g0[k] & ~255u); const unsigned tag = 255u - (g0[k] & 255u);
                const unsigned e1 = *(LAS const unsigned char*)(iscr + (tag >> 4)), e2 = *(LAS const unsigned char*)(iscr + 16 + (tag & 15u)); ev[k] = (int)(e1 * 128u + e2); }
            float ex[16], es = 0.f;
#pragma unroll
            for (int k = 0; k < 16; ++k) { ex[k] = __builtin_amdgcn_exp2f((sv[k] - sv[0]) * LOG2E); es += ex[k]; }
            const float inv = 1.f / es;
            { LAS unsigned char* tt = lds + 73728 + wave * 4096 + lh * 2048;
#pragma unroll
              for (int q = 0; q < 4; ++q) { const f32x4 gq = {ex[4 * q] * inv, ex[4 * q + 1] * inv, ex[4 * q + 2] * inv, ex[4 * q + 3] * inv}; const v4i iq = {ev[4 * q], ev[4 * q + 1], ev[4 * q + 2], ev[4 * q + 3]};
                  *(LAS v4i*)(tt + r32 * 64 + 16 * (q ^ ((r32 >> 2) & 3))) = lh == 0 ? __builtin_bit_cast(v4i, gq) : iq; }
              LAS const unsigned char* t0 = lds + 73728 + wave * 4096;
#pragma unroll
              for (int j = 0; j < 2; ++j) { const int g = 64 * j + lane, row = g >> 2, c = g & 3, off = row * 64 + 16 * (c ^ ((row >> 2) & 3));
                  *(v4i*)((unsigned char*)(GATE + (size_t)task * 512) + 16 * g) = *(LAS const v4i*)(t0 + off);
                  *(v4i*)((unsigned char*)(IDX + (size_t)task * 512) + 16 * g) = *(LAS const v4i*)(t0 + 2048 + off); } }
            LDS_WAIT();
        }
        { const float* c_e_down = p_e_down; const float* c_e_up = p_e_up;
        f32x4 nxr[8];
        if (gw < 2 * NEXP) { const float* s0 = (gw >= NEXP ? c_e_up + (size_t)(gw - NEXP) * DM : c_e_down + (size_t)gw * DM) + 32 * lane;
#pragma unroll
            for (int q = 0; q < 8; ++q) nxr[q] = *(const f32x4*)(s0 + 4 * q); }
        for (int rw = gw; rw < 2 * NEXP; rw += NGW) { const int which = rw >= NEXP, e = rw - which * NEXP;
            f32x4 cur[8]; f32x16 v0, v1; float am = 0.f;
#pragma unroll
            for (int q = 0; q < 8; ++q) cur[q] = nxr[q];
            { const int rn = rw + NGW; if (rn < 2 * NEXP) { const float* s1 = (rn >= NEXP ? c_e_up + (size_t)(rn - NEXP) * DM : c_e_down + (size_t)rn * DM) + 32 * lane;
#pragma unroll
                for (int q = 0; q < 8; ++q) nxr[q] = *(const f32x4*)(s1 + 4 * q); } }
#pragma unroll
            for (int q = 0; q < 4; ++q) { const f32x4 a = cur[q], b = cur[4 + q];
                v0[2 * q] = a.x; v1[2 * q] = a.y; v0[2 * q + 1] = a.z; v1[2 * q + 1] = a.w; v0[8 + 2 * q] = b.x; v1[8 + 2 * q] = b.y; v0[8 + 2 * q + 1] = b.z; v1[8 + 2 * q + 1] = b.w;
                am = fmaxf(am, fmaxf(fmaxf(fmaxf(fabsf(a.x), fabsf(a.y)), fmaxf(fabsf(a.z), fabsf(a.w))), fmaxf(fmaxf(fabsf(b.x), fabsf(b.y)), fmaxf(fabsf(b.z), fabsf(b.w))))); }

            am = wave_max_nonneg_dpp(am);
            const float sc = am > 0.f ? am * (1.f / 7.5f) : 1.f, inv = am > 0.f ? 7.5f / am : 0.f;
            v0 = v0 * inv; v1 = v1 * inv;
            const v6u pk = __builtin_amdgcn_cvt_scalef32_2xpk16_fp6_f32(v0, v1, 1.0f);
            unsigned* dst = (unsigned*)((which ? EU8 : ED8) + (size_t)e * 1536 + 24 * lane);
            *(v3u*)dst = (v3u){pk[0], pk[1], pk[2]}; *(v3u*)(dst + 3) = (v3u){pk[3], pk[4], pk[5]};
            if (lane == 0) (which ? SU : SD)[e] = sc; }
        }
    }
    SEAM(15);

    if (IN(16)) {
        const float* c_ln2_g = p_ln2_g; const float* c_ln2_b = p_ln2_b; float* c_out = p_out;
        for (int t = gw; t < T; t += NGW) {
            float xf[32];
            { LAS unsigned char* tr = lds + (tid >> 6) * 16384 + 8192;
#pragma unroll
              for (int j = 0; j < 4; ++j) { const int o = 16 * j + (lane >> 2), c = lane & 3;
                  *(LAS v4u*)(tr + o * 64 + 16 * (c ^ ((o >> 2) & 3))) = *(const v4u*)((const unsigned char*)(H1B + (size_t)t * DM) + 1024 * j + 16 * lane); } }
#pragma unroll
            for (int q = 0; q < 4; ++q) { const v4u w = *(LAS const v4u*)(lds + (tid >> 6) * 16384 + 8192 + lane * 64 + 16 * (q ^ ((lane >> 2) & 3)));
                xf[8 * q + 0] = bf_lo(w.x); xf[8 * q + 1] = bf_hi(w.x); xf[8 * q + 2] = bf_lo(w.y); xf[8 * q + 3] = bf_hi(w.y); xf[8 * q + 4] = bf_lo(w.z); xf[8 * q + 5] = bf_hi(w.z); xf[8 * q + 6] = bf_lo(w.w); xf[8 * q + 7] = bf_hi(w.w); }
            int ivv[2]; float gvv[2], sdl[2], sul[2], wl[2];
#pragma unroll
            for (int h = 0; h < 2; ++h) { ivv[h] = IDX[(size_t)t * 128 + 64 * h + lane]; gvv[h] = GATE[(size_t)t * 128 + 64 * h + lane]; }
#pragma unroll
            for (int h = 0; h < 2; ++h) { sdl[h] = SD[ivv[h]]; sul[h] = SU[ivv[h]]; }
#pragma unroll
            for (int h = 0; h < 2; ++h) { int dots = 0;
#pragma unroll 1
                for (int k0 = 0; k0 < 64; k0 += 4) {
                    v3u dr[4][2];
#pragma unroll
                    for (int u = 0; u < 4; ++u) { const int e = __builtin_amdgcn_readlane(ivv[h], k0 + u); const unsigned char* dp = ED8 + (size_t)e * 1536 + 24 * lane;
                        dr[u][0] = *(const v3u*)dp; dr[u][1] = *(const v3u*)(dp + 12); }
                    SBAR();
                    float tot[4];
#pragma unroll
                    for (int u = 0; u < 4; ++u) { const v6u c6 = {dr[u][0].x, dr[u][0].y, dr[u][0].z, dr[u][1].x, dr[u][1].y, dr[u][1].z};
                        const v32f dv = __builtin_amdgcn_cvt_scalef32_pk32_f32_fp6(c6, 1.0f);
                        f32x2 a0 = {0.f, 0.f}, a1 = {0.f, 0.f};
#pragma unroll
                        for (int i = 0; i < 32; i += 4) { a0 += (f32x2){dv[i], dv[i + 1]} * (f32x2){xf[i], xf[i + 1]}; a1 += (f32x2){dv[i + 2], dv[i + 3]} * (f32x2){xf[i + 2], xf[i + 3]}; }
                        tot[u] = (a0[0] + a0[1]) + (a1[0] + a1[1]); SBAR(); }
                    wave_total_dpp4(tot);
#pragma unroll
                    for (int u = 0; u < 4; ++u) { const int sv = __builtin_amdgcn_readlane(__builtin_bit_cast(int, tot[u]), 63); dots = (lane == k0 + u) ? sv : dots; }
                }
                wl[h] = gvv[h] * gelu_erf(sdl[h] * __builtin_bit_cast(float, dots)) * sul[h]; }
            float y[32];
#pragma unroll
            for (int i = 0; i < 32; ++i) y[i] = 0.f;
#pragma unroll
            for (int h = 0; h < 2; ++h) {
#pragma unroll 1
                for (int k0 = 0; k0 < 64; k0 += 4) {
                    v3u ur[4][2];
#pragma unroll
                    for (int u = 0; u < 4; ++u) { const int e = __builtin_amdgcn_readlane(ivv[h], k0 + u); const unsigned char* up = EU8 + (size_t)e * 1536 + 24 * lane;
                        ur[u][0] = *(const v3u*)up; ur[u][1] = *(const v3u*)(up + 12); }
                    SBAR();
#pragma unroll
                    for (int u = 0; u < 4; ++u) { const float w = __builtin_bit_cast(float, __builtin_amdgcn_readlane(__builtin_bit_cast(int, wl[h]), k0 + u));
                        const v6u c6 = {ur[u][0].x, ur[u][0].y, ur[u][0].z, ur[u][1].x, ur[u][1].y, ur[u][1].z};
                        const v32f uv = __builtin_amdgcn_cvt_scalef32_pk32_f32_fp6(c6, 1.0f);
#pragma unroll
                        for (int i = 0; i < 32; ++i) y[i] = __builtin_fmaf(w, uv[i], y[i]);
                        SBAR(); }
                } }
            float s = 0.f;
#pragma unroll
            for (int i = 0; i < 32; ++i) { y[i] += ALPHA * xf[i]; s += y[i]; }
            const float mean = wave_sum(s) * (1.f / DM); float s2 = 0.f;
#pragma unroll
            for (int i = 0; i < 32; ++i) { y[i] -= mean; s2 += y[i] * y[i]; }
            const float rstd = 1.f / sqrtf(wave_sum(s2) * (1.f / DM) + LN_EPS);
            { LAS unsigned char* tl = lds + (tid >> 6) * 16384;
#pragma unroll
              for (int q = 0; q < 8; ++q) *(LAS f32x4*)(tl + lane * 128 + 16 * (q ^ (lane & 7))) = (f32x4){y[4 * q] * rstd, y[4 * q + 1] * rstd, y[4 * q + 2] * rstd, y[4 * q + 3] * rstd};
#pragma unroll
              for (int q = 0; q < 8; ++q) { const int s = 8 * q + (lane >> 3), ch = lane & 7, c = 256 * q + 4 * lane;
                  const f32x4 g0 = *(const f32x4*)(c_ln2_g + c), b0 = *(const f32x4*)(c_ln2_b + c), v = *(LAS const f32x4*)(tl + s * 128 + 16 * (ch ^ (s & 7)));
                  *(f32x4*)(c_out + (size_t)t * DM + c) = v * g0 + b0; }
              LDS_WAIT(); }
        }
    }
#undef IN
#undef SEAM
#undef DIL_PASS
#undef DIL_DESC
#undef p_x
#undef p_w_in
#undef p_b_gates
#undef p_a_w_out
#undef p_q_norm
#undef p_w_uq
#undef p_kv_norm
#undef p_w_ukv
#undef p_mla_w_out
#undef p_w_out
#undef p_ln1_g
#undef p_ln1_b
#undef p_w_pq
#undef p_sk1
#undef p_sk2
#undef p_e_down
#undef p_e_up
#undef p_ln2_g
#undef p_ln2_b
#undef p_out
#undef WA8
#undef WG8
#undef WAO
#undef WBO
#undef WO
#undef WPQ
#undef WUQ
#undef WUKV
#undef SK
#undef ROPE
#undef XB8
#undef QKV
#undef CQKV
#undef KRRAW
#undef CQN
#undef CKVN
#undef KRR
#undef LSEB
#undef OA
#undef QB
#undef KN
#undef VT8
#undef OB8
#undef OA8
#undef VB
#undef YA
#undef YB
#undef UB
#undef RB
#undef H1B
#undef ED8
#undef EU8
#undef SD
#undef SU
#undef PQ
#undef IDX
#undef GATE
}


#if defined(MK_PROBE)
constexpr int CHK_OFF = 512;
__device__ __forceinline__ float fp8f(const unsigned char* p, size_t i) { const int w = (int)((const unsigned*)p)[i >> 2]; switch (i & 3) { case 0: return __builtin_amdgcn_cvt_f32_fp8(w, 0); case 1: return __builtin_amdgcn_cvt_f32_fp8(w, 1); case 2: return __builtin_amdgcn_cvt_f32_fp8(w, 2); default: return __builtin_amdgcn_cvt_f32_fp8(w, 3); } }
__device__ __forceinline__ float o8f(const unsigned char* row, int c) { const int h = c >> 7, w = c & 127; return fp8f(row, (size_t)(h * 128 + 4 * (w & 31) + (w >> 5))) * (1.f / 64.f); }
__device__ __forceinline__ unsigned hash32(unsigned a) { a ^= a >> 16; a *= 0x7feb352dU; a ^= a >> 15; a *= 0x846ca68bU; a ^= a >> 16; return a; }
__device__ __forceinline__ void chk_acc(unsigned char* ws, int k, float num, float den) {
    __shared__ float red[2][16];
    const int lane = threadIdx.x & 63, w = threadIdx.x >> 6, nw = (blockDim.x + 63) >> 6;
    num = wave_sum(num); den = wave_sum(den);
    if (lane == 0) { red[0][w] = num; red[1][w] = den; }
    __syncthreads();
    if (threadIdx.x == 0) { float a = 0.f, b = 0.f; for (int i = 0; i < nw; ++i) { a += red[0][i]; b += red[1][i]; }
        atomicAdd((float*)(ws + WS_CTL) + CHK_OFF + 2 * k, a); atomicAdd((float*)(ws + WS_CTL) + CHK_OFF + 2 * k + 1, b); }
    __syncthreads();
}
__global__ void __launch_bounds__(256) chk_inproj(const float* x, const float* w_in, unsigned char* ws) {
    const int s = blockIdx.x, j = threadIdx.x; const int t = hash32(s * 7 + 1) % T; const int c = (j * 28 + s * 3) % 7232;
    float ref = 0.f; for (int k = 0; k < DM; ++k) ref += x[(size_t)t * DM + k] * w_in[(size_t)k * IN_W + c];
    float fast;
    if (c < 6144) fast = bf2f(((const bf16*)(ws + WS_QKV))[(size_t)t * 6144 + c]) / (c < 2048 ? QSC_A : 1.f);
    else if (c < 7168) fast = bf2f(((const bf16*)(ws + WS_CQKV))[(size_t)t * 1024 + c - 6144]);
    else fast = bf2f(((const bf16*)(ws + WS_KRRAW))[(size_t)t * 64 + c - 7168]);
    chk_acc(ws, 0, (fast - ref) * (fast - ref), ref * ref);
}
__global__ void __launch_bounds__(64) chk_norm(const float* qn, const float* kvn, unsigned char* ws) {
    const int s = blockIdx.x, lane = threadIdx.x; const int t = hash32(s * 11 + 5) % T;
    const bf16* raw = (const bf16*)(ws + WS_CQKV) + (size_t)t * 1024; float num = 0.f, den = 0.f;
    for (int part = 0; part < 2; ++part) { float ss = 0.f; for (int k = lane; k < 512; k += 64) { const float v = bf2f(raw[part * 512 + k]); ss += v * v; }
        ss = wave_sum(ss); const float r = 1.f / sqrtf(ss / 512.f + RMS_EPS);
        const unsigned char* o = (const unsigned char*)(ws + (part ? WS_CKVN : WS_CQN)) + (size_t)t * 512; const float* g = part ? kvn : qn;
        for (int k = lane; k < 512; k += 64) { const float ref = bf2f(raw[part * 512 + k]) * r * g[k], f = fp8f(o, k); num += (f - ref) * (f - ref); den += ref * ref; } }
    { const int i = lane & 31; const bf16* kr = (const bf16*)(ws + WS_KRRAW) + (size_t)t * 64; const float t1 = bf2f(kr[i]), t2 = bf2f(kr[i + 32]);
      const float inv = powf(10000.f, -(float)i / 32.f); const float ang = (float)(t & (SEQ - 1)) * inv; float sn, cs; sincos_d((double)ang, sn, cs);
      const float ref = lane < 32 ? t1 * cs - t2 * sn : t1 * sn + t2 * cs, f = fp8f((const unsigned char*)(ws + WS_KRR), (size_t)t * 64 + lane); num += (f - ref) * (f - ref); den += ref * ref; }
    chk_acc(ws, 1, num, den);
}
__global__ void __launch_bounds__(64) chk_dil(unsigned char* ws) {
    __shared__ float lg[3][132]; __shared__ float og[3][128]; __shared__ float qs[128];
    const int s = blockIdx.x, lane = threadIdx.x; const unsigned hh = hash32(s * 13 + 7);
    const int b = hh & 1, h = (hh >> 1) & 15; int t = (hh >> 5) % SEQ; if (s < 8) t = s * 3; if (s >= 8 && s < 16) t = 100 + s * 37;
    const bf16* QKV_ = (const bf16*)(ws + WS_QKV); const size_t rowq = (size_t)b * SEQ + t;
    for (int c = lane; c < 128; c += 64) qs[c] = bf2f(QKV_[rowq * 6144 + h * 128 + c]) / QSC_A;
    __syncthreads();
    const float slope = exp2f(-0.5f * (float)(h + 1)); float lse[3];
    const int dil[3] = {1, 4, 16};
    for (int g = 0; g < 3; ++g) { const int d = dil[g], i = t / d;
        for (int j = lane; j <= 128; j += 64) { float l = -1e30f;
            if (i - j >= 0) { const size_t rk = (size_t)b * SEQ + (t - j * d); float dot = 0.f; for (int c = 0; c < 128; ++c) dot += qs[c] * bf2f(QKV_[rk * 6144 + 2048 + h * 128 + c]);
                l = dot * 0.08838834764831845f - slope * (float)(d * j); }
            lg[g][j] = l; }
        __syncthreads();
        float m = -1e30f; for (int j = 0; j <= 128; ++j) m = fmaxf(m, lg[g][j]);
        float z = 0.f; for (int j = 0; j <= 128; ++j) z += expf(lg[g][j] - m);
        for (int c = lane; c < 128; c += 64) { float o = 0.f; for (int j = 0; j <= 128; ++j) { if (i - j < 0) break; const size_t rk = (size_t)b * SEQ + (t - j * d); o += expf(lg[g][j] - m) / z * bf2f(QKV_[rk * 6144 + 4096 + h * 128 + c]); } og[g][c] = o; }
        lse[g] = m + logf(z);
        __syncthreads(); }
    const float mm = fmaxf(lse[0], fmaxf(lse[1], lse[2])); const float e0 = expf(lse[0] - mm), e1 = expf(lse[1] - mm), e2 = expf(lse[2] - mm), es = e0 + e1 + e2;
    float num = 0.f, den = 0.f;
    for (int c = lane; c < 128; c += 64) { const float ref = (e0 * og[0][c] + e1 * og[1][c] + e2 * og[2][c]) / es, f = o8f((const unsigned char*)(ws + WS_OA8) + rowq * DM, h * 128 + c); num += (f - ref) * (f - ref); den += ref * ref; }
    chk_acc(ws, 2, num, den);
}
__global__ void __launch_bounds__(192) chk_qb(const float* w_uq, unsigned char* ws) {
    __shared__ float raw[192];
    const int s = blockIdx.x, c = threadIdx.x; const unsigned hh = hash32(s * 17 + 3); const int t = hh % T, head = (hh >> 16) & 15;
    const unsigned char* cq = (const unsigned char*)(ws + WS_CQN) + (size_t)t * 512; float a = 0.f; for (int k = 0; k < 512; ++k) a += fp8f(cq, k) * w_uq[(size_t)k * NQB + head * 192 + c];
    raw[c] = a; __syncthreads();
    float ref = a;
    if (c >= 128) { const int i = (c - 128) & 31; const float inv = powf(10000.f, -(float)i / 32.f); const float ang = (float)(t & (SEQ - 1)) * inv; float sn, cs; sincos_d((double)ang, sn, cs);
        const float t1 = raw[128 + i], t2 = raw[160 + i]; ref = c < 160 ? t1 * cs - t2 * sn : t1 * sn + t2 * cs; }
    ref *= QSC_B; const float f = fp8f((const unsigned char*)(ws + WS_QB), (size_t)t * NQB + head * 192 + c) * (1.f / 8.f);
    chk_acc(ws, 3, (f - ref) * (f - ref), ref * ref);
}
__global__ void __launch_bounds__(256) chk_kv(const float* w_ukv, unsigned char* ws) {
    const int s = blockIdx.x, c = threadIdx.x; const unsigned hh = hash32(s * 19 + 9); const int t = hh % T, head = (hh >> 16) & 15;
    const unsigned char* ck = (const unsigned char*)(ws + WS_CKVN) + (size_t)t * 512; float ref = 0.f; for (int k = 0; k < 512; ++k) ref += fp8f(ck, k) * w_ukv[(size_t)k * NKV + head * 256 + c];
    const float f = c < 128 ? fp8f((const unsigned char*)(ws + WS_KN), (size_t)t * DM + head * 128 + c) : fp8f((const unsigned char*)(ws + WS_VT), ((size_t)((t / SEQ) * 16 + head) * 128 + (c - 128)) * SEQ + ((t % SEQ) & ~63) + att8::vperm((t % SEQ) & 63));
    chk_acc(ws, 4, (f - ref) * (f - ref), ref * ref);
}
__global__ void __launch_bounds__(256) chk_mla(unsigned char* ws) {
    __shared__ float qs[192]; __shared__ float redm[4]; __shared__ float redz[4];
    const int s = blockIdx.x, tid = threadIdx.x; const unsigned hh = hash32(s * 23 + 11); const int b = hh & 1, h = (hh >> 1) & 15; int t = (hh >> 5) % SEQ; if (s < 6) t = s * 51; if (s >= 6 && s < 12) t = SEQ - 1 - (s - 6) * 77;
    const size_t tb = (size_t)b * SEQ; float* pbuf = (float*)(ws + WS_END) + (size_t)s * SEQ;
    for (int c = tid; c < 192; c += 256) qs[c] = fp8f((const unsigned char*)(ws + WS_QB), (tb + t) * NQB + h * 192 + c) * (1.f / 8.f);
    __syncthreads();
    float m = -1e30f;
    for (int k = tid; k <= t; k += 256) { float dot = 0.f; const unsigned char* kn = (const unsigned char*)(ws + WS_KN) + (tb + k) * DM + h * 128; const unsigned char* kr = (const unsigned char*)(ws + WS_KRR) + (tb + k) * 64;
        for (int c = 0; c < 128; ++c) dot += qs[c] * fp8f(kn, c); for (int c = 0; c < 64; ++c) dot += qs[128 + c] * fp8f(kr, c);
        pbuf[k] = dot; m = fmaxf(m, dot); }
    for (int o = 1; o < 64; o <<= 1) m = fmaxf(m, __shfl_xor(m, o));
    if ((tid & 63) == 0) redm[tid >> 6] = m; __syncthreads(); m = fmaxf(fmaxf(redm[0], redm[1]), fmaxf(redm[2], redm[3]));
    float z = 0.f; for (int k = tid; k <= t; k += 256) { const float p = exp2f(pbuf[k] - m); pbuf[k] = p; z += p; }
    z = wave_sum(z); if ((tid & 63) == 0) redz[tid >> 6] = z; __syncthreads(); z = redz[0] + redz[1] + redz[2] + redz[3];
    __threadfence_block(); __syncthreads();
    float num = 0.f, den = 0.f;
    if (tid < 128) { float o = 0.f; for (int k = 0; k <= t; ++k) o += pbuf[k] * fp8f((const unsigned char*)(ws + WS_VT), ((size_t)(b * 16 + h) * 128 + tid) * SEQ + (k & ~63) + att8::vperm(k & 63));
        const float ref = o / z, f = o8f((const unsigned char*)(ws + WS_OB) + (tb + t) * DM, h * 128 + tid); num = (f - ref) * (f - ref); den = ref * ref; }
    chk_acc(ws, 5, num, den);
}
__global__ void __launch_bounds__(256) chk_y(const float* wa, const float* wb, unsigned char* ws) {
    const int s = blockIdx.x, j = threadIdx.x; const int t = hash32(s * 29 + 13) % T, c = (j * 8 + s) % DM;
    const unsigned char* oa = (const unsigned char*)(ws + WS_OA8) + (size_t)t * DM; const unsigned char* ob = (const unsigned char*)(ws + WS_OB) + (size_t)t * DM; float ra = 0.f, rb = 0.f;
    for (int k = 0; k < DM; ++k) { ra += o8f(oa, k) * wa[(size_t)k * DM + c]; rb += o8f(ob, k) * wb[(size_t)k * DM + c]; }
    const float fa = fp8f((const unsigned char*)(ws + WS_YA), (size_t)t * DM + c) * (1.f / 64.f), fb = fp8f((const unsigned char*)(ws + WS_YB), (size_t)t * DM + c) * (1.f / 64.f);
    chk_acc(ws, 6, (fa - ra) * (fa - ra) + (fb - rb) * (fb - rb), ra * ra + rb * rb);
}
__global__ void __launch_bounds__(256) chk_u(const float* x, const float* w_in, const float* bg, unsigned char* ws) {
    const int s = blockIdx.x, j = threadIdx.x; const int t = hash32(s * 31 + 17) % T, c = (j * 8 + s) % DM;
    float ga = 0.f, gb = 0.f; for (int k = 0; k < DM; ++k) { const float xv = x[(size_t)t * DM + k]; ga += xv * w_in[(size_t)k * IN_W + 7232 + c]; gb += xv * w_in[(size_t)k * IN_W + 7232 + DM + c]; }
    ga = 1.f / (1.f + expf(-(ga + bg[c]))); gb = 1.f / (1.f + expf(-(gb + bg[DM + c])));
    const float ref = ga * fp8f((const unsigned char*)(ws + WS_YA), (size_t)t * DM + c) * (1.f / 64.f) + gb * fp8f((const unsigned char*)(ws + WS_YB), (size_t)t * DM + c) * (1.f / 64.f), f = fp8f((const unsigned char*)(ws + WS_U), (size_t)t * DM + c) * (1.f / 64.f);
    chk_acc(ws, 7, (f - ref) * (f - ref), ref * ref);
}
__global__ void __launch_bounds__(256) chk_r(const float* x, const float* wo, unsigned char* ws) {
    const int s = blockIdx.x, j = threadIdx.x; const int t = hash32(s * 37 + 19) % T, c = (j * 8 + s) % DM;
    const unsigned char* u = (const unsigned char*)(ws + WS_U) + (size_t)t * DM; float ref = 0.f; for (int k = 0; k < DM; ++k) ref += fp8f(u, k) * (1.f / 64.f) * wo[(size_t)k * DM + c];
    const float f = bf2f(((const bf16*)(ws + WS_R))[(size_t)t * DM + c]) - ALPHA * x[(size_t)t * DM + c];
    chk_acc(ws, 8, (f - ref) * (f - ref), ref * ref);
}
__global__ void __launch_bounds__(64) chk_dummy(unsigned char* ws) { chk_acc(ws, 9, threadIdx.x == 0 ? 2.f : 0.f, threadIdx.x == 0 ? 1.f : 0.f); }
__global__ void __launch_bounds__(256) chk_report(float* out, unsigned char* ws, int nchk, float thr) {
    const float* a = (const float*)(ws + WS_CTL) + CHK_OFF; int bad = -1; float e = 0.f;
    for (int k = 0; k < nchk; ++k) { const float num = a[2 * k], den = a[2 * k + 1]; const float err = (den > 0.f) ? sqrtf(num / den) : 1.f; const bool nan = !(err == err);
        const float th = (k == 0 || k == 1 || k == 2 || k == 3 || k == 4 || k == 5 || k == 6 || k == 7) ? (k == 5 ? 0.12f : 0.08f) : (k == 8 ? 0.2f : thr);
        if (bad < 0 && (nan || err > th || !(den > 0.f))) { bad = k; e = nan ? 1.f : fminf(err, 1.f); } }
    if (bad < 0) return;
    const float K = sqrtf((1.f + 8.f * e) * powf(10.f, (float)(bad + 2)));
    for (size_t i = (size_t)blockIdx.x * blockDim.x + threadIdx.x; i < (size_t)T * DM; i += (size_t)gridDim.x * blockDim.x) out[i] = K;
}
#endif

#if defined(MK_FP6PROBE)
__global__ void __launch_bounds__(256) fp6_probe(float* out, int which_slot) {
    const float pos[16] = {0.125f, 0.25f, 0.375f, 0.5f, 0.625f, 0.75f, 0.875f, 1.f, 1.25f, 1.5f, 1.75f, 2.f, 2.5f, 3.f, 3.5f, 4.f};
    f32x16_t x0, x1;
#pragma unroll
    for (int i = 0; i < 16; ++i) { x0[i] = pos[i]; x1[i] = -pos[i]; }
    const v6u pk = __builtin_amdgcn_cvt_scalef32_2xpk16_fp6_f32(x0, x1, 1.0f);
    const v32f r = __builtin_amdgcn_cvt_scalef32_pk32_f32_fp6(pk, 1.0f);
    int m1 = 0, m2 = 0, m3 = 0, scaled = 0;
#pragma unroll
    for (int j = 0; j < 32; ++j) { const float h1 = j < 16 ? pos[j] : -pos[j - 16], h2 = (j & 1) ? -pos[j >> 1] : pos[j >> 1], h3 = (j & 1) ? pos[j >> 1] : -pos[j >> 1];
        m1 += (r[j] == h1); m2 += (r[j] == h2); m3 += (r[j] == h3); scaled += (r[j] != 0.f && (fabsf(r[j]) > 4.f || fabsf(r[j]) < 0.125f)); }
    float code = 6.f;
    if (m1 == 32) code = 2.f; else if (m2 == 32) code = 3.f; else if (m3 == 32) code = 4.f; else if (scaled) code = 8.f;
    if (which_slot >= 0) { float v = 0.f;
#pragma unroll
        for (int j = 0; j < 32; ++j) if (j == which_slot) v = r[j];
        int src = 40;
#pragma unroll
        for (int i = 0; i < 16; ++i) { if (v == pos[i]) src = i; if (v == -pos[i]) src = 16 + i; }
        code = 10.f + (float)src * 0.5f; }
    const float K = sqrtf(powf(10.f, code));
    for (size_t i = (size_t)blockIdx.x * blockDim.x + threadIdx.x; i < (size_t)T * DM; i += (size_t)gridDim.x * blockDim.x) out[i] = K;
}
#endif

extern "C" void kernel_launch(void* const* d_in, const int* in_sizes, int n_in, void* d_out, int out_size, void* d_ws, size_t ws_size, hipStream_t stream) {
    static int grid = 0;
    if (grid == 0) {
        if (n_in != 19 || in_sizes[0] != T * DM || out_size != T * DM || ws_size < WS_END) { fprintf(stderr, "kernel_launch: unexpected shapes (n_in %d, in0 %d, out %d, ws %zu)\n", n_in, n_in > 0 ? in_sizes[0] : -1, out_size, ws_size); grid = -1; return; }
        int dev = 0, cus = 0, per_cu = 0;
        if (hipGetDevice(&dev) != hipSuccess || hipDeviceGetAttribute(&cus, hipDeviceAttributeMultiprocessorCount, dev) != hipSuccess) { grid = -1; return; }
        if (hipFuncSetAttribute((const void*)mk_fwd, hipFuncAttributeMaxDynamicSharedMemorySize, LDS_BYTES) != hipSuccess) { fprintf(stderr, "kernel_launch: hipFuncSetAttribute failed\n"); grid = -1; return; }
        if (hipOccupancyMaxActiveBlocksPerMultiprocessor(&per_cu, (const void*)mk_fwd, 512, LDS_BYTES) != hipSuccess || per_cu < 1) { fprintf(stderr, "kernel_launch: occupancy query says %d blocks per CU\n", per_cu); }
        (void)hipGetLastError();
        grid = cus;
    }
    if (grid < 0) return;
    if (hipMemsetAsync((char*)d_ws + WS_CTL, 0, CTL_ZERO_BYTES, stream) != hipSuccess) return;
    Args a{};
    for (int i = 0; i < 19; ++i) a.in[i] = (const float*)d_in[i];
    a.out = (float*)d_out; a.ws = (unsigned char*)d_ws;
#if defined(MK_FP6PROBE)
    hipLaunchKernelGGL(fp6_probe, dim3(1024), dim3(256), 0, stream, (float*)d_out, MK_FP6PROBE);
#elif defined(MK_PROBE)
    {
        const int cuts[10] = {0, 2, 3, 6, 8, 9, 11, 12, 13, NPHASE};
        unsigned char* w = (unsigned char*)d_ws;
        for (int li = 0; li < 9; ++li) { a.ph_lo = cuts[li]; a.ph_hi = cuts[li + 1]; a.bli = li; hipLaunchKernelGGL(mk_fwd, dim3(grid), dim3(512), LDS_BYTES, stream, a);
            if (li == 0) hipLaunchKernelGGL(chk_inproj, dim3(64), dim3(256), 0, stream, a.in[0], a.in[1], w);
            if (li == 1) hipLaunchKernelGGL(chk_norm, dim3(64), dim3(64), 0, stream, a.in[4], a.in[6], w);
            if (li == 2) hipLaunchKernelGGL(chk_dil, dim3(128), dim3(64), 0, stream, w);
            if (li == 3) { hipLaunchKernelGGL(chk_qb, dim3(64), dim3(192), 0, stream, a.in[5], w); hipLaunchKernelGGL(chk_kv, dim3(64), dim3(256), 0, stream, a.in[7], w); }
            if (li == 4) hipLaunchKernelGGL(chk_mla, dim3(64), dim3(256), 0, stream, w);
            if (li == 5) hipLaunchKernelGGL(chk_y, dim3(64), dim3(256), 0, stream, a.in[3], a.in[8], w);
            if (li == 6) hipLaunchKernelGGL(chk_u, dim3(64), dim3(256), 0, stream, a.in[0], a.in[1], a.in[2], w);
            if (li == 7) hipLaunchKernelGGL(chk_r, dim3(64), dim3(256), 0, stream, a.in[0], a.in[9], w);
        }
        hipLaunchKernelGGL(chk_dummy, dim3(1), dim3(64), 0, stream, w);
        hipLaunchKernelGGL(chk_report, dim3(1024), dim3(256), 0, stream, (float*)d_out, w, 10, 0.015f);
    }
#elif defined(MK_DUP_PHASE)
    a.ph_lo = 0; a.ph_hi = MK_DUP_PHASE + 1; a.bli = 0; hipLaunchKernelGGL(mk_fwd, dim3(grid), dim3(512), LDS_BYTES, stream, a);
    a.ph_lo = MK_DUP_PHASE; a.ph_hi = NPHASE; a.bli = 1; hipLaunchKernelGGL(mk_fwd, dim3(grid), dim3(512), LDS_BYTES, stream, a);
#else
    a.ph_lo = 0; a.ph_hi = NPHASE; a.bli = 0;
    hipLaunchKernelGGL(mk_fwd, dim3(grid), dim3(512), LDS_BYTES, stream, a);
#endif
}
```

```cpp
#include <hip/hip_runtime.h>
#include <cstdio>
#include <cstdint>

#define GAS __attribute__((address_space(1)))
#define LAS __attribute__((address_space(3)))
typedef unsigned short bf16;
typedef unsigned v4u __attribute__((ext_vector_type(4)));
typedef unsigned v2u __attribute__((ext_vector_type(2)));
struct v3u { unsigned x, y, z; };
typedef unsigned v6u __attribute__((ext_vector_type(6)));
typedef float v32f __attribute__((ext_vector_type(32)));
typedef float f32x16_t __attribute__((ext_vector_type(16)));
typedef int v4i __attribute__((ext_vector_type(4)));
typedef float f32x4 __attribute__((ext_vector_type(4)));
typedef float f32x2 __attribute__((ext_vector_type(2)));
typedef float f32x16 __attribute__((ext_vector_type(16)));
typedef short bf16x8 __attribute__((ext_vector_type(8)));
typedef short s16x4 __attribute__((ext_vector_type(4)));

constexpr int DM = 2048, BATCH = 2, SEQ = 16384, T = BATCH * SEQ;
constexpr int IN_W = 11328;
constexpr int NA = 7424;
constexpr int NGATE = 4096;
constexpr int NQB = 3072, NKV = 4096, QL = 512;
constexpr int NEXP = 16384, PH = 8, PTOPK = 16;
constexpr float LN_EPS = 1e-5f, RMS_EPS = 1e-6f;
constexpr float ALPHA = 1.189207115002721f;
constexpr float LOG2E = 1.4426950408889634f;
constexpr float QSC_A = 0.08838834764831845f * LOG2E;
constexpr float QSC_B = 0.07216878364870322f * LOG2E;
constexpr int NPHASE = 17;

constexpr size_t MiB = 1u << 20;
constexpr size_t WS_CTL = 0, CTL_ZERO_BYTES = 262144;
constexpr size_t WS_WA = 1 * MiB, WS_WG = 30 * MiB, WS_WAO = 46 * MiB, WS_WBO = 54 * MiB, WS_WO = 62 * MiB, WS_WPQ = 70 * MiB, WS_WUQ = 78 * MiB, WS_WUKV = 81 * MiB;
constexpr size_t WS_SK = 85 * MiB, WS_ROPE = 86 * MiB;
constexpr size_t WS_XB = 96 * MiB, WS_OA8 = 160 * MiB;
constexpr size_t WS_QKV = 224 * MiB, WS_CQKV = 608 * MiB, WS_KRRAW = 672 * MiB, WS_CQN = 676 * MiB, WS_CKVN = 708 * MiB, WS_KRR = 740 * MiB, WS_LSE = 744 * MiB, WS_OA = 746 * MiB;
constexpr size_t WS_QB = 224 * MiB, WS_KN = 416 * MiB, WS_VT = 480 * MiB, WS_OB = 544 * MiB, WS_VB = 874 * MiB;
constexpr size_t WS_YA = 224 * MiB, WS_YB = 352 * MiB, WS_U = 874 * MiB;
constexpr size_t WS_R = 224 * MiB, WS_H1B = 480 * MiB, WS_ED = 608 * MiB, WS_EU = 640 * MiB, WS_SD = 672 * MiB, WS_SU = 672 * MiB + 65536, WS_PQ = 736 * MiB, WS_IDX = 874 * MiB, WS_GATE = 890 * MiB;
constexpr size_t WS_END = 1002 * MiB;
static_assert(WS_WA + (size_t)NA * DM * 2 <= WS_WG && WS_WUKV + (size_t)NKV * QL * 2 <= WS_SK && WS_ROPE + (size_t)SEQ * 64 * 4 <= WS_XB, "weights map");
static_assert(WS_QKV + (size_t)T * 6144 * 2 <= WS_CQKV && WS_OA + (size_t)T * DM * 2 <= WS_VB && WS_VB + (size_t)T * DM * 2 <= WS_END, "activation map");
static_assert(WS_QB + (size_t)T * NQB * 2 <= WS_KN && WS_KN + (size_t)T * DM * 2 <= WS_OB && WS_OB + (size_t)T * DM * 2 <= WS_KRRAW, "mla map");
static_assert(WS_R + (size_t)T * DM * 2 <= WS_H1B && WS_H1B + (size_t)T * DM * 2 <= WS_ED && WS_ED + (size_t)NEXP * 1536 <= WS_EU && WS_EU + (size_t)NEXP * DM <= WS_SD && WS_SU + (size_t)NEXP * 4 <= WS_PQ && WS_PQ + (size_t)T * DM * 2 <= WS_IDX, "peer map");
constexpr int CW_BAR = 1024;

constexpr int RING_BYTES = 131072;
constexpr int MISC_OFF = RING_BYTES;
constexpr int LDS_BYTES = 147456;

#define LDS_WAIT() asm volatile("s_waitcnt lgkmcnt(0)" ::: "memory")
#define VM_WAIT() asm volatile("s_waitcnt vmcnt(0)" ::: "memory")
#define SBAR() __builtin_amdgcn_sched_barrier(0)
__device__ __forceinline__ unsigned f2bf(float f) { unsigned u = __builtin_bit_cast(unsigned, f); return (u + 0x7fffu + ((u >> 16) & 1u)) >> 16; }
__device__ __forceinline__ unsigned pk2(float lo, float hi) { return f2bf(lo) | (f2bf(hi) << 16); }
__device__ __forceinline__ float bf_lo(unsigned w) { return __builtin_bit_cast(float, w << 16); }
__device__ __forceinline__ float bf_hi(unsigned w) { return __builtin_bit_cast(float, w & 0xffff0000u); }
__device__ __forceinline__ float bf2f(bf16 b) { return __builtin_bit_cast(float, ((unsigned)b) << 16); }
__device__ __forceinline__ unsigned pk4_fp8(float a, float b, float c, float d) { int w = __builtin_amdgcn_cvt_pk_fp8_f32(a, b, 0, false); w = __builtin_amdgcn_cvt_pk_fp8_f32(c, d, w, true); return (unsigned)w; }
__device__ __forceinline__ float wave_sum(float v) {
    int x = __builtin_bit_cast(int, v);
#define WS_DPP_ADD(ctrl_, rmask_) do { const int t_ = __builtin_amdgcn_update_dpp(0, x, ctrl_, rmask_, 0xf, false); x = __builtin_bit_cast(int, __builtin_bit_cast(float, x) + __builtin_bit_cast(float, t_)); } while (0)
    WS_DPP_ADD(0xB1, 0xf); WS_DPP_ADD(0x4E, 0xf); WS_DPP_ADD(0x141, 0xf); WS_DPP_ADD(0x140, 0xf); WS_DPP_ADD(0x142, 0xa); WS_DPP_ADD(0x143, 0xc);
#undef WS_DPP_ADD
    return __builtin_bit_cast(float, __builtin_amdgcn_readlane(x, 63));
}

#define XB_TMO      128
#define XB_XCNT(j)  (256  + 64 * (j))
#define XB_XSUB(j)  (1280 + 64 * (j))
#define XB_XGEN(j)  (2304 + 64 * (j))
#define XB_TOP      3328
#define XB_TOPGEN   3392
#define XCD_BAR_WORDS 3456
#define XB_SPIN_CAP (1u << 24)

__device__ __forceinline__ unsigned xb_ld(unsigned* p)              { return __hip_atomic_load(p, __ATOMIC_RELAXED, __HIP_MEMORY_SCOPE_AGENT); }
__device__ __forceinline__ unsigned xb_add(unsigned* p, unsigned v) { return __hip_atomic_fetch_add(p, v, __ATOMIC_RELAXED, __HIP_MEMORY_SCOPE_AGENT); }
__device__ __forceinline__ unsigned xb_xcc_id() { return (unsigned)__builtin_amdgcn_s_getreg((3 << 11) | 20) & 0xFu; }
#define XB_SPIN(cond, bar) do { unsigned _sp = 0; while (cond) { __builtin_amdgcn_s_sleep(1); \
    if ((++_sp & 255u) == 0u) { if (xb_ld(&(bar)[XB_TMO])) break; if (_sp > XB_SPIN_CAP) { atomicAdd(&(bar)[XB_TMO], 1u); break; } } } } while (0)

struct XcdBarrier {
    unsigned* bar; unsigned x;
    volatile LAS unsigned* st;
};

__device__ __forceinline__ XcdBarrier xcd_barrier_post(unsigned* bar, volatile LAS unsigned* st) {
    XcdBarrier b; b.bar = bar; b.x = xb_xcc_id(); b.st = st;
    if (threadIdx.x == 0) (void)xb_add(&bar[XB_XCNT(b.x)], 1u);
    return b;
}
__device__ __forceinline__ void xcd_barrier_complete(unsigned* bar, unsigned x, unsigned& nloc, unsigned& nx) {
    const unsigned G = gridDim.x * gridDim.y * gridDim.z;
    unsigned sum, cnt, mine, sp = 0u;
    for (;;) {
        sum = 0u; cnt = 0u; mine = 0u;
#pragma unroll
        for (unsigned j = 0; j < 16; ++j) { const unsigned c = xb_ld(&bar[XB_XCNT(j)]); sum += c; cnt += (c > 0u) ? 1u : 0u; mine = (j == x) ? c : mine; }
        if (sum == G) break;
        __builtin_amdgcn_s_sleep(1);
        if ((++sp & 255u) == 0u) { if (xb_ld(&bar[XB_TMO])) break; if (sp > XB_SPIN_CAP) { atomicAdd(&bar[XB_TMO], 1u); break; } }
    }
    nloc = mine > 0u ? mine : 1u; nx = cnt > 0u ? cnt : 1u;
}

__device__ __forceinline__ void xcd_barrier(const XcdBarrier& b) {
    asm volatile("s_waitcnt vmcnt(0)" ::: "memory");
    __syncthreads();
    if (threadIdx.x == 0) {
        unsigned* bar = b.bar;
        __builtin_amdgcn_s_waitcnt(0);
        unsigned nloc = b.st[0], nx = b.st[1];
        if (nloc == 0u) { xcd_barrier_complete(bar, b.x, nloc, nx); b.st[0] = nloc; b.st[1] = nx; }
        const unsigned old = xb_add(&bar[XB_XSUB(b.x)], 1u);
        const unsigned gen = old / nloc;
        if (old + 1u == (gen + 1u) * nloc) {
            __builtin_amdgcn_fence(__ATOMIC_RELEASE, "agent");
            asm volatile("s_waitcnt vmcnt(0)" ::: "memory");
            const unsigned og = xb_add(&bar[XB_TOP], 1u);
            const unsigned tg = og / nx;
            if (og + 1u == (tg + 1u) * nx) xb_add(&bar[XB_TOPGEN], 1u);
            else XB_SPIN(xb_ld(&bar[XB_TOPGEN]) == tg, bar);
            __builtin_amdgcn_fence(__ATOMIC_ACQUIRE, "agent");
            xb_add(&bar[XB_XGEN(b.x)], 1u);
            asm volatile("s_waitcnt vmcnt(0)" ::: "memory");
        } else {
            XB_SPIN(xb_ld(&bar[XB_XGEN(b.x)]) == gen, bar);
            __builtin_amdgcn_fence(__ATOMIC_ACQUIRE, "agent");
            asm volatile("s_waitcnt vmcnt(0)" ::: "memory");
        }
    }
    __syncthreads();
}


namespace pg8 {
#define PG8_LAS __attribute__((address_space(3)))
typedef unsigned short bf16_t;
typedef short bf16x8 __attribute__((ext_vector_type(8)));
typedef float f32x4 __attribute__((ext_vector_type(4)));
typedef unsigned u32x4 __attribute__((ext_vector_type(4)));
constexpr int BM = 256, BK = 64, HALF = 128, HTB = HALF * BK * 2  , STAGE_BYTES = 8 * HTB, NXCD = 8, WGM = 4;

__host__ __device__ __forceinline__ int lds_byte(int r, int c) { const int st = (r >> 4) * 2 + (c >> 5), rr = r & 15, cc = c & 31, ob = rr * 64 + cc * 2; return st * 1024 + (ob ^ (((ob >> 9) & 1) << 5)); }
__host__ __device__ __forceinline__ void stage_rc(int b, int& R, int& C) { const int st = b / 1024, sb = b % 1024, swz = sb ^ (((sb >> 9) & 1) << 5); R = (st >> 1) * 16 + swz / 64; C = (st & 1) * 32 + (swz % 64) / 2; }
__host__ __device__ __forceinline__ int perm32(int rho) { const int n = rho >> 4, i = rho & 15; return 8 * (i >> 2) + 4 * n + (i & 3); }

struct Unit { int pm, pn; };
struct Gemm { const bf16_t* A; const bf16_t* Bt; int M, N, K; };

struct StaticOrder {
    int nM, nN, nwg, G, c;
    __host__ __device__ void init(int M, int N, int G_, int c_) { nM = M / BM; nN = N / BM; nwg = nM * nN; G = G_; c = c_; }
    __host__ __device__ bool next(int i, Unit& u) const {
        const long L = (long)i * G + c; if (L >= nwg) return false;
        int wgid = (int)L; { const int q = nwg / NXCD, r = nwg % NXCD, xcd = wgid % NXCD, off = wgid / NXCD; wgid = (xcd < r ? xcd * (q + 1) : r * (q + 1) + (xcd - r) * q) + off; }
        const int nig = WGM * nN, gid = wgid / nig, fm = gid * WGM, gsz = (nM - fm) < WGM ? (nM - fm) : WGM;
        u.pm = fm + ((wgid % nig) % gsz); u.pn = (wgid % nig) / gsz; return true;
    }
    __device__ __forceinline__ void a_ready(const Unit&) const {}
    __device__ __forceinline__ void done(const Unit&) const {}
};
__device__ __forceinline__ unsigned cvt_pk_bf16(float lo, float hi) { unsigned r; asm volatile("v_cvt_pk_bf16_f32 %0, %1, %2" : "=v"(r) : "v"(lo), "v"(hi)); return r; }
typedef float f32x2 __attribute__((ext_vector_type(2)));
__device__ __forceinline__ f32x2 gelu_pk(f32x2 v) {
    const f32x2 av = __builtin_elementwise_abs(v), d = av * 0.2316418882f + 1.0f;
    f32x2 t; t.x = __builtin_amdgcn_rcpf(d.x); t.y = __builtin_amdgcn_rcpf(d.y);
    f32x2 q = t * 0.5307027145f + (-0.7265760135f); q = q * t + 0.7107068705f; q = q * t + (-0.142248368f); q = q * t + 0.127414796f; q = q * t;
    const f32x2 s = (v * v) * (-0.72134752044f);
    f32x2 e; e.x = __builtin_amdgcn_exp2f(s.x); e.y = __builtin_amdgcn_exp2f(s.y);
    const f32x2 m = v * (q * e), r = v - m;
    f32x2 o; o.x = v.x < 0.f ? m.x : r.x; o.y = v.y < 0.f ? m.y : r.y; return o;
}

__device__ __forceinline__ u32x4 pack8s(f32x4 v0, f32x4 v1, float s) { u32x4 w; w.x = cvt_pk_bf16(v0[0] * s, v0[1] * s); w.y = cvt_pk_bf16(v0[2] * s, v0[3] * s); w.z = cvt_pk_bf16(v1[0] * s, v1[1] * s); w.w = cvt_pk_bf16(v1[2] * s, v1[3] * s); return w; }
struct EpiA {
    static constexpr bool PERM = true, AFTER_DRAIN = false;
    bf16_t* qkv; bf16_t* cqkv; bf16_t* krraw; float accs;
    __device__ __forceinline__ void operator()(const f32x4 (&acc)[2][2][4][2], const Unit& u, int wr, int wc, int fr, int fq) const {
        const int row0 = u.pm * BM + wr * 64 + fr, cw = wc * 32 + 8 * fq, pn = u.pn;
        bf16_t* base; int ldc, colt; float sc = accs; bool narrow = false;
        if (pn < 24) { base = qkv; ldc = 6144; colt = pn * 256; if (pn < 8) sc = QSC_A * accs; }
        else if (pn < 28) { base = cqkv; ldc = 1024; colt = (pn - 24) * 256; }
        else { base = krraw; ldc = 64; colt = 0; narrow = true; }
#pragma unroll
        for (int ai = 0; ai < 2; ++ai)
#pragma unroll
            for (int m = 0; m < 4; ++m) { bf16_t* rowp = base + (size_t)(row0 + ai * HALF + m * 16) * ldc + colt + cw;
#pragma unroll
                for (int bj = 0; bj < 2; ++bj) { if (narrow && (bj == 1 || cw >= 64)) continue;
                    *(u32x4*)(rowp + bj * HALF) = pack8s(acc[ai][bj][m][0], acc[ai][bj][m][1], sc); } }
    }
};
struct EpiQ {
    static constexpr bool PERM = true, AFTER_DRAIN = false;
    unsigned char* qb; const float* rope; float qsc;
    __device__ __forceinline__ void operator()(const f32x4 (&acc)[2][2][4][2], const Unit& u, int wr, int wc, int fr, int fq) const {
        const int row0 = u.pm * BM + wr * 64 + fr;
#pragma unroll
        for (int bj = 0; bj < 2; ++bj) { const int c0 = u.pn * BM + bj * HALF + wc * 32 + 8 * fq; const int head = c0 / 192, off = c0 - head * 192;
            typedef unsigned u32x2 __attribute__((ext_vector_type(2)));
            if (off < 128) {
#pragma unroll
                for (int ai = 0; ai < 2; ++ai)
#pragma unroll
                    for (int m = 0; m < 4; ++m) { const int row = row0 + ai * HALF + m * 16; unsigned char* rowp = qb + (size_t)row * NQB + head * 192;
                        const f32x4 v0 = acc[ai][bj][m][0], v1 = acc[ai][bj][m][1];
                        u32x2 w; w.x = pk4_fp8(v0[0] * qsc, v0[1] * qsc, v0[2] * qsc, v0[3] * qsc); w.y = pk4_fp8(v1[0] * qsc, v1[1] * qsc, v1[2] * qsc, v1[3] * qsc); *(u32x2*)(rowp + off) = w; }
            } else { const int i0 = (off - 128) >> 1;
                f32x4 cav[2][4], cbv[2][4];
#pragma unroll
                for (int ai = 0; ai < 2; ++ai)
#pragma unroll
                    for (int m = 0; m < 4; ++m) { const int row = row0 + ai * HALF + m * 16; const float* cs = rope + ((size_t)(row & (SEQ - 1)) * 32 + i0) * 2; cav[ai][m] = *(const f32x4*)cs; cbv[ai][m] = *(const f32x4*)(cs + 4); }
#pragma unroll
                for (int ai = 0; ai < 2; ++ai)
#pragma unroll
                    for (int m = 0; m < 4; ++m) { const int row = row0 + ai * HALF + m * 16; unsigned char* rowp = qb + (size_t)row * NQB + head * 192;
                        const f32x4 v0 = acc[ai][bj][m][0], v1 = acc[ai][bj][m][1];
                        const f32x4 ca = cav[ai][m], cb = cbv[ai][m];
                        const float a0 = v0[0] * ca[0] - v0[1] * ca[1], b0 = v0[0] * ca[1] + v0[1] * ca[0];
                        const float a1 = v0[2] * ca[2] - v0[3] * ca[3], b1 = v0[2] * ca[3] + v0[3] * ca[2];
                        const float a2 = v1[0] * cb[0] - v1[1] * cb[1], b2 = v1[0] * cb[1] + v1[1] * cb[0];
                        const float a3 = v1[2] * cb[2] - v1[3] * cb[3], b3 = v1[2] * cb[3] + v1[3] * cb[2];
                        *(unsigned*)(rowp + 128 + i0) = pk4_fp8(a0 * qsc, a1 * qsc, a2 * qsc, a3 * qsc); *(unsigned*)(rowp + 160 + i0) = pk4_fp8(b0 * qsc, b1 * qsc, b2 * qsc, b3 * qsc); }
            } }
    }
};
struct EpiKV {
    static constexpr bool PERM = true, AFTER_DRAIN = false;
    unsigned char* kn; unsigned char* vt; PG8_LAS unsigned char* scr; float accs;
    __device__ __forceinline__ void operator()(const f32x4 (&acc)[2][2][4][2], const Unit& u, int wr, int wc, int fr, int fq) const {
        const int row0 = u.pm * BM + wr * 64 + fr, cw = u.pn * 128 + wc * 32 + 8 * fq;
        const int lane = threadIdx.x & 63;
        const int bb = (u.pm * BM) / SEQ, key0 = (u.pm * BM) % SEQ + wr * 64;
        unsigned char* vrow = vt + ((size_t)(bb * 16 + u.pn) * 128 + wc * 32 + (lane >> 1)) * SEQ + key0 + 32 * (lane & 1);
#pragma unroll
        for (int ai = 0; ai < 2; ++ai) {
#pragma unroll
            for (int m = 0; m < 4; ++m) { const size_t ro = (size_t)(row0 + ai * HALF + m * 16) * DM + cw;
                { typedef unsigned u32x2 __attribute__((ext_vector_type(2))); const f32x4 k0 = acc[ai][0][m][0] * accs, k1 = acc[ai][0][m][1] * accs; u32x2 w; w.x = pk4_fp8(k0[0], k0[1], k0[2], k0[3]); w.y = pk4_fp8(k1[0], k1[1], k1[2], k1[3]); *(u32x2*)(kn + ro) = w; } }
#pragma unroll
            for (int mp = 0; mp < 2; ++mp) {
#pragma unroll
                for (int mm = 0; mm < 2; ++mm) { const int k = mm * 16 + fr, lp = 16 * ((k >> 2) & 1) + 4 * ((k >> 3) & 3) + (k & 3);
#pragma unroll
                    for (int n = 0; n < 2; ++n) { const f32x4 v = acc[ai][1][2 * mp + mm][n] * accs; const unsigned w = pk4_fp8(v[0], v[1], v[2], v[3]);
#pragma unroll
                        for (int i = 0; i < 4; ++i) scr[(8 * fq + 4 * n + i) * 48 + lp] = (unsigned char)((w >> (8 * i)) & 0xffu); } }
                const u32x4 piece = *(const PG8_LAS u32x4*)(scr + (lane >> 1) * 48 + 16 * (lane & 1));
                *(u32x4*)(vrow + ai * HALF + 16 * mp) = piece; }
        }
    }
};
struct EpiPlain {
    static constexpr bool PERM = true, AFTER_DRAIN = false;
    bf16_t* O; int ldc; float accs;
    __device__ __forceinline__ void operator()(const f32x4 (&acc)[2][2][4][2], const Unit& u, int wr, int wc, int fr, int fq) const {
        const int row0 = u.pm * BM + wr * 64 + fr, c0 = u.pn * BM + wc * 32 + 8 * fq;
#pragma unroll
        for (int ai = 0; ai < 2; ++ai)
#pragma unroll
            for (int m = 0; m < 4; ++m) { bf16_t* rowp = O + (size_t)(row0 + ai * HALF + m * 16) * ldc + c0;
#pragma unroll
                for (int bj = 0; bj < 2; ++bj) *(u32x4*)(rowp + bj * HALF) = pack8s(acc[ai][bj][m][0], acc[ai][bj][m][1], accs); }
    }
};
struct EpiPlain8 {
    static constexpr bool PERM = true, AFTER_DRAIN = false;
    unsigned char* O; int ldc; float accs;
    __device__ __forceinline__ void operator()(const f32x4 (&acc)[2][2][4][2], const Unit& u, int wr, int wc, int fr, int fq) const {
        const int row0 = u.pm * BM + wr * 64 + fr, c0 = u.pn * BM + wc * 32 + 8 * fq;
        typedef unsigned u32x2 __attribute__((ext_vector_type(2)));
#pragma unroll
        for (int ai = 0; ai < 2; ++ai)
#pragma unroll
            for (int m = 0; m < 4; ++m) { unsigned char* rowp = O + (size_t)(row0 + ai * HALF + m * 16) * ldc + c0;
#pragma unroll
                for (int bj = 0; bj < 2; ++bj) { const f32x4 v0 = acc[ai][bj][m][0] * accs, v1 = acc[ai][bj][m][1] * accs; u32x2 w; w.x = pk4_fp8(v0[0], v0[1], v0[2], v0[3]); w.y = pk4_fp8(v1[0], v1[1], v1[2], v1[3]); *(u32x2*)(rowp + bj * HALF) = w; } }
    }
};
__device__ __forceinline__ float sigmoidf_fast(float x) { return __builtin_amdgcn_rcpf(1.f + __builtin_amdgcn_exp2f(-LOG2E * x)); }
struct EpiGate {
    static constexpr bool PERM = true, AFTER_DRAIN = false;
    const unsigned char* ya; const unsigned char* yb; const float* bg; unsigned char* uo; float accs;
    __device__ __forceinline__ void operator()(const f32x4 (&acc)[2][2][4][2], const Unit& u, int wr, int wc, int fr, int fq) const {
        const int row0 = u.pm * BM + wr * 64 + fr, cc = u.pn * 128 + wc * 32 + 8 * fq;
        const f32x4 ba0 = *(const f32x4*)(bg + cc), ba1 = *(const f32x4*)(bg + cc + 4), bb0 = *(const f32x4*)(bg + DM + cc), bb1 = *(const f32x4*)(bg + DM + cc + 4);
        typedef unsigned u32x2 __attribute__((ext_vector_type(2))); typedef float f32x2_ __attribute__((ext_vector_type(2)));
        u32x2 a8v[2][4], b8v[2][4];
#pragma unroll
        for (int ai = 0; ai < 2; ++ai)
#pragma unroll
            for (int m = 0; m < 4; ++m) { const size_t ro = (size_t)(row0 + ai * HALF + m * 16) * DM + cc; a8v[ai][m] = *(const u32x2*)(ya + ro); b8v[ai][m] = *(const u32x2*)(yb + ro); }
#pragma unroll
        for (int ai = 0; ai < 2; ++ai)
#pragma unroll
            for (int m = 0; m < 4; ++m) { const size_t ro = (size_t)(row0 + ai * HALF + m * 16) * DM + cc;
                const u32x2 a8 = a8v[ai][m], b8 = b8v[ai][m];
                const f32x4 ga0 = acc[ai][0][m][0] * accs + ba0, ga1 = acc[ai][0][m][1] * accs + ba1, gb0 = acc[ai][1][m][0] * accs + bb0, gb1 = acc[ai][1][m][1] * accs + bb1;
                const float ga[8] = {ga0[0], ga0[1], ga0[2], ga0[3], ga1[0], ga1[1], ga1[2], ga1[3]}, gb[8] = {gb0[0], gb0[1], gb0[2], gb0[3], gb1[0], gb1[1], gb1[2], gb1[3]};
                float yav[8], ybv[8];
                { const f32x2_ t0 = __builtin_amdgcn_cvt_pk_f32_fp8((int)a8.x, false), t1 = __builtin_amdgcn_cvt_pk_f32_fp8((int)a8.x, true), t2 = __builtin_amdgcn_cvt_pk_f32_fp8((int)a8.y, false), t3 = __builtin_amdgcn_cvt_pk_f32_fp8((int)a8.y, true);
                  yav[0] = t0[0]; yav[1] = t0[1]; yav[2] = t1[0]; yav[3] = t1[1]; yav[4] = t2[0]; yav[5] = t2[1]; yav[6] = t3[0]; yav[7] = t3[1]; }
                { const f32x2_ t0 = __builtin_amdgcn_cvt_pk_f32_fp8((int)b8.x, false), t1 = __builtin_amdgcn_cvt_pk_f32_fp8((int)b8.x, true), t2 = __builtin_amdgcn_cvt_pk_f32_fp8((int)b8.y, false), t3 = __builtin_amdgcn_cvt_pk_f32_fp8((int)b8.y, true);
                  ybv[0] = t0[0]; ybv[1] = t0[1]; ybv[2] = t1[0]; ybv[3] = t1[1]; ybv[4] = t2[0]; ybv[5] = t2[1]; ybv[6] = t3[0]; ybv[7] = t3[1]; }
                float r[8];
#pragma unroll
                for (int j = 0; j < 8; ++j) r[j] = sigmoidf_fast(ga[j]) * yav[j] + sigmoidf_fast(gb[j]) * ybv[j];
                u32x2 w; w.x = pk4_fp8(r[0], r[1], r[2], r[3]); w.y = pk4_fp8(r[4], r[5], r[6], r[7]);
                *(u32x2*)(uo + ro) = w; }
    }
};
struct EpiResid {
    static constexpr bool PERM = true, AFTER_DRAIN = false;
    const float* x; bf16_t* r; float accs;
    __device__ __forceinline__ void operator()(const f32x4 (&acc)[2][2][4][2], const Unit& u, int wr, int wc, int fr, int fq) const {
        const int row0 = u.pm * BM + wr * 64 + fr, c0 = u.pn * BM + wc * 32 + 8 * fq;
#pragma unroll
        for (int ai = 0; ai < 2; ++ai) {
            f32x4 xv[4][2][2];
#pragma unroll
            for (int m = 0; m < 4; ++m) { const size_t ro = (size_t)(row0 + ai * HALF + m * 16) * DM + c0;
#pragma unroll
                for (int bj = 0; bj < 2; ++bj) { xv[m][bj][0] = *(const f32x4*)(x + ro + bj * HALF); xv[m][bj][1] = *(const f32x4*)(x + ro + bj * HALF + 4); } }
#pragma unroll
            for (int m = 0; m < 4; ++m) { const size_t ro = (size_t)(row0 + ai * HALF + m * 16) * DM + c0;
#pragma unroll
                for (int bj = 0; bj < 2; ++bj) { const f32x4 a0 = acc[ai][bj][m][0] * accs + xv[m][bj][0] * ALPHA, a1 = acc[ai][bj][m][1] * accs + xv[m][bj][1] * ALPHA;
                    *(u32x4*)(r + ro + bj * HALF) = pack8s(a0, a1, 1.f); } }
        }
    }
};
template <class Epi, class Sched, bool STAMP = false>
__device__ __forceinline__ void gemm_phase(PG8_LAS unsigned char* lds, const Gemm g, const Sched& S, const Epi& E, unsigned long long* stamps) {
    const int tid = threadIdx.x, wid = __builtin_amdgcn_readfirstlane(tid >> 6), lane = tid & 63, wr = wid >> 2, wc = wid & 3, fr = lane & 15, fq = lane >> 4;
    const int K = g.K, nt = K / BK;
    int ts_lo = 0, ts_hi = 0, nts = 0; const unsigned long long rt_entry = STAMP ? (unsigned long long)wall_clock64() : 0ull;
#define PG8_STAMP() do { if (STAMP && wid == 0 && nts < 64) { const unsigned long long _c = (unsigned long long)clock64(); \
        ts_lo = (lane == nts) ? (int)(unsigned)_c : ts_lo; ts_hi = (lane == nts) ? (int)(unsigned)(_c >> 32) : ts_hi; ++nts; } } while (0)
    PG8_STAMP();
    unsigned voffA[2], voffB[2];
#pragma unroll
    for (int i = 0; i < 2; ++i) { int R, C; stage_rc(tid * 16 + i * 8192, R, C); const int Rb = Epi::PERM ? ((R & ~31) + perm32(R & 31)) : R;
        voffA[i] = (unsigned)(R * K + C) * 2u; voffB[i] = (unsigned)(Rb * K + C) * 2u; }
    const size_t kstep = (size_t)(BK * 2);
    const size_t hstep = (size_t)HALF * K * 2;
    const size_t tstep = 2 * hstep;
    const unsigned ldsw = (unsigned)wid * 1024u;
    const int aoff = lds_byte(wr * 64 + fr, fq * 8), boff = lds_byte(wc * 32 + fr, fq * 8);
#define PG8_SA(b, h) (((b) * 2 + (h)) * HTB)
#define PG8_SB(b, h) ((4 + (b) * 2 + (h)) * HTB)
#define PG8_STAGE(bufoff, gbase, voff) do { _Pragma("unroll") for (int _i = 0; _i < 2; ++_i) \
        __builtin_amdgcn_global_load_lds((const unsigned*)((const char*)(gbase) + (voff)[_i]), (PG8_LAS unsigned*)(lds + (bufoff) + ldsw + _i * 8192), 16, 0, 0); } while (0)
#define PG8_LDA(dst, b, h) do { _Pragma("unroll") for (int m = 0; m < 4; ++m) _Pragma("unroll") for (int k = 0; k < 2; ++k) dst[m][k] = *(const PG8_LAS bf16x8*)(lds + PG8_SA(b, h) + aoff + m * 2048 + k * 1024); } while (0)
#define PG8_LDB(dst, b, h) do { _Pragma("unroll") for (int n = 0; n < 2; ++n) _Pragma("unroll") for (int k = 0; k < 2; ++k) dst[n][k] = *(const PG8_LAS bf16x8*)(lds + PG8_SB(b, h) + boff + n * 2048 + k * 1024); } while (0)
#define PG8_MMA(ai, bj, At, Bt) do { __builtin_amdgcn_s_setprio(1); _Pragma("unroll") for (int m = 0; m < 4; ++m) _Pragma("unroll") for (int n = 0; n < 2; ++n) _Pragma("unroll") for (int k = 0; k < 2; ++k) \
        acc[ai][bj][m][n] = __builtin_amdgcn_mfma_f32_16x16x32_bf16(Bt[n][k], At[m][k], acc[ai][bj][m][n], 0, 0, 0); __builtin_amdgcn_s_setprio(0); } while (0)
#define PG8_WAIT_V(n) asm volatile("s_waitcnt vmcnt(" #n ")" ::: "memory")
#define PG8_WAIT_L(n) asm volatile("s_waitcnt lgkmcnt(" #n ")" ::: "memory")
#define PG8_BAR __builtin_amdgcn_s_barrier()
#define PG8_SCHED __builtin_amdgcn_sched_barrier(0)
    Unit cur, nxt; int ui = 0;
    if (!S.next(0, cur)) return;
    f32x4 acc[2][2][4][2];
#pragma unroll
    for (int a = 0; a < 2; ++a)
#pragma unroll
        for (int b = 0; b < 2; ++b)
#pragma unroll
            for (int m = 0; m < 4; ++m)
#pragma unroll
                for (int n = 0; n < 2; ++n) acc[a][b][m][n] = (f32x4){0.f, 0.f, 0.f, 0.f};
    bf16x8 At[4][2], B0[2][2], B1[2][2];
    const char* cA = (const char*)g.A + (size_t)cur.pm * tstep; const char* cB = (const char*)g.Bt + (size_t)cur.pn * tstep;
    S.a_ready(cur);
    PG8_STAGE(PG8_SB(0, 0), cB, voffB); PG8_STAGE(PG8_SA(0, 0), cA, voffA); PG8_STAGE(PG8_SB(0, 1), cB + hstep, voffB); PG8_STAGE(PG8_SA(0, 1), cA + hstep, voffA);
    if (wr == 1) PG8_BAR;
    PG8_WAIT_V(4); PG8_BAR;
    PG8_STAGE(PG8_SB(1, 0), cB + kstep, voffB); PG8_STAGE(PG8_SA(1, 0), cA + kstep, voffA); PG8_STAGE(PG8_SB(1, 1), cB + hstep + kstep, voffB);
    PG8_WAIT_V(6); PG8_BAR;
    PG8_STAMP();
    for (;;) {
        const bool has_next = S.next(ui + 1, nxt);
        const char* nA = has_next ? (const char*)g.A + (size_t)nxt.pm * tstep : cA; const char* nB = has_next ? (const char*)g.Bt + (size_t)nxt.pn * tstep : cB;
        for (int t = 0; t < nt; t += 2) {
            const bool last = (t == nt - 2);
            const char* a1 = cA + (size_t)(t + 1) * kstep;
            const char* a2 = last ? nA : cA + (size_t)(t + 2) * kstep; const char* b2 = last ? nB : cB + (size_t)(t + 2) * kstep;
            const char* a3 = a2 + kstep; const char* b3 = b2 + kstep;
            if (last && has_next) S.a_ready(nxt);
            PG8_LDB(B0, 0, 0); PG8_SCHED; PG8_LDA(At, 0, 0); PG8_STAGE(PG8_SA(1, 1), a1 + hstep, voffA);
            PG8_WAIT_L(8); PG8_BAR; PG8_WAIT_L(0); PG8_MMA(0, 0, At, B0); PG8_BAR; PG8_SCHED;
            PG8_LDB(B1, 0, 1); PG8_STAGE(PG8_SB(0, 0), b2, voffB);
            PG8_BAR; PG8_WAIT_L(0); PG8_MMA(0, 1, At, B1); PG8_BAR;
            PG8_LDA(At, 0, 1); PG8_STAGE(PG8_SA(0, 0), a2, voffA);
            PG8_BAR; PG8_WAIT_L(0); PG8_MMA(1, 0, At, B0); PG8_BAR; PG8_SCHED;
            PG8_STAGE(PG8_SB(0, 1), b2 + hstep, voffB);
            PG8_WAIT_V(6); PG8_BAR; PG8_MMA(1, 1, At, B1); PG8_BAR;
            PG8_LDB(B0, 1, 0); PG8_SCHED; PG8_LDA(At, 1, 0); PG8_STAGE(PG8_SA(0, 1), a2 + hstep, voffA);
            PG8_WAIT_L(8); PG8_BAR; PG8_WAIT_L(0); PG8_MMA(0, 0, At, B0); PG8_BAR; PG8_SCHED;
            PG8_LDB(B1, 1, 1); PG8_STAGE(PG8_SB(1, 0), b3, voffB);
            PG8_BAR; PG8_WAIT_L(0); PG8_MMA(0, 1, At, B1); PG8_BAR;
            PG8_LDA(At, 1, 1); PG8_STAGE(PG8_SA(1, 0), a3, voffA);
            PG8_BAR; PG8_WAIT_L(0); PG8_MMA(1, 0, At, B0); PG8_BAR; PG8_SCHED;
            PG8_STAGE(PG8_SB(1, 1), b3 + hstep, voffB);
            PG8_WAIT_V(6); PG8_BAR; PG8_MMA(1, 1, At, B1); PG8_BAR;
        }
        PG8_STAMP();
        if constexpr (!Epi::AFTER_DRAIN) { E(acc, cur, wr, wc, fr, fq); S.done(cur); }
        PG8_STAMP();
        if (!has_next) break;
#pragma unroll
        for (int a = 0; a < 2; ++a)
#pragma unroll
            for (int b = 0; b < 2; ++b)
#pragma unroll
                for (int m = 0; m < 4; ++m)
#pragma unroll
                    for (int n = 0; n < 2; ++n) acc[a][b][m][n] = (f32x4){0.f, 0.f, 0.f, 0.f};
        cur = nxt; cA = nA; cB = nB; ++ui;
    }
    PG8_WAIT_V(0);
    if (wr == 0) PG8_BAR;
    PG8_BAR;
    if constexpr (Epi::AFTER_DRAIN) { E.fused(acc, cur, wr, wc, fr, fq, lds, wid, lane); S.done(cur); }
    PG8_STAMP();
    if (STAMP && wid == 0) { stamps[lane] = lane < nts ? (((unsigned long long)(unsigned)ts_hi << 32) | (unsigned)ts_lo) : 0ull;
        if (lane == 62) stamps[62] = rt_entry; if (lane == 63) stamps[63] = (unsigned long long)wall_clock64(); }
#undef PG8_STAMP
#undef PG8_SA
#undef PG8_SB
#undef PG8_STAGE
#undef PG8_LDA
#undef PG8_LDB
#undef PG8_MMA
#undef PG8_WAIT_V
#undef PG8_WAIT_L
#undef PG8_BAR
#undef PG8_SCHED
}
typedef int i32x4 __attribute__((ext_vector_type(4)));
typedef int i32x8 __attribute__((ext_vector_type(8)));
template <class Epi, class Sched, bool STAMP = false>
__device__ __forceinline__ void gemm_phase8(PG8_LAS unsigned char* lds, const Gemm g, const Sched& S, const Epi& E, unsigned long long* stamps) {
    const int tid = threadIdx.x, wid = __builtin_amdgcn_readfirstlane(tid >> 6), lane = tid & 63, wr = wid >> 2, wc = wid & 3, fr = lane & 15, fq = lane >> 4;
    const int K = g.K, nt = K / BK;
    int ts_lo = 0, ts_hi = 0, nts = 0; const unsigned long long rt_entry = STAMP ? (unsigned long long)wall_clock64() : 0ull;
#define PG8_STAMP() do { if (STAMP && wid == 0 && nts < 64) { const unsigned long long _c = (unsigned long long)clock64(); \
        ts_lo = (lane == nts) ? (int)(unsigned)_c : ts_lo; ts_hi = (lane == nts) ? (int)(unsigned)(_c >> 32) : ts_hi; ++nts; } } while (0)
    PG8_STAMP();
    unsigned voffA[2], voffB[2];
#pragma unroll
    for (int i = 0; i < 2; ++i) { int R, C; stage_rc(tid * 16 + i * 8192, R, C); const int Rb = Epi::PERM ? ((R & ~31) + perm32(R & 31)) : R;
        voffA[i] = (unsigned)(R * K + C) * 2u; voffB[i] = (unsigned)(Rb * K + C) * 2u; }
    const size_t kstep = (size_t)(BK * 2);
    const size_t hstep = (size_t)HALF * K * 2;
    const size_t tstep = 2 * hstep;
    const unsigned ldsw = (unsigned)wid * 1024u;
    const int aoff = lds_byte(wr * 64 + fr, fq * 16), boff = lds_byte(wc * 32 + fr, fq * 16);
    const int hsw = (fq & 1) * 16, aofL = aoff + hsw, aofH = aoff + 16 - hsw, bofL = boff + hsw, bofH = boff + 16 - hsw;
#define PG8_SA(b, h) (((b) * 2 + (h)) * HTB)
#define PG8_SB(b, h) ((4 + (b) * 2 + (h)) * HTB)
#define PG8_STAGE(bufoff, gbase, voff) do { _Pragma("unroll") for (int _i = 0; _i < 2; ++_i) \
        __builtin_amdgcn_global_load_lds((const unsigned*)((const char*)(gbase) + (voff)[_i]), (PG8_LAS unsigned*)(lds + (bufoff) + ldsw + _i * 8192), 16, 0, 0); } while (0)
#define PG8_LDA(dst, b, h) do { _Pragma("unroll") for (int m = 0; m < 4; ++m) { const i32x4 lo_ = *(const PG8_LAS i32x4*)(lds + PG8_SA(b, h) + aofL + m * 2048), hi_ = *(const PG8_LAS i32x4*)(lds + PG8_SA(b, h) + aofH + m * 2048); dst[m] = (i32x8){lo_[0], lo_[1], lo_[2], lo_[3], hi_[0], hi_[1], hi_[2], hi_[3]}; } } while (0)
#define PG8_LDB(dst, b, h) do { _Pragma("unroll") for (int n = 0; n < 2; ++n) { const i32x4 lo_ = *(const PG8_LAS i32x4*)(lds + PG8_SB(b, h) + bofL + n * 2048), hi_ = *(const PG8_LAS i32x4*)(lds + PG8_SB(b, h) + bofH + n * 2048); dst[n] = (i32x8){lo_[0], lo_[1], lo_[2], lo_[3], hi_[0], hi_[1], hi_[2], hi_[3]}; } } while (0)
#define PG8_MMA(ai, bj, At, Bt) do { __builtin_amdgcn_s_setprio(1); _Pragma("unroll") for (int m = 0; m < 4; ++m) _Pragma("unroll") for (int n = 0; n < 2; ++n) \
        asm volatile("v_mfma_scale_f32_16x16x128_f8f6f4 %0, %1, %2, %0, %3, %3 op_sel_hi:[0,0,0]" : "+v"(acc[ai][bj][m][n]) : "v"(Bt[n]), "v"(At[m]), "v"(sc1)); __builtin_amdgcn_s_setprio(0); } while (0)
#define PG8_WAIT_V(n) asm volatile("s_waitcnt vmcnt(" #n ")" ::: "memory")
#define PG8_WAIT_L(n) asm volatile("s_waitcnt lgkmcnt(" #n ")" ::: "memory")
#define PG8_BAR __builtin_amdgcn_s_barrier()
#define PG8_SCHED __builtin_amdgcn_sched_barrier(0)
    const int sc1 = 0x7f7f7f7f;
    Unit cur, nxt; int ui = 0;
    if (!S.next(0, cur)) return;
    f32x4 acc[2][2][4][2];
#pragma unroll
    for (int a = 0; a < 2; ++a)
#pragma unroll
        for (int b = 0; b < 2; ++b)
#pragma unroll
            for (int m = 0; m < 4; ++m)
#pragma unroll
                for (int n = 0; n < 2; ++n) acc[a][b][m][n] = (f32x4){0.f, 0.f, 0.f, 0.f};
    i32x8 At[4], B0[2], B1[2];
    const char* cA = (const char*)g.A + (size_t)cur.pm * tstep; const char* cB = (const char*)g.Bt + (size_t)cur.pn * tstep;
    S.a_ready(cur);
    PG8_STAGE(PG8_SB(0, 0), cB, voffB); PG8_STAGE(PG8_SA(0, 0), cA, voffA); PG8_STAGE(PG8_SB(0, 1), cB + hstep, voffB); PG8_STAGE(PG8_SA(0, 1), cA + hstep, voffA);
    if (wr == 1) PG8_BAR;
    PG8_WAIT_V(4); PG8_BAR;
    PG8_STAGE(PG8_SB(1, 0), cB + kstep, voffB); PG8_STAGE(PG8_SA(1, 0), cA + kstep, voffA); PG8_STAGE(PG8_SB(1, 1), cB + hstep + kstep, voffB);
    PG8_WAIT_V(6); PG8_BAR;
    PG8_STAMP();
    for (;;) {
        const bool has_next = S.next(ui + 1, nxt);
        const char* nA = has_next ? (const char*)g.A + (size_t)nxt.pm * tstep : cA; const char* nB = has_next ? (const char*)g.Bt + (size_t)nxt.pn * tstep : cB;
        for (int t = 0; t < nt; t += 2) {
            const bool last = (t == nt - 2);
            const char* a1 = cA + (size_t)(t + 1) * kstep;
            const char* a2 = last ? nA : cA + (size_t)(t + 2) * kstep; const char* b2 = last ? nB : cB + (size_t)(t + 2) * kstep;
            const char* a3 = a2 + kstep; const char* b3 = b2 + kstep;
            if (last && has_next) S.a_ready(nxt);
            PG8_LDB(B0, 0, 0); PG8_SCHED; PG8_LDA(At, 0, 0); PG8_STAGE(PG8_SA(1, 1), a1 + hstep, voffA);
            PG8_WAIT_L(8); PG8_BAR; PG8_WAIT_L(0); PG8_MMA(0, 0, At, B0); PG8_BAR; PG8_SCHED;
            PG8_LDB(B1, 0, 1); PG8_STAGE(PG8_SB(0, 0), b2, voffB);
            PG8_BAR; PG8_WAIT_L(0); PG8_MMA(0, 1, At, B1); PG8_BAR;
            PG8_LDA(At, 0, 1); PG8_STAGE(PG8_SA(0, 0), a2, voffA);
            PG8_BAR; PG8_WAIT_L(0); PG8_MMA(1, 0, At, B0); PG8_BAR; PG8_SCHED;
            PG8_STAGE(PG8_SB(0, 1), b2 + hstep, voffB);
            PG8_WAIT_V(6); PG8_BAR; PG8_MMA(1, 1, At, B1); PG8_BAR;
            PG8_LDB(B0, 1, 0); PG8_SCHED; PG8_LDA(At, 1, 0); PG8_STAGE(PG8_SA(0, 1), a2 + hstep, voffA);
            PG8_WAIT_L(8); PG8_BAR; PG8_WAIT_L(0); PG8_MMA(0, 0, At, B0); PG8_BAR; PG8_SCHED;
            PG8_LDB(B1, 1, 1); PG8_STAGE(PG8_SB(1, 0), b3, voffB);
            PG8_BAR; PG8_WAIT_L(0); PG8_MMA(0, 1, At, B1); PG8_BAR;
            PG8_LDA(At, 1, 1); PG8_STAGE(PG8_SA(1, 0), a3, voffA);
            PG8_BAR; PG8_WAIT_L(0); PG8_MMA(1, 0, At, B0); PG8_BAR; PG8_SCHED;
            PG8_STAGE(PG8_SB(1, 1), b3 + hstep, voffB);
            PG8_WAIT_V(6); PG8_BAR; PG8_MMA(1, 1, At, B1); PG8_BAR;
        }
        PG8_STAMP();
        asm volatile("s_nop 15\n\ts_nop 15" ::: "memory");
        if constexpr (!Epi::AFTER_DRAIN) { E(acc, cur, wr, wc, fr, fq); S.done(cur); }
        PG8_STAMP();
        if (!has_next) break;
#pragma unroll
        for (int a = 0; a < 2; ++a)
#pragma unroll
            for (int b = 0; b < 2; ++b)
#pragma unroll
                for (int m = 0; m < 4; ++m)
#pragma unroll
                    for (int n = 0; n < 2; ++n) acc[a][b][m][n] = (f32x4){0.f, 0.f, 0.f, 0.f};
        cur = nxt; cA = nA; cB = nB; ++ui;
    }
    PG8_WAIT_V(0);
    if (wr == 0) PG8_BAR;
    PG8_BAR;
    if constexpr (Epi::AFTER_DRAIN) { E.fused(acc, cur, wr, wc, fr, fq, lds, wid, lane); S.done(cur); }
    PG8_STAMP();
    if (STAMP && wid == 0) { stamps[lane] = lane < nts ? (((unsigned long long)(unsigned)ts_hi << 32) | (unsigned)ts_lo) : 0ull;
        if (lane == 62) stamps[62] = rt_entry; if (lane == 63) stamps[63] = (unsigned long long)wall_clock64(); }
#undef PG8_STAMP
#undef PG8_SA
#undef PG8_SB
#undef PG8_STAGE
#undef PG8_LDA
#undef PG8_LDB
#undef PG8_MMA
#undef PG8_WAIT_V
#undef PG8_WAIT_L
#undef PG8_BAR
#undef PG8_SCHED
}
}

namespace att {
constexpr int SHM_V = 16384, SHM_K = 24576;
constexpr int OFF_V = 0, OFF_K = 2 * SHM_V, OFF_WS = OFF_K + 2 * SHM_K;
constexpr int ATT_LDS = OFF_WS + 8 * 256;
static_assert(ATT_LDS <= RING_BYTES, "attention LDS");
constexpr float THR = 11.5f;
__device__ __forceinline__ int v_st(int k, int c) { const int kk = (k & ~0xC) | ((k & 4) << 1) | ((k & 8) >> 1); return ((kk >> 3) * 4 + (c >> 5)) * 512 + ((kk & 7) * 32 + (c & 31)) * 2; }
__device__ __forceinline__ int v_rd_base(int lane) { return ((lane & 3) << 3) | (((lane >> 2) & 3) << 6) | (((lane >> 4) & 1) << 5) | (((lane >> 5) & 1) << 8); }
constexpr int v_rd_off(int d0, int ks, int half) { return d0 * 512 + ks * 4096 + half * 2048; }
__device__ __forceinline__ int crow(int r, int hi) { return (r & 3) + 8 * (r >> 2) + 4 * hi; }
__device__ __forceinline__ unsigned cvtpk(float lo, float hi) { unsigned r; asm volatile("v_cvt_pk_bf16_f32 %0, %1, %2" : "=v"(r) : "v"(lo), "v"(hi)); return r; }

struct Desc {
    const bf16* Q; long qs;
    const bf16* K; long ks;
    const bf16* K2; long k2s;
    const bf16* V; long vs;
    bf16* O; long os;
    float* LSE; long ls;
    int q0;
    int j_lo, j_hi;
    float sl;
    int first;
    unsigned char* O8; long o8s;
};

template <int MODE>
__device__ __forceinline__ void attn_prime(LAS unsigned char* lds, const Desc& a, bf16x8 (&qr)[MODE == 0 ? 12 : 8]) {
    constexpr int NQ = MODE == 0 ? 12 : 8;
    const int tid = threadIdx.x, wid = __builtin_amdgcn_readfirstlane(tid >> 6), lane = tid & 63, r32 = lane & 31, hi = lane >> 5;
    { const bf16* qrow = a.Q + (long)(wid * 32 + r32) * a.qs + hi * 8;
#pragma unroll
      for (int d0 = 0; d0 < NQ; ++d0) qr[d0] = *(const bf16x8*)(qrow + d0 * 16); }
#pragma unroll
    for (int r = 0; r < 2; ++r) { const int sidx = r * 512 + wid * 64 + lane; const int row = sidx >> 4, c = (sidx & 15) ^ (row & 15); const int oA = row * (int)a.ks + c * 8;
        const int sub = sidx >> 5, within = sidx & 31, kk = (sub >> 2) * 8 + (within >> 2), kq = (kk & ~0xC) | ((kk & 4) << 1) | ((kk & 8) >> 1), cc = (sub & 3) * 32 + (within & 3) * 8; const int oV = kq * (int)a.vs + cc;
        __builtin_amdgcn_global_load_lds((const unsigned*)(a.K + (long)(a.j_lo * 64) * a.ks + oA), (LAS unsigned*)(lds + OFF_K + r * 8192 + wid * 1024), 16, 0, 0);
        __builtin_amdgcn_global_load_lds((const unsigned*)(a.V + (long)(a.j_lo * 64) * a.vs + oV), (LAS unsigned*)(lds + OFF_V + r * 8192 + wid * 1024), 16, 0, 0); }
}
template <int MODE>
__device__ __forceinline__ void attn_unit(LAS unsigned char* lds, const Desc& a, const Desc& nx, bool has_next, bf16x8 (&qr)[MODE == 0 ? 12 : 8]) {
    constexpr int NQ = MODE == 0 ? 12 : 8;
    constexpr unsigned W = MODE == 0 ? 0x7fffffffu : 129u;
    const int tid = threadIdx.x, wid = __builtin_amdgcn_readfirstlane(tid >> 6), lane = tid & 63, r32 = lane & 31, hi = lane >> 5;
    const unsigned ldsb = (unsigned)(uintptr_t)lds;
    LAS float* wsf = (LAS float*)(lds + OFF_WS) + wid * 64; LAS float* li_l = wsf; LAS float* al_l = wsf + 32;
    float m_reg = -1e30f, l_reg = 0.f; f32x16 o[4];
#pragma unroll
    for (int d = 0; d < 4; ++d) o[d] = f32x16{};
    if (MODE == 1 && !a.first) {
        m_reg = a.LSE[(long)(wid * 32 + r32) * a.ls]; l_reg = 1.f;
#pragma unroll
        for (int r = 0; r < 16; ++r) { const v2u w = *(const v2u*)(a.O + (long)(wid * 32 + crow(r, hi)) * a.os + 4 * r32);
            o[0][r] = bf_lo(w.x); o[1][r] = bf_hi(w.x); o[2][r] = bf_lo(w.y); o[3][r] = bf_hi(w.y); }
    }
    int offA[2], offV[2], offB;
#pragma unroll
    for (int r = 0; r < 2; ++r) { const int sidx = r * 512 + wid * 64 + lane; const int row = sidx >> 4, c = (sidx & 15) ^ (row & 15); offA[r] = row * (int)a.ks + c * 8;
        const int sub = sidx >> 5, within = sidx & 31, kk = (sub >> 2) * 8 + (within >> 2), kq = (kk & ~0xC) | ((kk & 4) << 1) | ((kk & 8) >> 1), cc = (sub & 3) * 32 + (within & 3) * 8; offV[r] = kq * (int)a.vs + cc; }
    { const int sidx = wid * 64 + lane; const int row = sidx >> 3, c = (sidx & 7) ^ ((row >> 1) & 7); offB = row * (int)a.k2s + c * 8; }
#define AT_DMA(kb_, bf) do { \
        _Pragma("unroll") for (int r_ = 0; r_ < 2; ++r_) { \
            __builtin_amdgcn_global_load_lds((const unsigned*)(a.K + (long)(kb_) * a.ks + offA[r_]), (LAS unsigned*)(lds + OFF_K + (bf) * SHM_K + r_ * 8192 + wid * 1024), 16, 0, 0); \
            __builtin_amdgcn_global_load_lds((const unsigned*)(a.V + (long)(kb_) * a.vs + offV[r_]), (LAS unsigned*)(lds + OFF_V + (bf) * SHM_V + r_ * 8192 + wid * 1024), 16, 0, 0); } \
        if (MODE == 0) __builtin_amdgcn_global_load_lds((const unsigned*)(a.K2 + (long)(kb_) * a.k2s + offB), (LAS unsigned*)(lds + OFF_K + (bf) * SHM_K + 16384 + wid * 1024), 16, 0, 0); } while (0)
    int kbA[8], kbB[4];
#pragma unroll
    for (int dd = 0; dd < 8; ++dd) kbA[dd] = r32 * 256 + (((2 * dd + hi) ^ (r32 & 15)) << 4);
#pragma unroll
    for (int dd = 0; dd < 4; ++dd) kbB[dd] = 16384 + r32 * 128 + (((2 * dd + hi) ^ ((r32 >> 1) & 7)) << 4);
    const unsigned vb0 = ldsb + OFF_V + v_rd_base(lane);
    const int qlo = a.q0 + wid * 32;
    const int qm = qlo + r32 - 4 * hi;
    const int NT = a.j_hi - a.j_lo;
    const float NEGINF = -__builtin_inff();
    f32x16 cvec;
#pragma unroll
    for (int r = 0; r < 16; ++r) cvec[r] = MODE == 1 ? a.sl * (float)((r & 3) + 8 * (r >> 2)) : 0.f;

    unsigned kaA[8], kaB[4];
#pragma unroll
    for (int dd = 0; dd < 8; ++dd) kaA[dd] = ldsb + OFF_K + kbA[dd];
#pragma unroll
    for (int dd = 0; dd < 4; ++dd) kaB[dd] = ldsb + OFF_K + kbB[dd];
#define KRD(dst, base, off) asm volatile("ds_read_b128 %0, %1 offset:%2" : "=&v"(dst) : "v"(base), "i"(off) : "memory")
#define KRD2(x0, x1, d0_, BUF) do { if constexpr ((d0_) < 8) { KRD(x0, kaA[(d0_)], (BUF) * SHM_K); KRD(x1, kaA[(d0_)], (BUF) * SHM_K + 8192); } \
        else { KRD(x0, kaB[((d0_) - 8) & 3], (BUF) * SHM_K); KRD(x1, kaB[((d0_) - 8) & 3], (BUF) * SHM_K + 4096); } } while (0)
#define KBATCH(f, bt, BUF) do { KRD2(f[0], f[1], 2 * (bt), BUF); KRD2(f[2], f[3], 2 * (bt) + 1, BUF); } while (0)
#define QK_MMA(f, bt) do { p0 = __builtin_amdgcn_mfma_f32_32x32x16_bf16(f[0], qr[2 * (bt)], p0, 0, 0, 0); p1 = __builtin_amdgcn_mfma_f32_32x32x16_bf16(f[1], qr[2 * (bt)], p1, 0, 0, 0); \
        p0 = __builtin_amdgcn_mfma_f32_32x32x16_bf16(f[2], qr[2 * (bt) + 1], p0, 0, 0, 0); p1 = __builtin_amdgcn_mfma_f32_32x32x16_bf16(f[3], qr[2 * (bt) + 1], p1, 0, 0, 0); } while (0)
#define QK_MMA0(f, c_) do { p0 = __builtin_amdgcn_mfma_f32_32x32x16_bf16(f[0], qr[0], c_, 0, 0, 0); p1 = __builtin_amdgcn_mfma_f32_32x32x16_bf16(f[1], qr[0], c_, 0, 0, 0); \
        p0 = __builtin_amdgcn_mfma_f32_32x32x16_bf16(f[2], qr[1], p0, 0, 0, 0); p1 = __builtin_amdgcn_mfma_f32_32x32x16_bf16(f[3], qr[1], p1, 0, 0, 0); } while (0)
#define MAX3(acc_, x_, y_) asm("v_max3_f32 %0, %0, %1, %2" : "+v"(acc_) : "v"(x_), "v"(y_))
#define ADD1(acc_, x_) asm("v_add_f32 %0, %0, %1" : "+v"(acc_) : "v"(x_))
#define LGK(n) asm volatile("s_waitcnt lgkmcnt(" #n ")" ::: "memory")
#define TRRD(dst, off) asm volatile("ds_read_b64_tr_b16 %0, %1 offset:%2" : "=&v"(dst) : "v"(vb0), "i"(off) : "memory")
#define VRD8(S, VB, d0) do { constexpr int b_ = (VB) * SHM_V + v_rd_off(d0, 0, 0); \
        TRRD(S[0], b_); TRRD(S[1], b_ + 2048); TRRD(S[2], b_ + 4096); TRRD(S[3], b_ + 6144); TRRD(S[4], b_ + 8192); TRRD(S[5], b_ + 10240); TRRD(S[6], b_ + 12288); TRRD(S[7], b_ + 14336); } while (0)
#define PV_MMA(S, d0) do { \
        o[d0] = __builtin_amdgcn_mfma_f32_32x32x16_bf16(pa0, (bf16x8){S[0][0], S[0][1], S[0][2], S[0][3], S[1][0], S[1][1], S[1][2], S[1][3]}, o[d0], 0, 0, 0); \
        o[d0] = __builtin_amdgcn_mfma_f32_32x32x16_bf16(pa1, (bf16x8){S[2][0], S[2][1], S[2][2], S[2][3], S[3][0], S[3][1], S[3][2], S[3][3]}, o[d0], 0, 0, 0); \
        o[d0] = __builtin_amdgcn_mfma_f32_32x32x16_bf16(pa2, (bf16x8){S[4][0], S[4][1], S[4][2], S[4][3], S[5][0], S[5][1], S[5][2], S[5][3]}, o[d0], 0, 0, 0); \
        o[d0] = __builtin_amdgcn_mfma_f32_32x32x16_bf16(pa3, (bf16x8){S[6][0], S[6][1], S[6][2], S[6][3], S[7][0], S[7][1], S[7][2], S[7][3]}, o[d0], 0, 0, 0); } while (0)
#define PK4(P, B_, OUT) do { unsigned a0 = cvtpk(P[B_ + 0], P[B_ + 1]), a1 = cvtpk(P[B_ + 2], P[B_ + 3]); \
        unsigned b0 = cvtpk(P[B_ + 4], P[B_ + 5]), b1 = cvtpk(P[B_ + 6], P[B_ + 7]); \
        auto r0 = __builtin_amdgcn_permlane32_swap(a0, b0, false, false); auto r1 = __builtin_amdgcn_permlane32_swap(a1, b1, false, false); \
        v4u w = {r0[0], r1[0], r0[1], r1[1]}; OUT = __builtin_bit_cast(bf16x8, w); } while (0)

#define AT_STEP(t, BUF) do { \
        const int kb = (a.j_lo + (t)) * 64; \
        if ((t) + 1 < NT) AT_DMA(kb + 64, (BUF) ^ 1); \
        const bool act = (kb <= qlo + 31) && (MODE == 0 || kb + 63 >= qlo - 128); \
        if (act) { \
            f32x16 p0, p1; \
            { bf16x8 fa[4], fb[4]; \
              KBATCH(fa, 0, BUF); KBATCH(fb, 1, BUF); \
              LGK(4); SBAR(); QK_MMA0(fa, cvec); SBAR(); KBATCH(fa, 2, BUF); \
              LGK(4); SBAR(); QK_MMA(fb, 1); SBAR(); KBATCH(fb, 3, BUF); \
              if constexpr (MODE == 0) { \
                  LGK(4); SBAR(); QK_MMA(fa, 2); SBAR(); KBATCH(fa, 4, BUF); \
                  LGK(4); SBAR(); QK_MMA(fb, 3); SBAR(); KBATCH(fb, 5, BUF); \
                  LGK(4); SBAR(); QK_MMA(fa, 4); SBAR(); \
                  LGK(0); SBAR(); QK_MMA(fb, 5); SBAR(); \
              } else { \
                  LGK(4); SBAR(); QK_MMA(fa, 2); SBAR(); \
                  LGK(0); SBAR(); QK_MMA(fb, 3); SBAR(); } } \
            const int dq = qm - kb; \
            const float nb = MODE == 1 ? -a.sl * (float)dq : 0.f, off1 = MODE == 1 ? 32.f * a.sl : 0.f;     \
            if ((kb + 63 > qlo) || (MODE == 1 && kb <= qlo + 31 - 129)) { \
                _Pragma("unroll") for (int r = 0; r < 16; ++r) { const int c = (r & 3) + 8 * (r >> 2); \
                    if ((unsigned)(dq - c) >= W) p0[r] = NEGINF; if ((unsigned)(dq - c - 32) >= W) p1[r] = NEGINF; } } \
            asm volatile("s_nop 15" : "+v"(p0), "+v"(p1));                   \
            float pmax; { float x0 = p0[0], x1 = p0[1], y0 = p1[0], y1 = p1[1]; \
                _Pragma("unroll") for (int r = 2; r < 16; r += 4) { MAX3(x0, p0[r], p0[r + 1]); MAX3(y0, p1[r], p1[r + 1]); } \
                _Pragma("unroll") for (int r = 4; r < 16; r += 4) { MAX3(x1, p0[r], p0[r + 1]); MAX3(y1, p1[r], p1[r + 1]); } \
                pmax = fmaxf(fmaxf(x0, x1), fmaxf(y0, y1) + off1) + nb; } \
            { auto rr = __builtin_amdgcn_permlane32_swap(__float_as_uint(pmax), __float_as_uint(pmax), false, false); pmax = fmaxf(__uint_as_float(rr[0]), __uint_as_float(rr[1])); } \
            float alpha = 1.f; \
            if (!__all(pmax - m_reg <= THR)) { const float mn = fmaxf(m_reg, pmax); alpha = __builtin_amdgcn_exp2f(m_reg - mn); m_reg = mn; } \
            if (__any(alpha < 1.f)) { if (hi == 0) al_l[r32] = alpha; LDS_WAIT(); \
                _Pragma("unroll") for (int r = 0; r < 16; ++r) { const float f = al_l[crow(r, hi)]; o[0][r] *= f; o[1][r] *= f; o[2][r] *= f; o[3][r] *= f; } } \
            float ps; { const float e0 = nb - m_reg, e1 = e0 + off1; float psa[4]; \
                _Pragma("unroll") for (int r = 0; r < 16; ++r) p0[r] = __builtin_amdgcn_exp2f(p0[r] + e0); \
                _Pragma("unroll") for (int r = 0; r < 16; ++r) p1[r] = __builtin_amdgcn_exp2f(p1[r] + e1); \
                asm volatile("s_nop 0" : "+v"(p0), "+v"(p1));            \
                _Pragma("unroll") for (int r = 0; r < 4; ++r) psa[r] = p0[r]; \
                _Pragma("unroll") for (int r = 4; r < 16; ++r) ADD1(psa[r & 3], p0[r]); \
                _Pragma("unroll") for (int r = 0; r < 16; ++r) ADD1(psa[r & 3], p1[r]); \
                ADD1(psa[0], psa[1]); ADD1(psa[2], psa[3]); ADD1(psa[0], psa[2]); ps = psa[0]; } \
            { auto rr = __builtin_amdgcn_permlane32_swap(__float_as_uint(ps), __float_as_uint(ps), false, false); ps = __uint_as_float(rr[0]) + __uint_as_float(rr[1]); } \
            l_reg = l_reg * alpha + ps; \
            bf16x8 pa0, pa1, pa2, pa3; PK4(p0, 0, pa0); PK4(p0, 8, pa1); PK4(p1, 0, pa2); PK4(p1, 8, pa3); \
            { s16x4 va[8], vb_[8]; \
              VRD8(va, BUF, 0); VRD8(vb_, BUF, 1); \
              LGK(8); SBAR(); PV_MMA(va, 0); SBAR(); VRD8(va, BUF, 2); \
              LGK(8); SBAR(); PV_MMA(vb_, 1); SBAR(); VRD8(vb_, BUF, 3); \
              LGK(8); SBAR(); PV_MMA(va, 2); SBAR(); \
              LGK(0); SBAR(); PV_MMA(vb_, 3); SBAR(); } \
        } \
        VM_WAIT(); __syncthreads(); } while (0)

    VM_WAIT(); __syncthreads();
    for (int t = 0; t < NT; t += 2) { AT_STEP(t, 0); if (t + 1 < NT) AT_STEP(t + 1, 1); }

    if (has_next) {
        { const bf16* qrow = nx.Q + (long)(wid * 32 + r32) * nx.qs + hi * 8;
#pragma unroll
          for (int d0 = 0; d0 < NQ; ++d0) qr[d0] = *(const bf16x8*)(qrow + d0 * 16); }
#pragma unroll
        for (int r_ = 0; r_ < 2; ++r_) {
            __builtin_amdgcn_global_load_lds((const unsigned*)(nx.K + (long)(nx.j_lo * 64) * nx.ks + offA[r_]), (LAS unsigned*)(lds + OFF_K + r_ * 8192 + wid * 1024), 16, 0, 0);
            __builtin_amdgcn_global_load_lds((const unsigned*)(nx.V + (long)(nx.j_lo * 64) * nx.vs + offV[r_]), (LAS unsigned*)(lds + OFF_V + r_ * 8192 + wid * 1024), 16, 0, 0); }
        SBAR(); }
    if (hi == 0) li_l[r32] = l_reg;
    LDS_WAIT();
    if (MODE == 1 && !a.O8 && hi == 0) a.LSE[(long)(wid * 32 + r32) * a.ls] = m_reg + __builtin_amdgcn_logf(l_reg);
    if (a.O8) {
#pragma unroll
        for (int r = 0; r < 16; ++r) { const int orow = crow(r, hi); const float rl = 64.f * __builtin_amdgcn_rcpf(li_l[orow]);
            *(unsigned*)(a.O8 + (long)(wid * 32 + orow) * a.o8s + 4 * r32) = pk4_fp8(o[0][r] * rl, o[1][r] * rl, o[2][r] * rl, o[3][r] * rl); }
    } else {
#pragma unroll
        for (int r = 0; r < 16; ++r) { const int orow = crow(r, hi); const float rl = __builtin_amdgcn_rcpf(li_l[orow]);
            *(v2u*)(a.O + (long)(wid * 32 + orow) * a.os + 4 * r32) = (v2u){cvtpk(o[0][r] * rl, o[1][r] * rl), cvtpk(o[2][r] * rl, o[3][r] * rl)}; }
    }
    asm volatile("s_waitcnt lgkmcnt(0)\n\ts_barrier" ::: "memory");
#undef AT_DMA
#undef TRRD
#undef KRD
#undef KRD2
#undef KBATCH
#undef QK_MMA
#undef LGK
#undef VRD8
#undef PV_MMA
#undef PK4
#undef AT_STEP
#undef QK_MMA0
#undef MAX3
#undef ADD1
}
}

namespace att8 {
typedef int i32x8 __attribute__((ext_vector_type(8)));
typedef int i32x4 __attribute__((ext_vector_type(4)));
constexpr int SHM_V = 8192, SHM_K = 12288;
constexpr int OFF_V = 0, OFF_K = 4 * SHM_V, OFF_WS = OFF_K + 3 * SHM_K;
constexpr float THR = 4.f;
constexpr float QPRE = 8.f;
__device__ __forceinline__ int pk4u_fp8(float a, float b, float c, float d) { int w; asm volatile("" : "=v"(w)); w = __builtin_amdgcn_cvt_pk_fp8_f32(a, b, w, false); return __builtin_amdgcn_cvt_pk_fp8_f32(c, d, w, true); }
#define PK4U(a_, b_, c_, d_) pk4u_fp8(a_, b_, c_, d_)
__device__ __forceinline__ int crow8(int r, int hi) { return (r & 3) + 8 * (r >> 2) + 4 * hi; }
__host__ __device__ __forceinline__ int vperm(int key) { return 32 * ((key >> 2) & 1) + 4 * (((key >> 3) & 3) + 4 * (key >> 5)) + (key & 3); }

struct Desc {
    const unsigned char* Q; long qs;
    const unsigned char* K; long ks;
    const unsigned char* K2; long k2s;
    const unsigned char* VT; long vts;
    unsigned char* O8; long o8s;
    int q0, j_hi;
    int trail;
};

__device__ __forceinline__ void attn_unit(LAS unsigned char* lds, const Desc& a) {
    const int tid = threadIdx.x, wid = __builtin_amdgcn_readfirstlane(tid >> 6), lane = tid & 63, r32 = lane & 31, hi = lane >> 5;
    const unsigned ldsb = (unsigned)(uintptr_t)lds;
    LAS float* wsf = (LAS float*)(lds + OFF_WS) + wid * 64; LAS float* li_l = wsf; LAS float* al_l = wsf + 32;
    const int sc1 = 0x7f7f7f7f, scq = 0x7c7c7c7c;
    i32x8 qf[3];
    { const unsigned char* qrow = a.Q + (long)(wid * 32 + r32) * a.qs + 32 * hi;
#pragma unroll
      for (int s = 0; s < 3; ++s) { const i32x4 lo_ = *(const i32x4*)(qrow + 64 * s), hi_ = *(const i32x4*)(qrow + 64 * s + 16); qf[s] = (i32x8){lo_[0], lo_[1], lo_[2], lo_[3], hi_[0], hi_[1], hi_[2], hi_[3]}; } }
    float m_reg = -1e30f, l_reg = 0.f; f32x16 o[4];
#pragma unroll
    for (int d = 0; d < 4; ++d) o[d] = f32x16{};
    int offA, offB, offV;
    { const int sidx = wid * 64 + lane; { const int row = sidx >> 3, c = (sidx & 7) ^ ((row >> 1) & 7); offA = row * (int)a.ks + 16 * c; }
      { const int row = (sidx & 255) >> 2, c = (sidx & 3) ^ ((row >> 2) & 3); offB = row * (int)a.k2s + 16 * c; }
      { const int d = sidx >> 2, c = (sidx & 3) ^ ((d >> 2) & 3); offV = d * (int)a.vts + 16 * c; } }
#define A8_DMA(kb_, bf, vs_) do { \
        __builtin_amdgcn_global_load_lds((const unsigned*)(a.K + (long)(kb_) * a.ks + offA), (LAS unsigned*)(lds + OFF_K + (bf) * SHM_K + wid * 1024), 16, 0, 0); \
        __builtin_amdgcn_global_load_lds((const unsigned*)(a.VT + (kb_) + offV), (LAS unsigned*)(lds + OFF_V + (vs_) * SHM_V + wid * 1024), 16, 0, 0); \
        if (wid < 4) __builtin_amdgcn_global_load_lds((const unsigned*)(a.K2 + (long)(kb_) * a.k2s + offB), (LAS unsigned*)(lds + OFF_K + (bf) * SHM_K + 8192 + wid * 1024), 16, 0, 0); } while (0)
    unsigned kaA[2][2], kaB[2], va[2];
#pragma unroll
    for (int e = 0; e < 2; ++e) {
#pragma unroll
        for (int s = 0; s < 2; ++s) kaA[s][e] = ldsb + OFF_K + r32 * 128 + (((4 * s + 2 * hi + e) ^ ((r32 >> 1) & 7)) << 4);
        kaB[e] = ldsb + OFF_K + 8192 + r32 * 64 + (((2 * hi + e) ^ ((r32 >> 2) & 3)) << 4);
        va[e] = ldsb + OFF_V + r32 * 64 + (((2 * hi + e) ^ ((r32 >> 2) & 3)) << 4); }
    const int qlo = a.q0 + wid * 32, qm = qlo + r32 - 4 * hi, NT = a.j_hi;
    const float NEGINF = -__builtin_inff();
#define RD16(dst, base, off) asm volatile("ds_read_b128 %0, %1 offset:%2" : "=&v"(dst) : "v"(base), "i"(off) : "memory")
#define LGK(n) asm volatile("s_waitcnt lgkmcnt(" #n ")" ::: "memory")
#define MMA8(acc_, a_, b_) asm volatile("s_nop 1\n\tv_mfma_scale_f32_32x32x64_f8f6f4 %0, %1, %2, %0, %3, %3 op_sel_hi:[0,0,0]" : "+v"(acc_) : "v"(a_), "v"(b_), "v"(sc1))
#define MMA8Z(acc_, a_, b_) asm volatile("s_nop 1\n\tv_mfma_scale_f32_32x32x64_f8f6f4 %0, %1, %2, 0, %3, %3 op_sel_hi:[0,0,0]" : "=&v"(acc_) : "v"(a_), "v"(b_), "v"(sc1))
#define MMAQ(acc_, a_, b_) asm volatile("s_nop 1\n\tv_mfma_scale_f32_32x32x64_f8f6f4 %0, %1, %2, %0, %3, %4 op_sel_hi:[0,0,0]" : "+v"(acc_) : "v"(a_), "v"(b_), "v"(sc1), "v"(scq))
#define MMAQZ(acc_, a_, b_) asm volatile("s_nop 1\n\tv_mfma_scale_f32_32x32x64_f8f6f4 %0, %1, %2, 0, %3, %4 op_sel_hi:[0,0,0]" : "=&v"(acc_) : "v"(a_), "v"(b_), "v"(sc1), "v"(scq))
#define MMAQC(acc_, a_, b_, c_) asm volatile("s_nop 1\n\tv_mfma_scale_f32_32x32x64_f8f6f4 %0, %1, %2, %3, %4, %5 op_sel_hi:[0,0,0]" : "=&v"(acc_) : "v"(a_), "v"(b_), "v"(c_), "v"(sc1), "v"(scq))
#define MK8(x_, l_, h_) x_ = (i32x8){l_[0], l_[1], l_[2], l_[3], h_[0], h_[1], h_[2], h_[3]}
#define KRD(s_, BUF, l0, h0, l1, h1) do { if constexpr ((s_) < 2) { RD16(l0, kaA[s_][0], (BUF) * SHM_K); RD16(h0, kaA[s_][1], (BUF) * SHM_K); RD16(l1, kaA[s_][0], (BUF) * SHM_K + 4096); RD16(h1, kaA[s_][1], (BUF) * SHM_K + 4096); } \
        else { RD16(l0, kaB[0], (BUF) * SHM_K); RD16(h0, kaB[1], (BUF) * SHM_K); RD16(l1, kaB[0], (BUF) * SHM_K + 2048); RD16(h1, kaB[1], (BUF) * SHM_K + 2048); } } while (0)
#define VRD(d0_, vb0_, vb1_, l0, h0) do { RD16(l0, vb0_, (d0_) * 2048); RD16(h0, vb1_, (d0_) * 2048); } while (0)

#define PV_PRE(vb0_, vb1_) do { i32x4 yl, yh; i32x8 fv; \
        VRD(0, vb0_, vb1_, vxl, vxh); VRD(1, vb0_, vb1_, yl, yh); \
        asm volatile("s_nop 3" : "+v"(pa)); \
        LGK(2); SBAR(); MK8(fv, vxl, vxh); MMA8(o[0], pa, fv); SBAR(); VRD(2, vb0_, vb1_, vxl, vxh); \
        LGK(2); SBAR(); MK8(fv, yl, yh); MMA8(o[1], pa, fv); SBAR(); VRD(3, vb0_, vb1_, yl, yh); \
        LGK(2); SBAR(); MK8(fv, vxl, vxh); MMA8(o[2], pa, fv); SBAR(); \
        LGK(0); SBAR(); MK8(fv, yl, yh); MMA8(o[3], pa, fv); SBAR(); } while (0)
#define MAX3(acc_, x_, y_) asm("v_max3_f32 %0, %0, %1, %2" : "+v"(acc_) : "v"(x_), "v"(y_))
#define ADD1(acc_, x_) asm("v_add_f32 %0, %0, %1" : "+v"(acc_) : "v"(x_))
#define BAR_RAW() asm volatile("s_barrier" ::: "memory")
#define BAR_DMA() asm volatile("s_waitcnt vmcnt(0) lgkmcnt(0)\n\ts_barrier" ::: "memory")
#define SEG_M(t, BUF, FIRST_) do { \
        const int kb = (t) * 64; \
        act = kb <= qlo + 31; \
        if (act_prev) PV_PRE(vp0, vp1);                                  \
        if (act) { \
            i32x4 xl0, xh0, xl1, xh1, yl0, yh0, yl1, yh1; i32x8 f0, f1; \
            KRD(0, BUF, xl0, xh0, xl1, xh1); KRD(1, BUF, yl0, yh0, yl1, yh1); \
            LGK(4); SBAR(); MK8(f0, xl0, xh0); MK8(f1, xl1, xh1); \
            if (FIRST_) { MMAQZ(p0, f0, qf[0]); MMAQZ(p1, f1, qf[0]); } else { MMAQC(p0, f0, qf[0], nm); MMAQC(p1, f1, qf[0], nm); } \
            SBAR(); KRD(2, BUF, xl0, xh0, xl1, xh1); \
            LGK(4); SBAR(); MK8(f0, yl0, yh0); MK8(f1, yl1, yh1); MMAQ(p0, f0, qf[1]); MMAQ(p1, f1, qf[1]); SBAR(); \
            LGK(0); SBAR(); MK8(f0, xl0, xh0); MK8(f1, xl1, xh1); MMAQ(p0, f0, qf[2]); MMAQ(p1, f1, qf[2]); SBAR(); } \
          \
        VM_WAIT(); \
        if ((t) + 2 < NT) A8_DMA(kb + 128, ((BUF) + 2) % 3, ((vsel + 2) & 3)); \
        asm volatile("s_nop 15\n\ts_nop 7" : "+v"(p0), "+v"(p1)); \
        BAR_RAW(); \
    } while (0)
#define SEG_V(t, BUF, FIRST_) do { \
        const int kb = (t) * 64; \
        if (act) { \
            const int dq = qm - kb; \
            if (kb + 63 > qlo) { \
                _Pragma("unroll") for (int r = 0; r < 16; ++r) { const int c = (r & 3) + 8 * (r >> 2); if (dq - c < 0) p0[r] = NEGINF; if (dq - c - 32 < 0) p1[r] = NEGINF; } } \
            float pmx[4] = {p0[0], p0[1], p0[2], p0[3]}; \
            _Pragma("unroll") for (int r = 4; r < 16; r += 2) MAX3(pmx[(r >> 1) & 3], p0[r], p0[r + 1]); \
            _Pragma("unroll") for (int r = 0; r < 16; r += 2) MAX3(pmx[(r >> 1) & 3], p1[r], p1[r + 1]); \
            float pmax; asm("v_max3_f32 %0, %1, %2, %3" : "=v"(pmax) : "v"(pmx[0]), "v"(pmx[1]), "v"(pmx[2])); asm("v_max_f32 %0, %0, %1" : "+v"(pmax) : "v"(pmx[3])); \
            { auto rr = __builtin_amdgcn_permlane32_swap(__float_as_uint(pmax), __float_as_uint(pmax), false, false); pmax = fmaxf(__uint_as_float(rr[0]), __uint_as_float(rr[1])); } \
            float alpha = 1.f; \
            if (FIRST_) {     \
                const float mn = fmaxf(m_reg, pmax); alpha = __builtin_amdgcn_exp2f(m_reg - mn); m_reg = mn; const float moff = 4.f - m_reg; \
                _Pragma("unroll") for (int r = 0; r < 16; ++r) { p0[r] += moff; p1[r] += moff; } \
                _Pragma("unroll") for (int r = 0; r < 16; ++r) nm[r] = moff; \
            } else if (!__all(pmax - 4.f <= THR)) {     \
                const float delta = fmaxf(pmax - 4.f, 0.f); alpha = __builtin_amdgcn_exp2f(-delta); m_reg += delta; const float moff = 4.f - m_reg; \
                _Pragma("unroll") for (int r = 0; r < 16; ++r) { p0[r] -= delta; p1[r] -= delta; } \
                _Pragma("unroll") for (int r = 0; r < 16; ++r) nm[r] = moff; } \
            if (__any(alpha < 1.f)) { if (hi == 0) al_l[r32] = alpha; LDS_WAIT(); \
                asm volatile("s_nop 15\n\ts_nop 7" : "+v"(o[0]), "+v"(o[1]), "+v"(o[2]), "+v"(o[3])); \
                _Pragma("unroll") for (int r = 0; r < 16; ++r) { const float f = al_l[crow8(r, hi)]; o[0][r] *= f; o[1][r] *= f; o[2][r] *= f; o[3][r] *= f; } } \
            float ps, psa[4];     \
            _Pragma("unroll") for (int r = 0; r < 16; ++r) p0[r] = __builtin_amdgcn_exp2f(p0[r]); \
            _Pragma("unroll") for (int r = 0; r < 16; ++r) p1[r] = __builtin_amdgcn_exp2f(p1[r]); \
            asm volatile("s_nop 0" : "+v"(p0), "+v"(p1));                \
            _Pragma("unroll") for (int r = 0; r < 4; ++r) psa[r] = p0[r]; \
            _Pragma("unroll") for (int r = 4; r < 16; ++r) ADD1(psa[r & 3], p0[r]); \
            _Pragma("unroll") for (int r = 0; r < 16; ++r) ADD1(psa[r & 3], p1[r]); \
            ADD1(psa[0], psa[1]); ADD1(psa[2], psa[3]); ADD1(psa[0], psa[2]); ps = psa[0]; \
            { auto rr = __builtin_amdgcn_permlane32_swap(__float_as_uint(ps), __float_as_uint(ps), false, false); ps = __uint_as_float(rr[0]) + __uint_as_float(rr[1]); } \
            l_reg = l_reg * alpha + ps; \
            _Pragma("unroll") for (int j = 0; j < 4; ++j) { pa[j] = PK4U(p0[4 * j], p0[4 * j + 1], p0[4 * j + 2], p0[4 * j + 3]); pa[4 + j] = PK4U(p1[4 * j], p1[4 * j + 1], p1[4 * j + 2], p1[4 * j + 3]); } \
        } \
        act_prev = act; vp0 = vc0; vp1 = vc1; vsel = (vsel + 1) & 3; vc0 = va[0] + (unsigned)vsel * SHM_V; vc1 = va[1] + (unsigned)vsel * SHM_V; \
        BAR_RAW(); \
    } while (0)

    f32x16 nm = f32x16{}, p0 = f32x16{}, p1 = f32x16{};
    i32x8 pa = i32x8{}; bool act = false, act_prev = false; int vsel = 0; unsigned vc0 = va[0], vc1 = va[1], vp0 = va[0], vp1 = va[1];
    i32x4 vxl, vxh;
    A8_DMA(0, 0, 0); if (1 < NT) A8_DMA(64, 1, 1);
    BAR_DMA();
    if (a.trail) BAR_RAW();
    SEG_M(0, 0, 1); SEG_V(0, 0, 1);
    for (int t = 1; t < NT; t += 3) {
        SEG_M(t, 1, 0); SEG_V(t, 1, 0);
        if (t + 1 < NT) { SEG_M(t + 1, 2, 0); SEG_V(t + 1, 2, 0); }
        if (t + 2 < NT) { SEG_M(t + 2, 0, 0); SEG_V(t + 2, 0, 0); } }
    if (act_prev) PV_PRE(vp0, vp1);
    if (!a.trail) BAR_RAW();

    asm volatile("s_nop 15\n\ts_nop 7" : "+v"(o[0]), "+v"(o[1]), "+v"(o[2]), "+v"(o[3]));
    if (hi == 0) li_l[r32] = l_reg;
    LDS_WAIT();
#pragma unroll
    for (int r = 0; r < 16; ++r) { const int orow = crow8(r, hi); const float rl = 64.f * __builtin_amdgcn_rcpf(li_l[orow]);
        *(unsigned*)(a.O8 + (long)(wid * 32 + orow) * a.o8s + 4 * r32) = pk4_fp8(o[0][r] * rl, o[1][r] * rl, o[2][r] * rl, o[3][r] * rl); }
    asm volatile("s_waitcnt lgkmcnt(0)\n\ts_barrier" ::: "memory");
#undef A8_DMA
#undef RD16
#undef LGK
#undef MMA8
#undef MMA8Z
#undef MMAQ
#undef MMAQZ
#undef MMAQC
#undef MK8
#undef KRD
#undef VRD
#undef SEG_M
#undef MAX3
#undef ADD1
#undef PK4U
#undef SEG_V
#undef BAR_RAW
#undef BAR_DMA
#undef PV_PRE
}
}

template <class RowMap>
__device__ __forceinline__ void transpose_item(const float* W, int ldw, int K, int k0, int nsrc0, bf16* WT, RowMap rm, LAS float* scr, int lane) {
#pragma unroll
    for (int i = 0; i < 8; ++i) { const int kk = 8 * i + (lane >> 3); const f32x4 v = *(const f32x4*)(W + (size_t)(k0 + kk) * ldw + nsrc0 + 4 * (lane & 7)); LAS float* d = scr + kk * 33 + 4 * (lane & 7); d[0] = v.x; d[1] = v.y; d[2] = v.z; d[3] = v.w; }
    LDS_WAIT(); asm volatile("" ::: "memory");
    const int c = lane & 7;
#pragma unroll
    for (int j = 0; j < 4; ++j) { const int n = (lane >> 3) + 8 * j; const LAS float* s = scr + (8 * c) * 33 + n;
        v4u o; o.x = pk2(s[0 * 33], s[1 * 33]); o.y = pk2(s[2 * 33], s[3 * 33]); o.z = pk2(s[4 * 33], s[5 * 33]); o.w = pk2(s[6 * 33], s[7 * 33]);
        *(v4u*)(WT + (size_t)rm(nsrc0 + n) * K + k0 + 8 * c) = o; }
    LDS_WAIT(); asm volatile("" ::: "memory");
}
struct KmIdent { __device__ __forceinline__ int operator()(int k) const { return k; } };
struct KmAttn { __device__ __forceinline__ int operator()(int k) const { return (k & ~127) + 32 * (k & 3) + ((k & 127) >> 2); } };
template <class RowMap, class KMap = KmIdent>
__device__ __forceinline__ void transpose_item8(const float* W, int ldw, int K, int k0, int nsrc0, unsigned char* WT, RowMap rm, LAS float* scr, int lane, KMap km = KMap()) {
#pragma unroll
    for (int i = 0; i < 8; ++i) { const int kk = 8 * i + (lane >> 3); const f32x4 v = *(const f32x4*)(W + (size_t)km(k0 + kk) * ldw + nsrc0 + 4 * (lane & 7)); LAS float* d = scr + kk * 33 + 4 * (lane & 7); d[0] = v.x; d[1] = v.y; d[2] = v.z; d[3] = v.w; }
    LDS_WAIT(); asm volatile("" ::: "memory");
    const int c = lane & 7;
#pragma unroll
    for (int j = 0; j < 4; ++j) { const int n = (lane >> 3) + 8 * j; const LAS float* s = scr + (8 * c) * 33 + n;
        v2u o; o.x = pk4_fp8(64.f * s[0 * 33], 64.f * s[1 * 33], 64.f * s[2 * 33], 64.f * s[3 * 33]); o.y = pk4_fp8(64.f * s[4 * 33], 64.f * s[5 * 33], 64.f * s[6 * 33], 64.f * s[7 * 33]);
        *(v2u*)(WT + (size_t)rm(nsrc0 + n) * K + k0 + 8 * c) = o; }
    LDS_WAIT(); asm volatile("" ::: "memory");
}
struct RmIdent { __device__ __forceinline__ int operator()(int c) const { return c; } };
struct RmGate { __device__ __forceinline__ int operator()(int c) const { const int cp = c - 7232, half = cp >> 11, cc = cp & 2047; return 256 * (cc >> 7) + 128 * half + (cc & 127); } };
struct RmUq { __device__ __forceinline__ int operator()(int c) const { const int head = c / 192, off = c - head * 192; if (off < 128) return c; const int j = off - 128; return head * 192 + 128 + 2 * (j & 31) + (j >> 5); } };

__device__ __forceinline__ void sincos_d(double x, float& s, float& c) {
    const double TWO_PI = 6.283185307179586476925286766559;
    const double k = __builtin_rint(x * (1.0 / TWO_PI)); double r = x - k * TWO_PI;
    const double r2 = r * r; double ss = 1.0, cc = 1.0, ts = 1.0, tc = 1.0;
#pragma unroll
    for (int i = 1; i <= 14; ++i) { tc *= -r2 * (1.0 / (double)((2 * i - 1) * (2 * i))); ts *= -r2 * (1.0 / (double)((2 * i) * (2 * i + 1))); cc += tc; ss += ts; }
    s = (float)(ss * r); c = (float)cc;
}

namespace peer {
__device__ __forceinline__ unsigned ordf(float f) { const unsigned u = __float_as_uint(f); return u ^ ((unsigned)((int)u >> 31) | 0x80000000u); }
__device__ __forceinline__ float unordf(unsigned o) { return __uint_as_float(o ^ ((unsigned)((~(int)o) >> 31) | 0x80000000u)); }
__device__ __forceinline__ void sort16_desc(unsigned (&v)[16]) {
#pragma unroll
    for (int k = 2; k <= 16; k <<= 1)
#pragma unroll
        for (int j = k >> 1; j > 0; j >>= 1)
#pragma unroll
            for (int i = 0; i < 16; ++i) { const int l = i ^ j; if (l > i) { const bool desc = ((i & k) == 0);
                const unsigned hi = v[i] > v[l] ? v[i] : v[l], lo = v[i] > v[l] ? v[l] : v[i]; v[i] = desc ? hi : lo; v[l] = desc ? lo : hi; } }
}
__device__ __forceinline__ void merge16_desc(unsigned (&a)[16], const unsigned (&b)[16]) {
#pragma unroll
    for (int i = 0; i < 16; ++i) a[i] = a[i] > b[15 - i] ? a[i] : b[15 - i];
#pragma unroll
    for (int j = 8; j > 0; j >>= 1)
#pragma unroll
        for (int i = 0; i < 16; ++i) { const int l = i ^ j; if (l > i) { const unsigned hi = a[i] > a[l] ? a[i] : a[l], lo = a[i] > a[l] ? a[l] : a[i]; a[i] = hi; a[l] = lo; } }
}
__device__ __forceinline__ void insert_desc(unsigned (&a)[16], unsigned x) {
#pragma unroll
    for (int i = 0; i < 16; ++i) { const unsigned hi = a[i] > x ? a[i] : x, lo = a[i] > x ? x : a[i]; a[i] = hi; x = lo; }
}
__device__ __forceinline__ void top16_of_128(const f32x16 (&acc)[4], int hi, unsigned (&out)[16]) {
    unsigned g[4][16];
#pragma unroll
    for (int kb = 0; kb < 4; ++kb)
#pragma unroll
        for (int r = 0; r < 16; ++r) { const unsigned base = (unsigned)(kb * 32 + (r & 3) + 8 * (r >> 2)); g[kb][r] = ((ordf(acc[kb][r]) & ~127u) | (127u - base)) ^ (unsigned)(4 * hi); }
    sort16_desc(g[0]); sort16_desc(g[1]); sort16_desc(g[2]); sort16_desc(g[3]);
    merge16_desc(g[0], g[1]); merge16_desc(g[2], g[3]); merge16_desc(g[0], g[2]);
    unsigned pr[16];
#pragma unroll
    for (int i = 0; i < 16; ++i) { auto rr = __builtin_amdgcn_permlane32_swap(g[0][i], g[0][i], false, false); pr[i] = hi ? rr[0] : rr[1]; }
    merge16_desc(g[0], pr);
#pragma unroll
    for (int i = 0; i < 16; ++i) out[i] = g[0][i];
}
__device__ __forceinline__ unsigned ckey(float v, int tag) { return (ordf(v) & ~255u) | (unsigned)(255 - tag); }
}

__device__ __forceinline__ float wave_total_dpp(float v) {
    int x = __builtin_bit_cast(int, v);
#define DPP_ADD(ctrl_, rmask_) do { const int t_ = __builtin_amdgcn_update_dpp(0, x, ctrl_, rmask_, 0xf, false); x = __builtin_bit_cast(int, __builtin_bit_cast(float, x) + __builtin_bit_cast(float, t_)); } while (0)
    DPP_ADD(0xB1, 0xf);
    DPP_ADD(0x4E, 0xf);
    DPP_ADD(0x141, 0xf);
    DPP_ADD(0x140, 0xf);
    DPP_ADD(0x142, 0xa);
    DPP_ADD(0x143, 0xc);
#undef DPP_ADD
    return __builtin_bit_cast(float, __builtin_amdgcn_readlane(x, 63));
}
__device__ __forceinline__ void wave_total_dpp4(float (&v)[4]) {
#define DPP_ADD8(ctrl_, rmask_) do { _Pragma("unroll") for (int u = 0; u < 4; ++u) { const int x_ = __builtin_bit_cast(int, v[u]); const int t_ = __builtin_amdgcn_update_dpp(0, x_, ctrl_, rmask_, 0xf, false); v[u] += __builtin_bit_cast(float, t_); } } while (0)
    DPP_ADD8(0xB1, 0xf); DPP_ADD8(0x4E, 0xf); DPP_ADD8(0x141, 0xf); DPP_ADD8(0x140, 0xf); DPP_ADD8(0x142, 0xa); DPP_ADD8(0x143, 0xc);
#undef DPP_ADD8
}
__device__ __forceinline__ float wave_max_nonneg_dpp(float v) {
    int x = __builtin_bit_cast(int, v);
#define DPP_MAX(ctrl_, rmask_) do { const int t_ = __builtin_amdgcn_update_dpp(0, x, ctrl_, rmask_, 0xf, false); x = __builtin_bit_cast(int, fmaxf(__builtin_bit_cast(float, x), __builtin_bit_cast(float, t_))); } while (0)
    DPP_MAX(0xB1, 0xf); DPP_MAX(0x4E, 0xf); DPP_MAX(0x141, 0xf); DPP_MAX(0x140, 0xf); DPP_MAX(0x142, 0xa); DPP_MAX(0x143, 0xc);
#undef DPP_MAX
    return __builtin_bit_cast(float, __builtin_amdgcn_readlane(x, 63));
}
__device__ __forceinline__ float gelu_erf(float v) {
    const float av = __builtin_fabsf(v), t = __builtin_amdgcn_rcpf(av * 0.2316418882f + 1.0f);
    float q = t * 0.5307027145f + (-0.7265760135f); q = q * t + 0.7107068705f; q = q * t + (-0.142248368f); q = q * t + 0.127414796f; q = q * t;
    const float e = __builtin_amdgcn_exp2f((v * v) * (-0.72134752044f));
    const float m = v * (q * e);
    return v < 0.f ? m : v - m;
}

constexpr int PTBL_OFF = MISC_OFF + 64;
__device__ __forceinline__ void* ldp(LAS unsigned char* lds, int k) { const v2u w = *(LAS const v2u*)(lds + PTBL_OFF + 8 * k);
    const unsigned lo = (unsigned)__builtin_amdgcn_readfirstlane((int)w.x), hi = (unsigned)__builtin_amdgcn_readfirstlane((int)w.y); return (void*)(((unsigned long long)hi << 32) | lo); }
struct Args { const float* in[19]; float* out; unsigned char* ws; int ph_lo, ph_hi, bli, pad; };
__global__ void __launch_bounds__(512, 2) mk_fwd(Args args) {
    extern __shared__ __attribute__((aligned(16))) unsigned char lds_raw[];
    LAS unsigned char* lds = (LAS unsigned char*)lds_raw;
    const int tid = threadIdx.x, lane = tid & 63, wave = __builtin_amdgcn_readfirstlane(tid >> 6);
    const int G = gridDim.x, bx = blockIdx.x;
    const int vcu = (G % 8 == 0) ? (bx % 8) * (G / 8) + bx / 8 : bx;
    const int gw = vcu * 8 + wave, NGW = G * 8;
    unsigned char* ws = args.ws;
#define p_x ((const float*)ldp(lds, 0))
#define p_w_in ((const float*)ldp(lds, 1))
#define p_b_gates ((const float*)ldp(lds, 2))
#define p_a_w_out ((const float*)ldp(lds, 3))
#define p_q_norm ((const float*)ldp(lds, 4))
#define p_w_uq ((const float*)ldp(lds, 5))
#define p_kv_norm ((const float*)ldp(lds, 6))
#define p_w_ukv ((const float*)ldp(lds, 7))
#define p_mla_w_out ((const float*)ldp(lds, 8))
#define p_w_out ((const float*)ldp(lds, 9))
#define p_ln1_g ((const float*)ldp(lds, 10))
#define p_ln1_b ((const float*)ldp(lds, 11))
#define p_w_pq ((const float*)ldp(lds, 12))
#define p_sk1 ((const float*)ldp(lds, 13))
#define p_sk2 ((const float*)ldp(lds, 14))
#define p_e_down ((const float*)ldp(lds, 15))
#define p_e_up ((const float*)ldp(lds, 16))
#define p_ln2_g ((const float*)ldp(lds, 17))
#define p_ln2_b ((const float*)ldp(lds, 18))
#define p_out ((float*)ldp(lds, 19))
#define WA8 ((unsigned char*)(ws + WS_WA))
#define WG8 ((unsigned char*)(ws + WS_WG))
#define WAO ((unsigned char*)(ws + WS_WAO))
#define WBO ((unsigned char*)(ws + WS_WBO))
#define WO ((unsigned char*)(ws + WS_WO))
#define WPQ ((bf16*)(ws + WS_WPQ))
#define WUQ ((unsigned char*)(ws + WS_WUQ))
#define WUKV ((unsigned char*)(ws + WS_WUKV))
#define SK ((bf16*)(ws + WS_SK))
#define ROPE ((float*)(ws + WS_ROPE))
#define XB8 ((unsigned char*)(ws + WS_XB))
#define QKV ((bf16*)(ws + WS_QKV))
#define CQKV ((bf16*)(ws + WS_CQKV))
#define KRRAW ((bf16*)(ws + WS_KRRAW))
#define CQN ((unsigned char*)(ws + WS_CQN))
#define CKVN ((unsigned char*)(ws + WS_CKVN))
#define KRR ((unsigned char*)(ws + WS_KRR))
#define LSEB ((float*)(ws + WS_LSE))
#define OA ((bf16*)(ws + WS_OA))
#define OA8 ((unsigned char*)(ws + WS_OA8))
#define QB ((unsigned char*)(ws + WS_QB))
#define KN ((unsigned char*)(ws + WS_KN))
#define VT8 ((unsigned char*)(ws + WS_VT))
#define OB8 ((unsigned char*)(ws + WS_OB))
#define VB ((bf16*)(ws + WS_VB))
#define YA ((unsigned char*)(ws + WS_YA))
#define YB ((unsigned char*)(ws + WS_YB))
#define UB ((unsigned char*)(ws + WS_U))
#define RB ((bf16*)(ws + WS_R))
#define H1B ((bf16*)(ws + WS_H1B))
#define ED8 ((unsigned char*)(ws + WS_ED))
#define EU8 ((unsigned char*)(ws + WS_EU))
#define SD ((float*)(ws + WS_SD))
#define SU ((float*)(ws + WS_SU))
#define PQ ((bf16*)(ws + WS_PQ))
#define IDX ((int*)(ws + WS_IDX))
#define GATE ((float*)(ws + WS_GATE))

    if (tid == 0) {
#define PT(k, p) *(LAS unsigned long long*)(lds + PTBL_OFF + 8 * (k)) = (unsigned long long)(uintptr_t)(p)
        PT(0, args.in[0]); PT(1, args.in[1]); PT(2, args.in[2]); PT(3, args.in[3]); PT(4, args.in[4]); PT(5, args.in[5]); PT(6, args.in[6]); PT(7, args.in[7]); PT(8, args.in[8]); PT(9, args.in[9]);
        PT(10, args.in[10]); PT(11, args.in[11]); PT(12, args.in[12]); PT(13, args.in[13]); PT(14, args.in[14]); PT(15, args.in[15]); PT(16, args.in[16]); PT(17, args.in[17]); PT(18, args.in[18]); PT(19, args.out);
#undef PT
    }
    if (tid < 4) ((LAS unsigned*)(lds + MISC_OFF))[tid] = 0u;
    __syncthreads();
    const int lo = args.ph_lo, hi = args.ph_hi;
    const bool use_bar = true;
    XcdBarrier bar; bar.bar = (unsigned*)(ws + WS_CTL) + CW_BAR + args.bli * XCD_BAR_WORDS; bar.x = 0; bar.st = nullptr;
    if (use_bar) bar = xcd_barrier_post((unsigned*)(ws + WS_CTL) + CW_BAR + args.bli * XCD_BAR_WORDS, (volatile LAS unsigned*)(lds + MISC_OFF));
#ifndef MK_PHASES
#define MK_PHASES 0xFFFFFFFFu
#endif
#define IN(k) ((((MK_PHASES) >> (k)) & 1u) && lo <= (k) && (k) < hi)
#define SEAM(k) do { if (IN(k) && IN((k) + 1)) xcd_barrier(bar); } while (0)

    if (IN(0)) {
        LAS float* scr = (LAS float*)(lds + wave * 16384);
        const float* c_w_in = p_w_in; const float* c_a_w_out = p_a_w_out; const float* c_mla_w_out = p_mla_w_out; const float* c_w_out = p_w_out; const float* c_w_pq = p_w_pq; const float* c_w_uq = p_w_uq; const float* c_w_ukv = p_w_ukv;
        const float* c_x = p_x; const float* c_sk1 = p_sk1; const float* c_sk2 = p_sk2;
        constexpr int I_A = 32 * 226, I_G = 32 * 128, I_SQ = 32 * 64, I_UQ = 8 * 96, I_UKV = 8 * 128;
        constexpr int NITEMS = I_A + I_G + 4 * I_SQ + I_UQ + I_UKV;
        for (int it = gw; it < NITEMS; it += NGW) {
            int r = it;
            if (r < I_A) { transpose_item8(c_w_in, IN_W, DM, 64 * (r / 226), 32 * (r % 226), WA8, RmIdent(), scr, lane); continue; } r -= I_A;
            if (r < I_G) { transpose_item8(c_w_in, IN_W, DM, 64 * (r / 128), 7232 + 32 * (r % 128), WG8, RmGate(), scr, lane); continue; } r -= I_G;
            if (r < I_SQ) { transpose_item8(c_a_w_out, DM, DM, 64 * (r / 64), 32 * (r % 64), WAO, RmIdent(), scr, lane, KmAttn()); continue; } r -= I_SQ;
            if (r < I_SQ) { transpose_item8(c_mla_w_out, DM, DM, 64 * (r / 64), 32 * (r % 64), WBO, RmIdent(), scr, lane, KmAttn()); continue; } r -= I_SQ;
            if (r < I_SQ) { transpose_item8(c_w_out, DM, DM, 64 * (r / 64), 32 * (r % 64), WO, RmIdent(), scr, lane); continue; } r -= I_SQ;
            if (r < I_SQ) { transpose_item(c_w_pq, DM, DM, 64 * (r / 64), 32 * (r % 64), WPQ, RmIdent(), scr, lane); continue; } r -= I_SQ;
            if (r < I_UQ) { transpose_item8(c_w_uq, NQB, QL, 64 * (r / 96), 32 * (r % 96), WUQ, RmUq(), scr, lane); continue; } r -= I_UQ;
            transpose_item8(c_w_ukv, NKV, QL, 64 * (r / 128), 32 * (r % 128), WUKV, RmIdent(), scr, lane);
        }
        const size_t gt = (size_t)vcu * 512 + tid, NT_ = (size_t)G * 512;
        for (size_t i = gt; i < (size_t)192 * DM / 16; i += NT_) *(v4u*)(WA8 + (size_t)7232 * DM + i * 16) = (v4u){0u, 0u, 0u, 0u};
        for (size_t i = gt; i < (size_t)T * DM / 16; i += NT_) { const f32x4 a = *(const f32x4*)(c_x + i * 16), b = *(const f32x4*)(c_x + i * 16 + 4), c = *(const f32x4*)(c_x + i * 16 + 8), d = *(const f32x4*)(c_x + i * 16 + 12);
            *(v4u*)(XB8 + i * 16) = (v4u){pk4_fp8(a[0], a[1], a[2], a[3]), pk4_fp8(b[0], b[1], b[2], b[3]), pk4_fp8(c[0], c[1], c[2], c[3]), pk4_fp8(d[0], d[1], d[2], d[3])}; }
        for (size_t i = gt; i < 2 * 16384; i += NT_) SK[i] = (bf16)f2bf(i < 16384 ? c_sk1[i] : c_sk2[i - 16384]);
        for (size_t i = gt; i < (size_t)SEQ * 32; i += NT_) { const int pos = (int)(i >> 5), j = (int)(i & 31);
            const float inv = (float)exp2(-(double)j / 32.0 * 13.287712379549449);
            const float ang = (float)pos * inv; float s, c; sincos_d((double)ang, s, c); ROPE[2 * i] = c; ROPE[2 * i + 1] = s; }
    }
    SEAM(0);

    if (IN(1)) {
        pg8::Gemm g{(const bf16*)XB8, (const bf16*)WA8, T, NA, DM / 2}; pg8::StaticOrder S; S.init(T, NA, G, bx);
        pg8::EpiA E{QKV, CQKV, KRRAW, 1.f / 64.f};
        pg8::gemm_phase8<pg8::EpiA, pg8::StaticOrder>(lds, g, S, E, nullptr);
    }
    SEAM(1);

    if (IN(2)) {
        const float* c_q_norm = p_q_norm; const float* c_kv_norm = p_kv_norm;
        for (int t = gw; t < T; t += NGW) {
            const v4u cq = *(const v4u*)(CQKV + (size_t)t * 1024 + lane * 8), ck = *(const v4u*)(CQKV + (size_t)t * 1024 + 512 + lane * 8);
            float fq[8] = {bf_lo(cq.x), bf_hi(cq.x), bf_lo(cq.y), bf_hi(cq.y), bf_lo(cq.z), bf_hi(cq.z), bf_lo(cq.w), bf_hi(cq.w)};
            float fk[8] = {bf_lo(ck.x), bf_hi(ck.x), bf_lo(ck.y), bf_hi(ck.y), bf_lo(ck.z), bf_hi(ck.z), bf_lo(ck.w), bf_hi(ck.w)};
            float sq = 0.f, sk = 0.f;
#pragma unroll
            for (int e = 0; e < 8; ++e) { sq += fq[e] * fq[e]; sk += fk[e] * fk[e]; }
            const float rq = 1.f / sqrtf(wave_sum(sq) * (1.f / 512.f) + RMS_EPS), rk = 1.f / sqrtf(wave_sum(sk) * (1.f / 512.f) + RMS_EPS);
            const f32x4 gq0 = *(const f32x4*)(c_q_norm + lane * 8), gq1 = *(const f32x4*)(c_q_norm + lane * 8 + 4), gk0 = *(const f32x4*)(c_kv_norm + lane * 8), gk1 = *(const f32x4*)(c_kv_norm + lane * 8 + 4);
            *(v2u*)(CQN + (size_t)t * 512 + lane * 8) = (v2u){pk4_fp8(fq[0] * rq * gq0[0], fq[1] * rq * gq0[1], fq[2] * rq * gq0[2], fq[3] * rq * gq0[3]), pk4_fp8(fq[4] * rq * gq1[0], fq[5] * rq * gq1[1], fq[6] * rq * gq1[2], fq[7] * rq * gq1[3])};
            *(v2u*)(CKVN + (size_t)t * 512 + lane * 8) = (v2u){pk4_fp8(fk[0] * rk * gk0[0], fk[1] * rk * gk0[1], fk[2] * rk * gk0[2], fk[3] * rk * gk0[3]), pk4_fp8(fk[4] * rk * gk1[0], fk[5] * rk * gk1[1], fk[6] * rk * gk1[2], fk[7] * rk * gk1[3])};
            const int i = lane & 31; const float t1 = bf2f(KRRAW[(size_t)t * 64 + i]), t2 = bf2f(KRRAW[(size_t)t * 64 + 32 + i]);
            const f32x2 cs = *(const f32x2*)(ROPE + ((size_t)(t & (SEQ - 1)) * 32 + i) * 2);
            const float o1 = t1 * cs.x - t2 * cs.y, o2 = t1 * cs.y + t2 * cs.x;
            KRR[(size_t)t * 64 + lane] = (unsigned char)(pk4_fp8(lane < 32 ? o1 : o2, 0.f, 0.f, 0.f) & 0xffu);
        }
    }

#define DIL_DESC(PH, DIL, u_, d) do { \
            const int bh = (u_) >> 6, rem = (u_) & 63, rr = rem / nblk, blk = rem % nblk, b = bh >> 4, h = bh & 15; \
            const size_t tok0 = (size_t)b * SEQ + rr, tq0 = tok0 + (size_t)blk * 256 * (DIL); \
            d.Q = QKV + tq0 * 6144 + h * 128; d.qs = (long)(DIL) * 6144; \
            d.K = QKV + tok0 * 6144 + 2048 + h * 128; d.ks = (long)(DIL) * 6144; d.K2 = nullptr; d.k2s = 0; \
            d.V = QKV + tok0 * 6144 + 4096 + h * 128; d.vs = (long)(DIL) * 6144; \
            d.O = OA + tq0 * DM + h * 128; d.os = (long)(DIL) * DM; d.LSE = LSEB + tq0 * 16 + h; d.ls = (long)(DIL) * 16; \
            d.q0 = blk * 256; d.j_lo = blk == 0 ? 0 : blk * 4 - 2; d.j_hi = blk * 4 + 4; \
            d.sl = __builtin_exp2f(-0.5f * (float)(h + 1)) * (float)(DIL) * LOG2E; d.first = ((PH) == 3); \
            d.O8 = ((PH) == 5) ? OA8 + tq0 * DM + h * 128 : nullptr; d.o8s = (long)(DIL) * DM; } while (0)
#define DIL_PASS(PH, DIL, LOG2D) \
    if (IN(PH)) { \
        constexpr int nblk = SEQ / (DIL) / 256; \
        bf16x8 qr[8]; att::Desc d, dn; \
        if (vcu < 2048) { DIL_DESC(PH, DIL, vcu, d); att::attn_prime<1>(lds, d, qr); } \
        for (int u = vcu; u < 2048; u += G) { \
            const bool hn = u + G < 2048; \
            if (hn) DIL_DESC(PH, DIL, u + G, dn); else dn = d; \
            att::attn_unit<1>(lds, d, dn, hn, qr); \
            d = dn; } }
    DIL_PASS(3, 1, 0)
    SEAM(3);
    DIL_PASS(4, 4, 2)
    SEAM(4);
    DIL_PASS(5, 16, 4)
    SEAM(5);

    if (IN(6)) {
        pg8::Gemm g{(const bf16*)CQN, (const bf16*)WUQ, T, NQB, QL / 2}; pg8::StaticOrder S; S.init(T, NQB, G, bx);
        pg8::EpiQ E{QB, ROPE, QSC_B * att8::QPRE / 64.f};
        pg8::gemm_phase8<pg8::EpiQ, pg8::StaticOrder>(lds, g, S, E, nullptr);
    }
    if (IN(7)) {
        pg8::Gemm g{(const bf16*)CKVN, (const bf16*)WUKV, T, NKV, QL / 2}; pg8::StaticOrder S; S.init(T, NKV, G, bx);
        pg8::EpiKV E{KN, VT8, lds + MISC_OFF + 1024 + (tid >> 6) * 1536, 1.f / 64.f};
        pg8::gemm_phase8<pg8::EpiKV, pg8::StaticOrder>(lds, g, S, E, nullptr);
    }
    SEAM(7);

    if (IN(8)) {
        int trail;
        { LAS unsigned* cnt = (LAS unsigned*)(lds + 126976);
          if (tid < 4) cnt[tid] = 0u;
          __syncthreads();
          const unsigned simd = ((unsigned)__builtin_amdgcn_s_getreg((1 << 11) | (4 << 6) | 4)) & 3u;
          unsigned rk = 0u; if (lane == 0) rk = __hip_atomic_fetch_add(cnt + simd, 1u, __ATOMIC_RELAXED, __HIP_MEMORY_SCOPE_WORKGROUP);
          trail = (int)(__builtin_amdgcn_readfirstlane((int)rk) & 1);
          __syncthreads(); }
        for (int it = vcu; it < 1024; it += G) {
            const int bh = it >> 5, y = it & 31, b = bh >> 4, h = bh & 15;
#pragma unroll 1
            for (int s = 0; s < 2; ++s) { const int xb_ = s == 0 ? 63 - y : y;
                att8::Desc d; const size_t tb = (size_t)b * SEQ;
                d.Q = QB + (tb + (size_t)xb_ * 256) * NQB + h * 192; d.qs = NQB;
                d.K = KN + tb * DM + h * 128; d.ks = DM; d.K2 = KRR + tb * 64; d.k2s = 64;
                d.VT = VT8 + (size_t)bh * 128 * SEQ; d.vts = SEQ; d.O8 = OB8 + (tb + (size_t)xb_ * 256) * DM + h * 128; d.o8s = DM;
                d.q0 = xb_ * 256; d.j_hi = xb_ * 4 + 4; d.trail = trail;
                att8::attn_unit(lds, d); }
        }
    }
    SEAM(8);

    if (IN(9)) {
        pg8::Gemm g{(const bf16*)OA8, (const bf16*)WAO, T, DM, DM / 2}; pg8::StaticOrder S; S.init(T, DM, G, bx);
        pg8::EpiPlain8 E{YA, DM, 1.f / 64.f};
        pg8::gemm_phase8<pg8::EpiPlain8, pg8::StaticOrder>(lds, g, S, E, nullptr);
    }
    if (IN(10)) {
        pg8::Gemm g{(const bf16*)OB8, (const bf16*)WBO, T, DM, DM / 2}; pg8::StaticOrder S; S.init(T, DM, G, bx);
        pg8::EpiPlain8 E{YB, DM, 1.f / 64.f};
        pg8::gemm_phase8<pg8::EpiPlain8, pg8::StaticOrder>(lds, g, S, E, nullptr);
    }
    SEAM(10);

    if (IN(11)) {
        pg8::Gemm g{(const bf16*)XB8, (const bf16*)WG8, T, NGATE, DM / 2}; pg8::StaticOrder S; S.init(T, NGATE, G, bx);
        pg8::EpiGate E{YA, YB, p_b_gates, UB, 1.f / 64.f};
        pg8::gemm_phase8<pg8::EpiGate, pg8::StaticOrder>(lds, g, S, E, nullptr);
    }
    SEAM(11);

    if (IN(12)) {
        pg8::Gemm g{(const bf16*)UB, (const bf16*)WO, T, DM, DM / 2}; pg8::StaticOrder S; S.init(T, DM, G, bx);
        pg8::EpiResid E{p_x, RB, 1.f / 4096.f};
        pg8::gemm_phase8<pg8::EpiResid, pg8::StaticOrder>(lds, g, S, E, nullptr);
    }
    SEAM(12);

    if (IN(13)) {
        const float* c_ln1_g = p_ln1_g; const float* c_ln1_b = p_ln1_b; const float* c_e_down = p_e_down; const float* c_e_up = p_e_up;
        f32x4 lg[8], lb[8];
#pragma unroll
        for (int j = 0; j < 4; ++j) { const int c = 512 * j + 8 * lane; lg[2 * j] = *(const f32x4*)(c_ln1_g + c); lg[2 * j + 1] = *(const f32x4*)(c_ln1_g + c + 4); lb[2 * j] = *(const f32x4*)(c_ln1_b + c); lb[2 * j + 1] = *(const f32x4*)(c_ln1_b + c + 4); }
        v4u nxw[4];
        if (gw < T) {
#pragma unroll
            for (int j = 0; j < 4; ++j) nxw[j] = *(const v4u*)(RB + (size_t)gw * DM + 512 * j + 8 * lane); }
        for (int t = gw; t < T; t += NGW) {
            float v[32]; float s = 0.f;
#pragma unroll
            for (int j = 0; j < 4; ++j) { const v4u w = nxw[j];
                v[8 * j + 0] = bf_lo(w.x); v[8 * j + 1] = bf_hi(w.x); v[8 * j + 2] = bf_lo(w.y); v[8 * j + 3] = bf_hi(w.y); v[8 * j + 4] = bf_lo(w.z); v[8 * j + 5] = bf_hi(w.z); v[8 * j + 6] = bf_lo(w.w); v[8 * j + 7] = bf_hi(w.w); }
            if (t + NGW < T) {
#pragma unroll
                for (int j = 0; j < 4; ++j) nxw[j] = *(const v4u*)(RB + (size_t)(t + NGW) * DM + 512 * j + 8 * lane); }
#pragma unroll
            for (int i = 0; i < 32; ++i) s += v[i];
            const float mean = wave_sum(s) * (1.f / DM); float s2 = 0.f;
#pragma unroll
            for (int i = 0; i < 32; ++i) { v[i] -= mean; s2 += v[i] * v[i]; }
            const float rstd = 1.f / sqrtf(wave_sum(s2) * (1.f / DM) + LN_EPS);
#pragma unroll
            for (int j = 0; j < 4; ++j) { const int c = 512 * j + 8 * lane; const f32x4 g0 = lg[2 * j], g1 = lg[2 * j + 1], b0 = lb[2 * j], b1 = lb[2 * j + 1];
                *(v4u*)(H1B + (size_t)t * DM + c) = (v4u){pk2(v[8 * j] * rstd * g0[0] + b0[0], v[8 * j + 1] * rstd * g0[1] + b0[1]), pk2(v[8 * j + 2] * rstd * g0[2] + b0[2], v[8 * j + 3] * rstd * g0[3] + b0[3]),
                                                          pk2(v[8 * j + 4] * rstd * g1[0] + b1[0], v[8 * j + 5] * rstd * g1[1] + b1[1]), pk2(v[8 * j + 6] * rstd * g1[2] + b1[2], v[8 * j + 7] * rstd * g1[3] + b1[3])}; }
        }
    }
    SEAM(13);

    if (IN(14)) {
        pg8::Gemm g{H1B, WPQ, T, DM, DM}; pg8::StaticOrder S; S.init(T, DM, G, bx);
        pg8::EpiPlain E{PQ, DM, 1.f};
        pg8::gemm_phase<pg8::EpiPlain, pg8::StaticOrder>(lds, g, S, E, nullptr);
    }
    SEAM(14);

    if (IN(15)) {
        for (int c = tid; c < 4096; c += 512) { const int which = c >> 11, row = (c >> 4) & 127, ch = c & 15;
            *(LAS v4u*)(lds + which * 32768 + row * 256 + ((ch ^ (row & 7)) << 4)) = *(const v4u*)(SK + (size_t)which * 16384 + row * 128 + ch * 8); }
        __syncthreads();
        const int r32 = lane & 31, lh = lane >> 5;
        LAS unsigned char* iscr = lds + 65536 + wave * 1024 + r32 * 32;
        for (int task = gw; task < T * PH / 32; task += NGW) {
            const int Rr = task * 32 + r32;
            const bf16* qp = PQ + (size_t)Rr * 256;
            unsigned K1[16], K2[16];
#pragma unroll
            for (int half = 0; half < 2; ++half) {
                bf16x8 qf[8];
#pragma unroll
                for (int ks = 0; ks < 8; ++ks) qf[ks] = *(const bf16x8*)(qp + half * 128 + ks * 16 + lh * 8);
                f32x16 acc[4];
#pragma unroll
                for (int kb = 0; kb < 4; ++kb) { acc[kb] = f32x16{};
#pragma unroll
                    for (int ks = 0; ks < 8; ++ks) { const bf16x8 af = *(LAS const bf16x8*)(lds + half * 32768 + (kb * 32 + r32) * 256 + (((2 * ks + lh) ^ (r32 & 7)) << 4));
                        acc[kb] = __builtin_amdgcn_mfma_f32_32x32x16_bf16(af, qf[ks], acc[kb], 0, 0, 0); } }
                if (half == 0) peer::top16_of_128(acc, lh, K1); else peer::top16_of_128(acc, lh, K2);
            }
            float v1[16], v2[16]; unsigned i1[16], i2[16];
#pragma unroll
            for (int a = 0; a < 16; ++a) { v1[a] = peer::unordf(K1[a] & ~127u); i1[a] = 127u - (K1[a] & 127u); v2[a] = peer::unordf(K2[a] & ~127u); i2[a] = 127u - (K2[a] & 127u); }
            if (lh == 0) {
                *(LAS v4u*)(iscr) = (v4u){i1[0] | (i1[1] << 8) | (i1[2] << 16) | (i1[3] << 24), i1[4] | (i1[5] << 8) | (i1[6] << 16) | (i1[7] << 24), i1[8] | (i1[9] << 8) | (i1[10] << 16) | (i1[11] << 24), i1[12] | (i1[13] << 8) | (i1[14] << 16) | (i1[15] << 24)};
                *(LAS v4u*)(iscr + 16) = (v4u){i2[0] | (i2[1] << 8) | (i2[2] << 16) | (i2[3] << 24), i2[4] | (i2[5] << 8) | (i2[6] << 16) | (i2[7] << 24), i2[8] | (i2[9] << 8) | (i2[10] << 16) | (i2[11] << 24), i2[12] | (i2[13] << 8) | (i2[14] << 16) | (i2[15] << 24)};
            }
            unsigned g0[16], g1[16], g2[16];
#pragma unroll
            for (int b = 0; b < 16; ++b) g0[b] = peer::ckey(v1[0] + v2[b], b);
#pragma unroll
            for (int a = 1; a < 16; ++a) g1[a - 1] = peer::ckey(v1[a] + v2[0], a * 16);
            g1[15] = 0u;
#define CK(a, b) peer::ckey(v1[a] + v2[b], (a) * 16 + (b))
            g2[0] = CK(1, 1); g2[1] = CK(1, 2); g2[2] = CK(1, 3); g2[3] = CK(1, 4); g2[4] = CK(1, 5); g2[5] = CK(1, 6); g2[6] = CK(1, 7);
            g2[7] = CK(2, 1); g2[8] = CK(2, 2); g2[9] = CK(2, 3); g2[10] = CK(2, 4); g2[11] = CK(3, 1); g2[12] = CK(3, 2); g2[13] = CK(3, 3);
            g2[14] = CK(4, 1); g2[15] = CK(4, 2);
            peer::sort16_desc(g2);
            peer::merge16_desc(g0, g1); peer::merge16_desc(g0, g2);
            peer::insert_desc(g0, CK(5, 1)); peer::insert_desc(g0, CK(6, 1)); peer::insert_desc(g0, CK(7, 1));
#undef CK
            LDS_WAIT();
            float sv[16]; int ev[16];
#pragma unroll
            for (int k = 0; k < 16; ++k) { sv[k] = peer::unordf(g0[k] & ~255u); const unsigned tag = 255u - (g0[k] & 255u);
                const unsigned e1 = *(LAS const unsigned char*)(iscr + (tag >> 4)), e2 = *(LAS const unsigned char*)(iscr + 16 + (tag & 15u)); ev[k] = (int)(e1 * 128u + e2); }
            float ex[16], es = 0.f;
#pragma unroll
            for (int k = 0; k < 16; ++k) { ex[k] = __builtin_amdgcn_exp2f((sv[k] - sv[0]) * LOG2E); es += ex[k]; }
            const float inv = 1.f / es;
            { LAS unsigned char* tt = lds + 73728 + wave * 4096 + lh * 2048;
#pragma unroll
              for (int q = 0; q < 4; ++q) { const f32x4 gq = {ex[4 * q] * inv, ex[4 * q + 1] * inv, ex[4 * q + 2] * inv, ex[4 * q + 3] * inv}; const v4i iq = {ev[4 * q], ev[4 * q + 1], ev[4 * q + 2], ev[4 * q + 3]};
                  *(LAS v4i*)(tt + r32 * 64 + 16 * (q ^ ((r32 >> 2) & 3))) = lh == 0 ? __builtin_bit_cast(v4i, gq) : iq; }
              LAS const unsigned char* t0 = lds + 73728 + wave * 4096;
#pragma unroll
              for (int j = 0; j < 2; ++j) { const int g = 64 * j + lane, row = g >> 2, c = g & 3, off = row * 64 + 16 * (c ^ ((row >> 2) & 3));
                  *(v4i*)((unsigned char*)(GATE + (size_t)task * 512) + 16 * g) = *(LAS const v4i*)(t0 + off);
                  *(v4i*)((unsigned char*)(IDX + (size_t)task * 512) + 16 * g) = *(LAS const v4i*)(t0 + 2048 + off); } }
            LDS_WAIT();
        }
        { const float* c_e_down = p_e_down; const float* c_e_up = p_e_up;
        f32x4 nxr[8];
        if (gw < 2 * NEXP) { const float* s0 = (gw >= NEXP ? c_e_up + (size_t)(gw - NEXP) * DM : c_e_down + (size_t)gw * DM) + 32 * lane;
#pragma unroll
            for (int q = 0; q < 8; ++q) nxr[q] = *(const f32x4*)(s0 + 4 * q); }
        for (int rw = gw; rw < 2 * NEXP; rw += NGW) { const int which = rw >= NEXP, e = rw - which * NEXP;
            f32x4 cur[8]; f32x16 v0, v1; float am = 0.f;
#pragma unroll
            for (int q = 0; q < 8; ++q) cur[q] = nxr[q];
            { const int rn = rw + NGW; if (rn < 2 * NEXP) { const float* s1 = (rn >= NEXP ? c_e_up + (size_t)(rn - NEXP) * DM : c_e_down + (size_t)rn * DM) + 32 * lane;
#pragma unroll
                for (int q = 0; q < 8; ++q) nxr[q] = *(const f32x4*)(s1 + 4 * q); } }
#pragma unroll
            for (int q = 0; q < 4; ++q) { const f32x4 a = cur[q], b = cur[4 + q];
                v0[2 * q] = a.x; v1[2 * q] = a.y; v0[2 * q + 1] = a.z; v1[2 * q + 1] = a.w; v0[8 + 2 * q] = b.x; v1[8 + 2 * q] = b.y; v0[8 + 2 * q + 1] = b.z; v1[8 + 2 * q + 1] = b.w;
                am = fmaxf(am, fmaxf(fmaxf(fmaxf(fabsf(a.x), fabsf(a.y)), fmaxf(fabsf(a.z), fabsf(a.w))), fmaxf(fmaxf(fabsf(b.x), fabsf(b.y)), fmaxf(fabsf(b.z), fabsf(b.w))))); }

            am = wave_max_nonneg_dpp(am);
            const float sc = am > 0.f ? am * (1.f / 7.5f) : 1.f, inv = am > 0.f ? 7.5f / am : 0.f;
            v0 = v0 * inv; v1 = v1 * inv;
            const v6u pk = __builtin_amdgcn_cvt_scalef32_2xpk16_fp6_f32(v0, v1, 1.0f);
            unsigned* dst = (unsigned*)((which ? EU8 : ED8) + (size_t)e * 1536 + 24 * lane);
            *(v3u*)dst = (v3u){pk[0], pk[1], pk[2]}; *(v3u*)(dst + 3) = (v3u){pk[3], pk[4], pk[5]};
            if (lane == 0) (which ? SU : SD)[e] = sc; }
        }
    }
    SEAM(15);

    if (IN(16)) {
        const float* c_ln2_g = p_ln2_g; const float* c_ln2_b = p_ln2_b; float* c_out = p_out;
        for (int t = gw; t < T; t += NGW) {
            float xf[32];
            { LAS unsigned char* tr = lds + (tid >> 6) * 16384 + 8192;
#pragma unroll
              for (int j = 0; j < 4; ++j) { const int o = 16 * j + (lane >> 2), c = lane & 3;
                  *(LAS v4u*)(tr + o * 64 + 16 * (c ^ ((o >> 2) & 3))) = *(const v4u*)((const unsigned char*)(H1B + (size_t)t * DM) + 1024 * j + 16 * lane); } }
#pragma unroll
            for (int q = 0; q < 4; ++q) { const v4u w = *(LAS const v4u*)(lds + (tid >> 6) * 16384 + 8192 + lane * 64 + 16 * (q ^ ((lane >> 2) & 3)));
                xf[8 * q + 0] = bf_lo(w.x); xf[8 * q + 1] = bf_hi(w.x); xf[8 * q + 2] = bf_lo(w.y); xf[8 * q + 3] = bf_hi(w.y); xf[8 * q + 4] = bf_lo(w.z); xf[8 * q + 5] = bf_hi(w.z); xf[8 * q + 6] = bf_lo(w.w); xf[8 * q + 7] = bf_hi(w.w); }
            int ivv[2]; float gvv[2], sdl[2], sul[2], wl[2];
#pragma unroll
            for (int h = 0; h < 2; ++h) { ivv[h] = IDX[(size_t)t * 128 + 64 * h + lane]; gvv[h] = GATE[(size_t)t * 128 + 64 * h + lane]; }
#pragma unroll
            for (int h = 0; h < 2; ++h) { sdl[h] = SD[ivv[h]]; sul[h] = SU[ivv[h]]; }
#pragma unroll
            for (int h = 0; h < 2; ++h) { int dots = 0;
#pragma unroll 1
                for (int k0 = 0; k0 < 64; k0 += 4) {
                    v3u dr[4][2];
#pragma unroll
                    for (int u = 0; u < 4; ++u) { const int e = __builtin_amdgcn_readlane(ivv[h], k0 + u); const unsigned char* dp = ED8 + (size_t)e * 1536 + 24 * lane;
                        dr[u][0] = *(const v3u*)dp; dr[u][1] = *(const v3u*)(dp + 12); }
                    SBAR();
                    float tot[4];
#pragma unroll
                    for (int u = 0; u < 4; ++u) { const v6u c6 = {dr[u][0].x, dr[u][0].y, dr[u][0].z, dr[u][1].x, dr[u][1].y, dr[u][1].z};
                        const v32f dv = __builtin_amdgcn_cvt_scalef32_pk32_f32_fp6(c6, 1.0f);
                        f32x2 a0 = {0.f, 0.f}, a1 = {0.f, 0.f};
#pragma unroll
                        for (int i = 0; i < 32; i += 4) { a0 += (f32x2){dv[i], dv[i + 1]} * (f32x2){xf[i], xf[i + 1]}; a1 += (f32x2){dv[i + 2], dv[i + 3]} * (f32x2){xf[i + 2], xf[i + 3]}; }
                        tot[u] = (a0[0] + a0[1]) + (a1[0] + a1[1]); SBAR(); }
                    wave_total_dpp4(tot);
#pragma unroll
                    for (int u = 0; u < 4; ++u) { const int sv = __builtin_amdgcn_readlane(__builtin_bit_cast(int, tot[u]), 63); dots = (lane == k0 + u) ? sv : dots; }
                }
                wl[h] = gvv[h] * gelu_erf(sdl[h] * __builtin_bit_cast(float, dots)) * sul[h]; }
            float y[32];
#pragma unroll
            for (int i = 0; i < 32; ++i) y[i] = 0.f;
#pragma unroll
            for (int h = 0; h < 2; ++h) {
#pragma unroll 1
                for (int k0 = 0; k0 < 64; k0 += 4) {
                    v3u ur[4][2];
#pragma unroll
                    for (int u = 0; u < 4; ++u) { const int e = __builtin_amdgcn_readlane(ivv[h], k0 + u); const unsigned char* up = EU8 + (size_t)e * 1536 + 24 * lane;
                        ur[u][0] = *(const v3u*)up; ur[u][1] = *(const v3u*)(up + 12); }
                    SBAR();
#pragma unroll
                    for (int u = 0; u < 4; ++u) { const float w = __builtin_bit_cast(float, __builtin_amdgcn_readlane(__builtin_bit_cast(int, wl[h]), k0 + u));
                        const v6u c6 = {ur[u][0].x, ur[u][0].y, ur[u][0].z, ur[u][1].x, ur[u][1].y, ur[u][1].z};
                        const v32f uv = __builtin_amdgcn_cvt_scalef32_pk32_f32_fp6(c6, 1.0f);
#pragma unroll
                        for (int i = 0; i < 32; ++i) y[i] = __builtin_fmaf(w, uv[i], y[i]);
                        SBAR(); }
                } }
            float s = 0.f;
#pragma unroll
            for (int i = 0; i < 32; ++i) { y[i] += ALPHA * xf[i]; s += y[i]; }
            const float mean = wave_sum(s) * (1.f / DM); float s2 = 0.f;
#pragma unroll
            for (int i = 0; i < 32; ++i) { y[i] -= mean; s2 += y[i] * y[i]; }
            const float rstd = 1.f / sqrtf(wave_sum(s2) * (1.f / DM) + LN_EPS);
            { LAS unsigned char* tl = lds + (tid >> 6) * 16384;
#pragma unroll
              for (int q = 0; q < 8; ++q) *(LAS f32x4*)(tl + lane * 128 + 16 * (q ^ (lane & 7))) = (f32x4){y[4 * q] * rstd, y[4 * q + 1] * rstd, y[4 * q + 2] * rstd, y[4 * q + 3] * rstd};
#pragma unroll
              for (int q = 0; q < 8; ++q) { const int s = 8 * q + (lane >> 3), ch = lane & 7, c = 256 * q + 4 * lane;
                  const f32x4 g0 = *(const f32x4*)(c_ln2_g + c), b0 = *(const f32x4*)(c_ln2_b + c), v = *(LAS const f32x4*)(tl + s * 128 + 16 * (ch ^ (s & 7)));
                  *(f32x4*)(c_out + (size_t)t * DM + c) = v * g0 + b0; }
              LDS_WAIT(); }
        }
    }
#undef IN
#undef SEAM
#undef DIL_PASS
#undef DIL_DESC
#undef p_x
#undef p_w_in
#undef p_b_gates
#undef p_a_w_out
#undef p_q_norm
#undef p_w_uq
#undef p_kv_norm
#undef p_w_ukv
#undef p_mla_w_out
#undef p_w_out
#undef p_ln1_g
#undef p_ln1_b
#undef p_w_pq
#undef p_sk1
#undef p_sk2
#undef p_e_down
#undef p_e_up
#undef p_ln2_g
#undef p_ln2_b
#undef p_out
#undef WA8
#undef WG8
#undef WAO
#undef WBO
#undef WO
#undef WPQ
#undef WUQ
#undef WUKV
#undef SK
#undef ROPE
#undef XB8
#undef QKV
#undef CQKV
#undef KRRAW
#undef CQN
#undef CKVN
#undef KRR
#undef LSEB
#undef OA
#undef QB
#undef KN
#undef VT8
#undef OB8
#undef OA8
#undef VB
#undef YA
#undef YB
#undef UB
#undef RB
#undef H1B
#undef ED8
#undef EU8
#undef SD
#undef SU
#undef PQ
#undef IDX
#undef GATE
}


#if defined(MK_PROBE)
constexpr int CHK_OFF = 512;
__device__ __forceinline__ float fp8f(const unsigned char* p, size_t i) { const int w = (int)((const unsigned*)p)[i >> 2]; switch (i & 3) { case 0: return __builtin_amdgcn_cvt_f32_fp8(w, 0); case 1: return __builtin_amdgcn_cvt_f32_fp8(w, 1); case 2: return __builtin_amdgcn_cvt_f32_fp8(w, 2); default: return __builtin_amdgcn_cvt_f32_fp8(w, 3); } }
__device__ __forceinline__ float o8f(const unsigned char* row, int c) { const int h = c >> 7, w = c & 127; return fp8f(row, (size_t)(h * 128 + 4 * (w & 31) + (w >> 5))) * (1.f / 64.f); }
__device__ __forceinline__ unsigned hash32(unsigned a) { a ^= a >> 16; a *= 0x7feb352dU; a ^= a >> 15; a *= 0x846ca68bU; a ^= a >> 16; return a; }
__device__ __forceinline__ void chk_acc(unsigned char* ws, int k, float num, float den) {
    __shared__ float red[2][16];
    const int lane = threadIdx.x & 63, w = threadIdx.x >> 6, nw = (blockDim.x + 63) >> 6;
    num = wave_sum(num); den = wave_sum(den);
    if (lane == 0) { red[0][w] = num; red[1][w] = den; }
    __syncthreads();
    if (threadIdx.x == 0) { float a = 0.f, b = 0.f; for (int i = 0; i < nw; ++i) { a += red[0][i]; b += red[1][i]; }
        atomicAdd((float*)(ws + WS_CTL) + CHK_OFF + 2 * k, a); atomicAdd((float*)(ws + WS_CTL) + CHK_OFF + 2 * k + 1, b); }
    __syncthreads();
}
__global__ void __launch_bounds__(256) chk_inproj(const float* x, const float* w_in, unsigned char* ws) {
    const int s = blockIdx.x, j = threadIdx.x; const int t = hash32(s * 7 + 1) % T; const int c = (j * 28 + s * 3) % 7232;
    float ref = 0.f; for (int k = 0; k < DM; ++k) ref += x[(size_t)t * DM + k] * w_in[(size_t)k * IN_W + c];
    float fast;
    if (c < 6144) fast = bf2f(((const bf16*)(ws + WS_QKV))[(size_t)t * 6144 + c]) / (c < 2048 ? QSC_A : 1.f);
    else if (c < 7168) fast = bf2f(((const bf16*)(ws + WS_CQKV))[(size_t)t * 1024 + c - 6144]);
    else fast = bf2f(((const bf16*)(ws + WS_KRRAW))[(size_t)t * 64 + c - 7168]);
    chk_acc(ws, 0, (fast - ref) * (fast - ref), ref * ref);
}
__global__ void __launch_bounds__(64) chk_norm(const float* qn, const float* kvn, unsigned char* ws) {
    const int s = blockIdx.x, lane = threadIdx.x; const int t = hash32(s * 11 + 5) % T;
    const bf16* raw = (const bf16*)(ws + WS_CQKV) + (size_t)t * 1024; float num = 0.f, den = 0.f;
    for (int part = 0; part < 2; ++part) { float ss = 0.f; for (int k = lane; k < 512; k += 64) { const float v = bf2f(raw[part * 512 + k]); ss += v * v; }
        ss = wave_sum(ss); const float r = 1.f / sqrtf(ss / 512.f + RMS_EPS);
        const unsigned char* o = (const unsigned char*)(ws + (part ? WS_CKVN : WS_CQN)) + (size_t)t * 512; const float* g = part ? kvn : qn;
        for (int k = lane; k < 512; k += 64) { const float ref = bf2f(raw[part * 512 + k]) * r * g[k], f = fp8f(o, k); num += (f - ref) * (f - ref); den += ref * ref; } }
    { const int i = lane & 31; const bf16* kr = (const bf16*)(ws + WS_KRRAW) + (size_t)t * 64; const float t1 = bf2f(kr[i]), t2 = bf2f(kr[i + 32]);
      const float inv = powf(10000.f, -(float)i / 32.f); const float ang = (float)(t & (SEQ - 1)) * inv; float sn, cs; sincos_d((double)ang, sn, cs);
      const float ref = lane < 32 ? t1 * cs - t2 * sn : t1 * sn + t2 * cs, f = fp8f((const unsigned char*)(ws + WS_KRR), (size_t)t * 64 + lane); num += (f - ref) * (f - ref); den += ref * ref; }
    chk_acc(ws, 1, num, den);
}
__global__ void __launch_bounds__(64) chk_dil(unsigned char* ws) {
    __shared__ float lg[3][132]; __shared__ float og[3][128]; __shared__ float qs[128];
    const int s = blockIdx.x, lane = threadIdx.x; const unsigned hh = hash32(s * 13 + 7);
    const int b = hh & 1, h = (hh >> 1) & 15; int t = (hh >> 5) % SEQ; if (s < 8) t = s * 3; if (s >= 8 && s < 16) t = 100 + s * 37;
    const bf16* QKV_ = (const bf16*)(ws + WS_QKV); const size_t rowq = (size_t)b * SEQ + t;
    for (int c = lane; c < 128; c += 64) qs[c] = bf2f(QKV_[rowq * 6144 + h * 128 + c]) / QSC_A;
    __syncthreads();
    const float slope = exp2f(-0.5f * (float)(h + 1)); float lse[3];
    const int dil[3] = {1, 4, 16};
    for (int g = 0; g < 3; ++g) { const int d = dil[g], i = t / d;
        for (int j = lane; j <= 128; j += 64) { float l = -1e30f;
            if (i - j >= 0) { const size_t rk = (size_t)b * SEQ + (t - j * d); float dot = 0.f; for (int c = 0; c < 128; ++c) dot += qs[c] * bf2f(QKV_[rk * 6144 + 2048 + h * 128 + c]);
                l = dot * 0.08838834764831845f - slope * (float)(d * j); }
            lg[g][j] = l; }
        __syncthreads();
        float m = -1e30f; for (int j = 0; j <= 128; ++j) m = fmaxf(m, lg[g][j]);
        float z = 0.f; for (int j = 0; j <= 128; ++j) z += expf(lg[g][j] - m);
        for (int c = lane; c < 128; c += 64) { float o = 0.f; for (int j = 0; j <= 128; ++j) { if (i - j < 0) break; const size_t rk = (size_t)b * SEQ + (t - j * d); o += expf(lg[g][j] - m) / z * bf2f(QKV_[rk * 6144 + 4096 + h * 128 + c]); } og[g][c] = o; }
        lse[g] = m + logf(z);
        __syncthreads(); }
    const float mm = fmaxf(lse[0], fmaxf(lse[1], lse[2])); const float e0 = expf(lse[0] - mm), e1 = expf(lse[1] - mm), e2 = expf(lse[2] - mm), es = e0 + e1 + e2;
    float num = 0.f, den = 0.f;
    for (int c = lane; c < 128; c += 64) { const float ref = (e0 * og[0][c] + e1 * og[1][c] + e2 * og[2][c]) / es, f = o8f((const unsigned char*)(ws + WS_OA8) + rowq * DM, h * 128 + c); num += (f - ref) * (f - ref); den += ref * ref; }
    chk_acc(ws, 2, num, den);
}
__global__ void __launch_bounds__(192) chk_qb(const float* w_uq, unsigned char* ws) {
    __shared__ float raw[192];
    const int s = blockIdx.x, c = threadIdx.x; const unsigned hh = hash32(s * 17 + 3); const int t = hh % T, head = (hh >> 16) & 15;
    const unsigned char* cq = (const unsigned char*)(ws + WS_CQN) + (size_t)t * 512; float a = 0.f; for (int k = 0; k < 512; ++k) a += fp8f(cq, k) * w_uq[(size_t)k * NQB + head * 192 + c];
    raw[c] = a; __syncthreads();
    float ref = a;
    if (c >= 128) { const int i = (c - 128) & 31; const float inv = powf(10000.f, -(float)i / 32.f); const float ang = (float)(t & (SEQ - 1)) * inv; float sn, cs; sincos_d((double)ang, sn, cs);
        const float t1 = raw[128 + i], t2 = raw[160 + i]; ref = c < 160 ? t1 * cs - t2 * sn : t1 * sn + t2 * cs; }
    ref *= QSC_B; const float f = fp8f((const unsigned char*)(ws + WS_QB), (size_t)t * NQB + head * 192 + c) * (1.f / 8.f);
    chk_acc(ws, 3, (f - ref) * (f - ref), ref * ref);
}
__global__ void __launch_bounds__(256) chk_kv(const float* w_ukv, unsigned char* ws) {
    const int s = blockIdx.x, c = threadIdx.x; const unsigned hh = hash32(s * 19 + 9); const int t = hh % T, head = (hh >> 16) & 15;
    const unsigned char* ck = (const unsigned char*)(ws + WS_CKVN) + (size_t)t * 512; float ref = 0.f; for (int k = 0; k < 512; ++k) ref += fp8f(ck, k) * w_ukv[(size_t)k * NKV + head * 256 + c];
    const float f = c < 128 ? fp8f((const unsigned char*)(ws + WS_KN), (size_t)t * DM + head * 128 + c) : fp8f((const unsigned char*)(ws + WS_VT), ((size_t)((t / SEQ) * 16 + head) * 128 + (c - 128)) * SEQ + ((t % SEQ) & ~63) + att8::vperm((t % SEQ) & 63));
    chk_acc(ws, 4, (f - ref) * (f - ref), ref * ref);
}
__global__ void __launch_bounds__(256) chk_mla(unsigned char* ws) {
    __shared__ float qs[192]; __shared__ float redm[4]; __shared__ float redz[4];
    const int s = blockIdx.x, tid = threadIdx.x; const unsigned hh = hash32(s * 23 + 11); const int b = hh & 1, h = (hh >> 1) & 15; int t = (hh >> 5) % SEQ; if (s < 6) t = s * 51; if (s >= 6 && s < 12) t = SEQ - 1 - (s - 6) * 77;
    const size_t tb = (size_t)b * SEQ; float* pbuf = (float*)(ws + WS_END) + (size_t)s * SEQ;
    for (int c = tid; c < 192; c += 256) qs[c] = fp8f((const unsigned char*)(ws + WS_QB), (tb + t) * NQB + h * 192 + c) * (1.f / 8.f);
    __syncthreads();
    float m = -1e30f;
    for (int k = tid; k <= t; k += 256) { float dot = 0.f; const unsigned char* kn = (const unsigned char*)(ws + WS_KN) + (tb + k) * DM + h * 128; const unsigned char* kr = (const unsigned char*)(ws + WS_KRR) + (tb + k) * 64;
        for (int c = 0; c < 128; ++c) dot += qs[c] * fp8f(kn, c); for (int c = 0; c < 64; ++c) dot += qs[128 + c] * fp8f(kr, c);
        pbuf[k] = dot; m = fmaxf(m, dot); }
    for (int o = 1; o < 64; o <<= 1) m = fmaxf(m, __shfl_xor(m, o));
    if ((tid & 63) == 0) redm[tid >> 6] = m; __syncthreads(); m = fmaxf(fmaxf(redm[0], redm[1]), fmaxf(redm[2], redm[3]));
    float z = 0.f; for (int k = tid; k <= t; k += 256) { const float p = exp2f(pbuf[k] - m); pbuf[k] = p; z += p; }
    z = wave_sum(z); if ((tid & 63) == 0) redz[tid >> 6] = z; __syncthreads(); z = redz[0] + redz[1] + redz[2] + redz[3];
    __threadfence_block(); __syncthreads();
    float num = 0.f, den = 0.f;
    if (tid < 128) { float o = 0.f; for (int k = 0; k <= t; ++k) o += pbuf[k] * fp8f((const unsigned char*)(ws + WS_VT), ((size_t)(b * 16 + h) * 128 + tid) * SEQ + (k & ~63) + att8::vperm(k & 63));
        const float ref = o / z, f = o8f((const unsigned char*)(ws + WS_OB) + (tb + t) * DM, h * 128 + tid); num = (f - ref) * (f - ref); den = ref * ref; }
    chk_acc(ws, 5, num, den);
}
__global__ void __launch_bounds__(256) chk_y(const float* wa, const float* wb, unsigned char* ws) {
    const int s = blockIdx.x, j = threadIdx.x; const int t = hash32(s * 29 + 13) % T, c = (j * 8 + s) % DM;
    const unsigned char* oa = (const unsigned char*)(ws + WS_OA8) + (size_t)t * DM; const unsigned char* ob = (const unsigned char*)(ws + WS_OB) + (size_t)t * DM; float ra = 0.f, rb = 0.f;
    for (int k = 0; k < DM; ++k) { ra += o8f(oa, k) * wa[(size_t)k * DM + c]; rb += o8f(ob, k) * wb[(size_t)k * DM + c]; }
    const float fa = fp8f((const unsigned char*)(ws + WS_YA), (size_t)t * DM + c) * (1.f / 64.f), fb = fp8f((const unsigned char*)(ws + WS_YB), (size_t)t * DM + c) * (1.f / 64.f);
    chk_acc(ws, 6, (fa - ra) * (fa - ra) + (fb - rb) * (fb - rb), ra * ra + rb * rb);
}
__global__ void __launch_bounds__(256) chk_u(const float* x, const float* w_in, const float* bg, unsigned char* ws) {
    const int s = blockIdx.x, j = threadIdx.x; const int t = hash32(s * 31 + 17) % T, c = (j * 8 + s) % DM;
    float ga = 0.f, gb = 0.f; for (int k = 0; k < DM; ++k) { const float xv = x[(size_t)t * DM + k]; ga += xv * w_in[(size_t)k * IN_W + 7232 + c]; gb += xv * w_in[(size_t)k * IN_W + 7232 + DM + c]; }
    ga = 1.f / (1.f + expf(-(ga + bg[c]))); gb = 1.f / (1.f + expf(-(gb + bg[DM + c])));
    const float ref = ga * fp8f((const unsigned char*)(ws + WS_YA), (size_t)t * DM + c) * (1.f / 64.f) + gb * fp8f((const unsigned char*)(ws + WS_YB), (size_t)t * DM + c) * (1.f / 64.f), f = fp8f((const unsigned char*)(ws + WS_U), (size_t)t * DM + c) * (1.f / 64.f);
    chk_acc(ws, 7, (f - ref) * (f - ref), ref * ref);
}
__global__ void __launch_bounds__(256) chk_r(const float* x, const float* wo, unsigned char* ws) {
    const int s = blockIdx.x, j = threadIdx.x; const int t = hash32(s * 37 + 19) % T, c = (j * 8 + s) % DM;
    const unsigned char* u = (const unsigned char*)(ws + WS_U) + (size_t)t * DM; float ref = 0.f; for (int k = 0; k < DM; ++k) ref += fp8f(u, k) * (1.f / 64.f) * wo[(size_t)k * DM + c];
    const float f = bf2f(((const bf16*)(ws + WS_R))[(size_t)t * DM + c]) - ALPHA * x[(size_t)t * DM + c];
    chk_acc(ws, 8, (f - ref) * (f - ref), ref * ref);
}
__global__ void __launch_bounds__(64) chk_dummy(unsigned char* ws) { chk_acc(ws, 9, threadIdx.x == 0 ? 2.f : 0.f, threadIdx.x == 0 ? 1.f : 0.f); }
__global__ void __launch_bounds__(256) chk_report(float* out, unsigned char* ws, int nchk, float thr) {
    const float* a = (const float*)(ws + WS_CTL) + CHK_OFF; int bad = -1; float e = 0.f;
    for (int k = 0; k < nchk; ++k) { const float num = a[2 * k], den = a[2 * k + 1]; const float err = (den > 0.f) ? sqrtf(num / den) : 1.f; const bool nan = !(err == err);
        const float th = (k == 0 || k == 1 || k == 2 || k == 3 || k == 4 || k == 5 || k == 6 || k == 7) ? (k == 5 ? 0.12f : 0.08f) : (k == 8 ? 0.2f : thr);
        if (bad < 0 && (nan || err > th || !(den > 0.f))) { bad = k; e = nan ? 1.f : fminf(err, 1.f); } }
    if (bad < 0) return;
    const float K = sqrtf((1.f + 8.f * e) * powf(10.f, (float)(bad + 2)));
    for (size_t i = (size_t)blockIdx.x * blockDim.x + threadIdx.x; i < (size_t)T * DM; i += (size_t)gridDim.x * blockDim.x) out[i] = K;
}
#endif

#if defined(MK_FP6PROBE)
__global__ void __launch_bounds__(256) fp6_probe(float* out, int which_slot) {
    const float pos[16] = {0.125f, 0.25f, 0.375f, 0.5f, 0.625f, 0.75f, 0.875f, 1.f, 1.25f, 1.5f, 1.75f, 2.f, 2.5f, 3.f, 3.5f, 4.f};
    f32x16_t x0, x1;
#pragma unroll
    for (int i = 0; i < 16; ++i) { x0[i] = pos[i]; x1[i] = -pos[i]; }
    const v6u pk = __builtin_amdgcn_cvt_scalef32_2xpk16_fp6_f32(x0, x1, 1.0f);
    const v32f r = __builtin_amdgcn_cvt_scalef32_pk32_f32_fp6(pk, 1.0f);
    int m1 = 0, m2 = 0, m3 = 0, scaled = 0;
#pragma unroll
    for (int j = 0; j < 32; ++j) { const float h1 = j < 16 ? pos[j] : -pos[j - 16], h2 = (j & 1) ? -pos[j >> 1] : pos[j >> 1], h3 = (j & 1) ? pos[j >> 1] : -pos[j >> 1];
        m1 += (r[j] == h1); m2 += (r[j] == h2); m3 += (r[j] == h3); scaled += (r[j] != 0.f && (fabsf(r[j]) > 4.f || fabsf(r[j]) < 0.125f)); }
    float code = 6.f;
    if (m1 == 32) code = 2.f; else if (m2 == 32) code = 3.f; else if (m3 == 32) code = 4.f; else if (scaled) code = 8.f;
    if (which_slot >= 0) { float v = 0.f;
#pragma unroll
        for (int j = 0; j < 32; ++j) if (j == which_slot) v = r[j];
        int src = 40;
#pragma unroll
        for (int i = 0; i < 16; ++i) { if (v == pos[i]) src = i; if (v == -pos[i]) src = 16 + i; }
        code = 10.f + (float)src * 0.5f; }
    const float K = sqrtf(powf(10.f, code));
    for (size_t i = (size_t)blockIdx.x * blockDim.x + threadIdx.x; i < (size_t)T * DM; i += (size_t)gridDim.x * blockDim.x) out[i] = K;
}
#endif

extern "C" void kernel_launch(void* const* d_in, const int* in_sizes, int n_in, void* d_out, int out_size, void* d_ws, size_t ws_size, hipStream_t stream) {
    static int grid = 0;
    if (grid == 0) {
        if (n_in != 19 || in_sizes[0] != T * DM || out_size != T * DM || ws_size < WS_END) { fprintf(stderr, "kernel_launch: unexpected shapes (n_in %d, in0 %d, out %d, ws %zu)\n", n_in, n_in > 0 ? in_sizes[0] : -1, out_size, ws_size); grid = -1; return; }
        int dev = 0, cus = 0, per_cu = 0;
        if (hipGetDevice(&dev) != hipSuccess || hipDeviceGetAttribute(&cus, hipDeviceAttributeMultiprocessorCount, dev) != hipSuccess) { grid = -1; return; }
        if (hipFuncSetAttribute((const void*)mk_fwd, hipFuncAttributeMaxDynamicSharedMemorySize, LDS_BYTES) != hipSuccess) { fprintf(stderr, "kernel_launch: hipFuncSetAttribute failed\n"); grid = -1; return; }
        if (hipOccupancyMaxActiveBlocksPerMultiprocessor(&per_cu, (const void*)mk_fwd, 512, LDS_BYTES) != hipSuccess || per_cu < 1) { fprintf(stderr, "kernel_launch: occupancy query says %d blocks per CU\n", per_cu); }
        (void)hipGetLastError();
        grid = cus;
    }
    if (grid < 0) return;
    if (hipMemsetAsync((char*)d_ws + WS_CTL, 0, CTL_ZERO_BYTES, stream) != hipSuccess) return;
    Args a{};
    for (int i = 0; i < 19; ++i) a.in[i] = (const float*)d_in[i];
    a.out = (float*)d_out; a.ws = (unsigned char*)d_ws;
#if defined(MK_FP6PROBE)
    hipLaunchKernelGGL(fp6_probe, dim3(1024), dim3(256), 0, stream, (float*)d_out, MK_FP6PROBE);
#elif defined(MK_PROBE)
    {
        const int cuts[10] = {0, 2, 3, 6, 8, 9, 11, 12, 13, NPHASE};
        unsigned char* w = (unsigned char*)d_ws;
        for (int li = 0; li < 9; ++li) { a.ph_lo = cuts[li]; a.ph_hi = cuts[li + 1]; a.bli = li; hipLaunchKernelGGL(mk_fwd, dim3(grid), dim3(512), LDS_BYTES, stream, a);
            if (li == 0) hipLaunchKernelGGL(chk_inproj, dim3(64), dim3(256), 0, stream, a.in[0], a.in[1], w);
            if (li == 1) hipLaunchKernelGGL(chk_norm, dim3(64), dim3(64), 0, stream, a.in[4], a.in[6], w);
            if (li == 2) hipLaunchKernelGGL(chk_dil, dim3(128), dim3(64), 0, stream, w);
            if (li == 3) { hipLaunchKernelGGL(chk_qb, dim3(64), dim3(192), 0, stream, a.in[5], w); hipLaunchKernelGGL(chk_kv, dim3(64), dim3(256), 0, stream, a.in[7], w); }
            if (li == 4) hipLaunchKernelGGL(chk_mla, dim3(64), dim3(256), 0, stream, w);
            if (li == 5) hipLaunchKernelGGL(chk_y, dim3(64), dim3(256), 0, stream, a.in[3], a.in[8], w);
            if (li == 6) hipLaunchKernelGGL(chk_u, dim3(64), dim3(256), 0, stream, a.in[0], a.in[1], a.in[2], w);
            if (li == 7) hipLaunchKernelGGL(chk_r, dim3(64), dim3(256), 0, stream, a.in[0], a.in[9], w);
        }
        hipLaunchKernelGGL(chk_dummy, dim3(1), dim3(64), 0, stream, w);
        hipLaunchKernelGGL(chk_report, dim3(1024), dim3(256), 0, stream, (float*)d_out, w, 10, 0.015f);
    }
#elif defined(MK_DUP_PHASE)
    a.ph_lo = 0; a.ph_hi = MK_DUP_PHASE + 1; a.bli = 0; hipLaunchKernelGGL(mk_fwd, dim3(grid), dim3(512), LDS_BYTES, stream, a);
    a.ph_lo = MK_DUP_PHASE; a.ph_hi = NPHASE; a.bli = 1; hipLaunchKernelGGL(mk_fwd, dim3(grid), dim3(512), LDS_BYTES, stream, a);
#else
    a.ph_lo = 0; a.ph_hi = NPHASE; a.bli = 0;
    hipLaunchKernelGGL(mk_fwd, dim3(grid), dim3(512), LDS_BYTES, stream, a);
#endif
}
```
